# Optimizing an MI355X kernel written in HIP

```python
import math
import jax, jax.numpy as jnp
from jax import lax
import numpy as np

D_MODEL = 2048
BATCH = 4
SEQ = 4096
DEPTH = 1

MIX_WIDTH = D_MODEL
DIFF_HEADS = 8
DIFF_HEAD_DIM = 64
DIFF_V_DIM = 2 * DIFF_HEAD_DIM
DIFF_WIDTH = DIFF_HEADS * DIFF_V_DIM
RET_HEADS = 8
RET_QK_DIM = 128
RET_V_DIM = 128
RET_WIDTH = RET_HEADS * RET_V_DIM
RET_CHUNK = 128
Q_BLOCK = 128
ROPE_THETA = 10000.0
N_EXPERTS = 16
EXPERT_FF = 2048
EC_CAPACITY_FACTOR = 2
NORM_EPS = 1e-6
N_MOD = 6
SPLITS = (
    DIFF_HEADS * 2 * DIFF_HEAD_DIM,
    DIFF_HEADS * 2 * DIFF_HEAD_DIM,
    DIFF_WIDTH,
    RET_HEADS * RET_QK_DIM,
    RET_HEADS * RET_QK_DIM,
    RET_WIDTH,
    RET_WIDTH,
)
IN_COLS = sum(SPLITS)

kernel_name = "hybrid_diffattn_retention_ec_moe_block"


def _lambda_init(layer_idx):
    return 0.8 - 0.6 * math.exp(-0.3 * layer_idx)


def _rmsnorm(x, gain):
    xf = x.astype(jnp.float32)
    y = xf * lax.rsqrt(jnp.mean(xf * xf, axis=-1, keepdims=True) + NORM_EPS)
    return (y * gain.astype(jnp.float32)).astype(x.dtype)


def _head_layernorm(x, gain):
    xf = x.astype(jnp.float32)
    mu = jnp.mean(xf, axis=-1, keepdims=True)
    var = jnp.mean(jnp.square(xf - mu), axis=-1, keepdims=True)
    y = (xf - mu) * lax.rsqrt(var + NORM_EPS)
    H, dv = x.shape[1], x.shape[3]
    g = gain.astype(jnp.float32).reshape(1, H, 1, dv)
    return (y * g).astype(x.dtype)


def _rope_tables(positions, dim):
    inv = 1.0 / (ROPE_THETA ** (jnp.arange(0, dim, 2, dtype=jnp.float32) / dim))
    ang = positions.astype(jnp.float32)[..., None] * inv
    return jnp.cos(ang), jnp.sin(ang)


def _rope(x, cos, sin):
    shape = cos.shape[:2] + (1,) * (x.ndim - 3) + cos.shape[-1:]
    cos = cos.reshape(shape)
    sin = sin.reshape(shape)
    x1, x2 = jnp.split(x.astype(jnp.float32), 2, axis=-1)
    return jnp.concatenate([x1 * cos - x2 * sin, x2 * cos + x1 * sin], axis=-1).astype(x.dtype)


def _diff_attention(qs, ks, v, lam):
    B, H, _, S, d = qs.shape
    nb = S // Q_BLOCK
    scale = d ** -0.5
    qb = jnp.moveaxis(qs.reshape(B, H, 2, nb, Q_BLOCK, d), 3, 0)

    def block(q_blk):
        s = jnp.einsum('bhmqd,bhmkd->bhmqk', q_blk, ks).astype(jnp.float32) * scale
        p = jax.nn.softmax(s, axis=-1)
        w = p[:, :, 0] - lam * p[:, :, 1]
        return jnp.einsum('bhqk,bhke->bhqe', w.astype(v.dtype), v)

    out = lax.map(block, qb)
    return jnp.moveaxis(out, 0, 2).reshape(B, H, S, v.shape[-1])


def _retention_one_direction(q, k, v, gamma, strict):
    B, H, S, dk = q.shape
    dv = v.shape[-1]
    C = RET_CHUNK
    N = S // C
    dt = q.dtype
    qc = q.reshape(B, H, N, C, dk)
    kc = k.reshape(B, H, N, C, dk)
    vc = v.reshape(B, H, N, C, dv)
    log_g = jnp.log(gamma)
    j = jnp.arange(C, dtype=jnp.float32)
    dist = j[:, None] - j[None, :]
    mask = (dist > 0) if strict else (dist >= 0)
    inner_decay = jnp.where(mask[None], jnp.exp(log_g[:, None, None] * jnp.maximum(dist, 0.0)[None]), 0.0)
    scores = jnp.einsum('bhncd,bhnmd->bhncm', qc, kc) * inner_decay[None, :, None].astype(dt)
    inner = jnp.einsum('bhncm,bhnme->bhnce', scores, vc)
    k_decay = jnp.exp(log_g[:, None] * (C - 1 - j)[None]).astype(dt)
    kv = jnp.einsum('bhncd,bhnce->bhnde', kc * k_decay[None, :, None, :, None], vc)
    chunk_decay = jnp.exp(log_g * C).astype(kv.dtype)[None, :, None, None]

    def step(state, kv_n):
        return state * chunk_decay + kv_n, state

    init = jnp.zeros((B, H, dk, dv), kv.dtype)
    _, prev = lax.scan(step, init, jnp.moveaxis(kv, 2, 0))
    prev = jnp.moveaxis(prev, 0, 2)
    q_decay = jnp.exp(log_g[:, None] * (j + 1.0)[None]).astype(dt)
    cross = jnp.einsum('bhncd,bhnde->bhnce', qc * q_decay[None, :, None, :, None], prev)
    return (inner + cross).reshape(B, H, S, dv)


def _bidirectional_retention(q, k, v, gamma_fwd, gamma_bwd):
    fwd = _retention_one_direction(q, k, v, gamma_fwd, strict=False)
    bwd = _retention_one_direction(jnp.flip(q, 2), jnp.flip(k, 2), jnp.flip(v, 2), gamma_bwd, strict=True)
    return fwd + jnp.flip(bwd, 2)


def _expert_choice_ffn(h, w_router, w_gate, w_up, w_down):
    B, S, D = h.shape
    cap = EC_CAPACITY_FACTOR * S // N_EXPERTS
    logits = jnp.einsum('bsd,de->bse', h, w_router).astype(jnp.float32)
    aff = jax.nn.softmax(logits, axis=-1)
    gates, idx = lax.top_k(jnp.swapaxes(aff, 1, 2), cap)
    xin = jax.vmap(lambda hb, ib: hb[ib])(h, idx)
    a = jnp.einsum('becd,edf->becf', xin, w_gate)
    u = jnp.einsum('becd,edf->becf', xin, w_up)
    y = jnp.einsum('becf,efd->becd', jax.nn.silu(a) * u, w_down) * gates[..., None].astype(h.dtype)
    return jax.vmap(lambda yb, ib: jnp.zeros((S, D), h.dtype).at[ib.reshape(-1)].add(yb.reshape(-1, D)))(y, idx)


def setup_inputs(seed: int = 0) -> dict:
    key = jax.random.key(seed)
    ks = jax.random.split(key, 24)
    L, D, E, F = DEPTH, D_MODEL, N_EXPERTS, EXPERT_FF
    nrm = lambda k, shape, s: jax.random.normal(k, shape, jnp.float32) * s
    base = np.log2(1.0 - 2.0 ** (-5.0 - np.arange(RET_HEADS)))
    gam = 1.0 - 2.0 ** (-5.0 - np.arange(RET_HEADS, dtype=np.float32))
    logit = jnp.asarray(np.log(gam / (1.0 - gam)), jnp.float32)
    return {
        'x': nrm(ks[0], (BATCH, SEQ, D), 1.0),
        'c': nrm(ks[1], (BATCH, D), 1.0),
        'positions': jnp.broadcast_to(jnp.arange(SEQ, dtype=jnp.int32)[None], (BATCH, SEQ)),
        'w_ada': nrm(ks[2], (L, D, N_MOD * D), 0.5 * D ** -0.5),
        'b_ada': nrm(ks[3], (L, N_MOD * D), 0.01),
        'g_pre_mix': 1.0 + nrm(ks[4], (L, D), 0.02),
        'g_post_mix': 1.0 + nrm(ks[5], (L, D), 0.02),
        'w_in': nrm(ks[6], (L, D, IN_COLS), D ** -0.5),
        'diff_lambda_q1': nrm(ks[7], (L, DIFF_HEAD_DIM), 0.1),
        'diff_lambda_k1': nrm(ks[8], (L, DIFF_HEAD_DIM), 0.1),
        'diff_lambda_q2': nrm(ks[9], (L, DIFF_HEAD_DIM), 0.1),
        'diff_lambda_k2': nrm(ks[10], (L, DIFF_HEAD_DIM), 0.1),
        'diff_subln_gain': 1.0 + nrm(ks[11], (L, DIFF_V_DIM), 0.02),
        'ret_decay_logit': logit[None, None, :] + nrm(ks[12], (L, 2, RET_HEADS), 0.1),
        'ret_norm_gain': 1.0 + nrm(ks[13], (L, RET_WIDTH), 0.02),
        'w_out': nrm(ks[14], (L, MIX_WIDTH, D), MIX_WIDTH ** -0.5),
        'g_pre_ffn': 1.0 + nrm(ks[15], (L, D), 0.02),
        'g_post_ffn': 1.0 + nrm(ks[16], (L, D), 0.02),
        'w_router': nrm(ks[17], (L, D, E), D ** -0.5),
        'w_gate': nrm(ks[18], (L, E, D, F), D ** -0.5),
        'w_up': nrm(ks[19], (L, E, D, F), D ** -0.5),
        'w_down': nrm(ks[20], (L, E, F, D), F ** -0.5),
    }


def reference(x, c, positions, w_ada, b_ada, g_pre_mix, g_post_mix, w_in,
              diff_lambda_q1, diff_lambda_k1, diff_lambda_q2, diff_lambda_k2, diff_subln_gain,
              ret_decay_logit, ret_norm_gain, w_out, g_pre_ffn, g_post_ffn,
              w_router, w_gate, w_up, w_down):
    B, S, D = x.shape
    cos_d, sin_d = _rope_tables(positions, DIFF_HEAD_DIM)
    cos_r, sin_r = _rope_tables(positions, RET_QK_DIM)
    split_at = np.cumsum(SPLITS)[:-1].tolist()
    for l in range(DEPTH):
        lam_init = _lambda_init(l)
        mod = jnp.einsum('bd,de->be', jax.nn.silu(c), w_ada[l]) + b_ada[l]
        shift1, scale1, gate1, shift2, scale2, gate2 = jnp.split(mod[:, None, :], N_MOD, axis=-1)

        h = _rmsnorm(x, g_pre_mix[l]) * (1.0 + scale1) + shift1
        proj = jnp.einsum('bsd,dc->bsc', h, w_in[l])
        dq, dk, dv, rq, rk, rv, rg = jnp.split(proj, split_at, axis=-1)

        dq = _rope(dq.reshape(B, S, DIFF_HEADS, 2, DIFF_HEAD_DIM), cos_d, sin_d)
        dk = _rope(dk.reshape(B, S, DIFF_HEADS, 2, DIFF_HEAD_DIM), cos_d, sin_d)
        qs = dq.transpose(0, 2, 3, 1, 4)
        kss = dk.transpose(0, 2, 3, 1, 4)
        vd = dv.reshape(B, S, DIFF_HEADS, DIFF_V_DIM).transpose(0, 2, 1, 3)
        lam = (jnp.exp(jnp.sum(diff_lambda_q1[l].astype(jnp.float32) * diff_lambda_k1[l].astype(jnp.float32)))
               - jnp.exp(jnp.sum(diff_lambda_q2[l].astype(jnp.float32) * diff_lambda_k2[l].astype(jnp.float32)))
               + lam_init)
        ad = _diff_attention(qs, kss, vd, lam)
        ad = _rmsnorm(ad, diff_subln_gain[l]) * (1.0 - lam_init)
        ad = ad.transpose(0, 2, 1, 3).reshape(B, S, DIFF_WIDTH)

        rq = _rope(rq.reshape(B, S, RET_HEADS, RET_QK_DIM), cos_r, sin_r).transpose(0, 2, 1, 3)
        rk = _rope(rk.reshape(B, S, RET_HEADS, RET_QK_DIM), cos_r, sin_r).transpose(0, 2, 1, 3)
        rk = rk * (RET_QK_DIM ** -0.5)
        rvv = rv.reshape(B, S, RET_HEADS, RET_V_DIM).transpose(0, 2, 1, 3)
        gammas = jax.nn.sigmoid(ret_decay_logit[l].astype(jnp.float32))
        ro = _bidirectional_retention(rq, rk, rvv, gammas[0], gammas[1])
        ro = _head_layernorm(ro, ret_norm_gain[l]).transpose(0, 2, 1, 3).reshape(B, S, RET_WIDTH)
        ro = jax.nn.silu(rg) * ro

        mix = jnp.einsum('bsc,cd->bsd', jnp.concatenate([ad, ro], axis=-1), w_out[l])
        x = x + gate1 * _rmsnorm(mix, g_post_mix[l])

        h = _rmsnorm(x, g_pre_ffn[l]) * (1.0 + scale2) + shift2
        ff = _expert_choice_ffn(h, w_router[l], w_gate[l], w_up[l], w_down[l])
        x = x + gate2 * _rmsnorm(ff, g_post_ffn[l])
    return x
```

```cpp
#include <hip/hip_runtime.h>
#include <cstdio>
#include <cstdint>

#ifndef OPT_IN
#define OPT_IN 1
#endif
#ifndef OPT_OUT
#define OPT_OUT 1
#endif
#ifndef OPT_E1
#define OPT_E1 1
#endif
#ifndef OPT_E2
#define OPT_E2 1
#endif
#ifndef OPT_ATTN
#define OPT_ATTN 1
#endif
#ifndef OPT_RET
#define OPT_RET 1
#endif
#ifndef F8_E1
#define F8_E1 1
#endif
#ifndef F8_E2
#define F8_E2 1
#endif
#ifndef F8_Y
#define F8_Y 1
#endif
#ifndef F8_IN
#define F8_IN 1
#endif
#ifndef EXP_F8
#define EXP_F8 (F8_E1 || F8_E2)
#endif
#ifndef REP_CONV
#define REP_CONV 1
#endif
#ifndef REP_IN
#define REP_IN 1
#endif
#ifndef REP_ATTN
#define REP_ATTN 1
#endif
#ifndef REP_E1
#define REP_E1 1
#endif
#ifndef REP_MISC
#define REP_MISC 1
#endif
#ifndef REP_SLICE
#define REP_SLICE 1
#endif
#ifndef REP_PRENORM
#define REP_PRENORM 1
#endif
#ifndef REP_ROWPASS
#define REP_ROWPASS 1
#endif
#ifndef REP_FINAL
#define REP_FINAL 1
#endif
#ifndef REP_RETOUT
#define REP_RETOUT 1
#endif
#ifndef REP_STATE
#define REP_STATE 1
#endif
#ifndef REP_TOPK
#define REP_TOPK 1
#endif
#ifndef REP_PREP
#define REP_PREP 1
#endif


constexpr int D = 2048, NB = 4, S = 4096, M = NB * S;
constexpr int NCOL = 7168;
constexpr int NE = 16, CAP = 512, FF = 2048;
constexpr int NH = 8;
constexpr float NORM_EPS = 1e-6f;
constexpr float LAM_INIT = 0.2f;
constexpr float QSCALE = 0.125f * 1.4426950408889634f;
constexpr float RKSCALE = 0.08838834764831845f;

constexpr size_t MiB = 1u << 20;
constexpr size_t WS_CTL = 0, CTL_ZERO_BYTES = 32768;
constexpr size_t WS_MOD = 1 * MiB;
constexpr int MOD_HALF = 4 * 6 * 2048;
constexpr size_t WS_AFF = 2 * MiB;
constexpr size_t WS_ROWMAP = 3 * MiB;
constexpr size_t WS_GATEV = 3 * MiB + 256 * 1024;
constexpr size_t WS_SEL = 4 * MiB;
constexpr size_t WS_ROPED = 6 * MiB;
constexpr size_t WS_ROPER = 10 * MiB;
constexpr size_t WS_WINT = 20 * MiB;
constexpr size_t WS_WOUTT = 48 * MiB;
constexpr size_t WS_W1T = 56 * MiB;
constexpr size_t WS_W2T = 312 * MiB;
constexpr size_t WS_H = 440 * MiB;
constexpr size_t WS_QD = 504 * MiB;
constexpr size_t WS_KD = 536 * MiB;
constexpr size_t WS_VD = 568 * MiB;
constexpr size_t WS_RQ = 600 * MiB;
constexpr size_t WS_RK = 632 * MiB;
constexpr size_t WS_RV = 664 * MiB;
constexpr size_t WS_RG = 696 * MiB;
constexpr size_t WS_HID = 504 * MiB;
constexpr size_t WS_ST = 728 * MiB;
constexpr size_t WS_MIXIN = 792 * MiB;
constexpr size_t WS_Y = 728 * MiB;
constexpr size_t WS_MIX = 856 * MiB;
constexpr size_t WS_X1 = 920 * MiB;
constexpr size_t WS_END = 1048 * MiB;
constexpr size_t WS_ON = WS_X1;
constexpr size_t WS_RAW = WS_MIX;

typedef unsigned short bf16_t;
typedef float f32x4 __attribute__((ext_vector_type(4)));
typedef float f32x2 __attribute__((ext_vector_type(2)));
typedef unsigned u32x4 __attribute__((ext_vector_type(4)));
typedef unsigned u32x2 __attribute__((ext_vector_type(2)));
#define DI __device__ __forceinline__

DI int lane_fresh() { int l; asm volatile("v_mbcnt_lo_u32_b32 %0, -1, 0\n\tv_mbcnt_hi_u32_b32 %0, -1, %0" : "=v"(l)); return l; }
DI int tid_fresh(int wave) { return wave * 64 + lane_fresh(); }
DI float bf2f(bf16_t v) { return __uint_as_float((unsigned)v << 16); }
DI float bflo(unsigned w) { return __uint_as_float(w << 16); }
DI float bfhi(unsigned w) { return __uint_as_float(w & 0xffff0000u); }
DI unsigned f2bf(float f) { unsigned u = __float_as_uint(f); return (u + 0x7fffu + ((u >> 16) & 1u)) >> 16; }
DI unsigned pk2(float lo, float hi) { unsigned r; asm("v_cvt_pk_bf16_f32 %0, %1, %2" : "=v"(r) : "v"(lo), "v"(hi)); return r; }
DI unsigned pk4_f8(float a, float b, float c, float d) {
    a = __builtin_amdgcn_fmed3f(a, -448.f, 448.f); b = __builtin_amdgcn_fmed3f(b, -448.f, 448.f); c = __builtin_amdgcn_fmed3f(c, -448.f, 448.f); d = __builtin_amdgcn_fmed3f(d, -448.f, 448.f);
    int w = __builtin_amdgcn_cvt_pk_fp8_f32(a, b, 0, false); w = __builtin_amdgcn_cvt_pk_fp8_f32(c, d, w, true); return (unsigned)w; }
constexpr float F8_WSCALE = 512.f, F8_HSCALE = 8.f, F8_HIDSCALE = 4.f, F8_YSCALE = 64.f;
constexpr int F8_WSCL = 0x76767676, F8_HSCL = 0x7C7C7C7C, F8_HIDSCL = 0x7D7D7D7D;
DI float silu_f(float v) { return v * __builtin_amdgcn_rcpf(1.f + __builtin_amdgcn_exp2f(-1.4426950408889634f * v)); }
DI float wave_sum(float v) {
    v += __builtin_bit_cast(float, __builtin_amdgcn_mov_dpp(__builtin_bit_cast(int, v), 0xB1, 0xF, 0xF, true));
    v += __builtin_bit_cast(float, __builtin_amdgcn_mov_dpp(__builtin_bit_cast(int, v), 0x4E, 0xF, 0xF, true));
    v += __builtin_bit_cast(float, __builtin_amdgcn_mov_dpp(__builtin_bit_cast(int, v), 0x141, 0xF, 0xF, true));
    v += __builtin_bit_cast(float, __builtin_amdgcn_mov_dpp(__builtin_bit_cast(int, v), 0x140, 0xF, 0xF, true));
    v += __builtin_bit_cast(float, __builtin_amdgcn_ds_swizzle(__builtin_bit_cast(int, v), 0x401F));
    { auto rr = __builtin_amdgcn_permlane32_swap(__float_as_uint(v), __float_as_uint(v), false, false); v = __uint_as_float(rr[0]) + __uint_as_float(rr[1]); }
    return v;
}

struct Args {
    const void* in[22];
    float* out;
    unsigned char* ws;
    int ph_lo, ph_hi;
};
enum { I_X = 0, I_C, I_POS, I_WADA, I_BADA, I_GPREMIX, I_GPOSTMIX, I_WIN, I_LQ1, I_LK1, I_LQ2, I_LK2, I_SUBLN, I_DECAY, I_RETG, I_WOUT, I_GPREFFN, I_GPOSTFFN, I_WROUTER, I_WGATE, I_WUP, I_WDOWN };

__host__ __device__ __forceinline__ int src_col_in(int n) {
    const int sec = n >> 10, r = n & 1023;
    if (sec <= 1) { const int g = r >> 6, j = r & 63; return (sec << 10) + (g << 6) + (j >> 1) + ((j & 1) << 5); }
    if (sec == 3 || sec == 4) { const int g = r >> 7, j = r & 127; return (sec << 10) + (g << 7) + (j >> 1) + ((j & 1) << 6); }
    return n;
}

DI void epi_in8(unsigned char* ws, int row, int col0, const float (&v)[8]) {
    const int sec = col0 >> 10, r = col0 & 1023, b = row >> 12, s = row & 4095;
    float o[8];
    bf16_t* dst;
    if (sec <= 1) {
        const int hm = r >> 6, j0 = r & 63;
        const f32x4* rt = (const f32x4*)(ws + WS_ROPED + ((size_t)row * 32 + (j0 >> 1)) * 8);
        const f32x4 t0 = rt[0], t1 = rt[1];
        const float cs[4] = {t0[0], t0[2], t1[0], t1[2]}, sn[4] = {t0[1], t0[3], t1[1], t1[3]};
        const float sc = sec == 0 ? QSCALE : 1.f;
#pragma unroll
        for (int t = 0; t < 4; ++t) { const float x1 = v[2 * t], x2 = v[2 * t + 1]; o[2 * t] = (x1 * cs[t] - x2 * sn[t]) * sc; o[2 * t + 1] = (x2 * cs[t] + x1 * sn[t]) * sc; }
        dst = (bf16_t*)(ws + (sec == 0 ? WS_QD : WS_KD)) + (((size_t)(b * 16 + hm) * S + s) * 64 + j0);
    } else if (sec == 3 || sec == 4) {
        const int h = r >> 7, j0 = r & 127;
        const f32x4* rt = (const f32x4*)(ws + WS_ROPER + ((size_t)row * 64 + (j0 >> 1)) * 8);
        const f32x4 t0 = rt[0], t1 = rt[1];
        const float cs[4] = {t0[0], t0[2], t1[0], t1[2]}, sn[4] = {t0[1], t0[3], t1[1], t1[3]};
        const float sc = sec == 4 ? RKSCALE : 1.f;
#pragma unroll
        for (int t = 0; t < 4; ++t) { const float x1 = v[2 * t], x2 = v[2 * t + 1]; o[2 * t] = (x1 * cs[t] - x2 * sn[t]) * sc; o[2 * t + 1] = (x2 * cs[t] + x1 * sn[t]) * sc; }
        dst = (bf16_t*)(ws + (sec == 3 ? WS_RQ : WS_RK)) + (((size_t)(b * 8 + h) * S + s) * 128 + j0);
    } else if (sec == 6) {
#pragma unroll
        for (int t = 0; t < 8; ++t) o[t] = silu_f(v[t]);
        dst = (bf16_t*)(ws + WS_RG) + ((size_t)row * 1024 + r);
    } else {
        const int h = r >> 7, j0 = r & 127;
#pragma unroll
        for (int t = 0; t < 8; ++t) o[t] = v[t];
        dst = (bf16_t*)(ws + (sec == 2 ? WS_VD : WS_RV)) + (((size_t)(b * 8 + h) * S + s) * 128 + j0);
    }
    u32x4 w; w.x = pk2(o[0], o[1]); w.y = pk2(o[2], o[3]); w.z = pk2(o[4], o[5]); w.w = pk2(o[6], o[7]);
    *(u32x4*)dst = w;
}
DI bool epi_in_is_rope(int col0) { const int sec = col0 >> 10; return sec <= 1 || sec == 3 || sec == 4; }
DI void epi_in_table(const unsigned char* ws, int row, int col0, f32x4& t0, f32x4& t1) {
    const int sec = col0 >> 10, r = col0 & 1023;
    const f32x4* rt = sec <= 1 ? (const f32x4*)(ws + WS_ROPED + ((size_t)row * 32 + ((r & 63) >> 1)) * 8) : (const f32x4*)(ws + WS_ROPER + ((size_t)row * 64 + ((r & 127) >> 1)) * 8);
    t0 = rt[0]; t1 = rt[1];
}
DI void epi_in8_rope(unsigned char* ws, int row, int col0, const float (&v)[8], const f32x4 t0, const f32x4 t1) {
    const int sec = col0 >> 10, r = col0 & 1023, b = row >> 12, s = row & 4095;
    float o[8];
    const float cs[4] = {t0[0], t0[2], t1[0], t1[2]}, sn[4] = {t0[1], t0[3], t1[1], t1[3]};
    const float sc = sec == 0 ? QSCALE : (sec == 4 ? RKSCALE : 1.f);
#pragma unroll
    for (int t = 0; t < 4; ++t) { const float x1 = v[2 * t], x2 = v[2 * t + 1]; o[2 * t] = (x1 * cs[t] - x2 * sn[t]) * sc; o[2 * t + 1] = (x2 * cs[t] + x1 * sn[t]) * sc; }
    bf16_t* dst;
    if (sec <= 1) { const int hm = r >> 6, j0 = r & 63; dst = (bf16_t*)(ws + (sec == 0 ? WS_QD : WS_KD)) + (((size_t)(b * 16 + hm) * S + s) * 64 + j0); }
    else { const int h = r >> 7, j0 = r & 127; dst = (bf16_t*)(ws + (sec == 3 ? WS_RQ : WS_RK)) + (((size_t)(b * 8 + h) * S + s) * 128 + j0); }
    u32x4 w; w.x = pk2(o[0], o[1]); w.y = pk2(o[2], o[3]); w.z = pk2(o[4], o[5]); w.w = pk2(o[6], o[7]);
    *(u32x4*)dst = w;
}
DI void store8_bf16(bf16_t* dst, const float (&o)[8]) {
    u32x4 w; w.x = pk2(o[0], o[1]); w.y = pk2(o[2], o[3]); w.z = pk2(o[4], o[5]); w.w = pk2(o[6], o[7]);
    *(u32x4*)dst = w;
}

struct EpiIn  { unsigned char* ws; DI void operator()(int row, int col0, const float (&v)[8], const float (&)[8]) const { epi_in8(ws, row, col0, v); } };
struct EpiOut { unsigned char* ws; DI void operator()(int row, int col0, const float (&v)[8], const float (&)[8]) const { store8_bf16((bf16_t*)(ws + WS_MIX) + (size_t)row * D + col0, v); } };
struct EpiE1  { unsigned char* ws; DI void operator()(int row, int col0, const float (&g)[8], const float (&u)[8]) const {
    float o[8];
#pragma unroll
    for (int t = 0; t < 8; ++t) o[t] = silu_f(g[t]) * u[t];
    store8_bf16((bf16_t*)(ws + WS_HID) + (size_t)row * FF + col0, o); } };
struct EpiE2  { unsigned char* ws; DI void operator()(int row, int col0, const float (&v)[8], const float (&)[8]) const {
    const float gt = ((const float*)(ws + WS_GATEV))[row]; float o[8];
#pragma unroll
    for (int t = 0; t < 8; ++t) o[t] = v[t] * gt;
    store8_bf16((bf16_t*)(ws + WS_Y) + (size_t)row * D + col0, o); } };

template <class Epi, bool DUAL, bool PERMIN>
__global__ void __launch_bounds__(256) k_gemm_naive(const bf16_t* __restrict__ A, int lda, const int* __restrict__ rowmap, const float* __restrict__ Bm, const float* __restrict__ B2m,
                                                     int ldb, int K, int Mz, long zB, Epi epi) {
    __shared__ __attribute__((aligned(16))) float As[16][68];
    __shared__ __attribute__((aligned(16))) float Bs[16][128];
    __shared__ __attribute__((aligned(16))) float B2s[DUAL ? 16 : 1][128];
    const int t = threadIdx.x, tx = t & 15, ty = t >> 4, z = blockIdx.z;
    const int n0 = blockIdx.x * 128, r0 = blockIdx.y * 64;
    const float* B = Bm + (size_t)z * zB; const float* B2 = DUAL ? B2m + (size_t)z * zB : nullptr;
    const int ar = t >> 2, akq = t & 3;
    const int grow = z * Mz + r0 + ar;
    const size_t arow = rowmap ? (size_t)rowmap[grow] : (size_t)grow;
    const bf16_t* ap = A + arow * lda + akq * 4;
    const int bk = t >> 4, bcg = t & 15;
    int scol[8];
#pragma unroll
    for (int j = 0; j < 8; ++j) scol[j] = PERMIN ? src_col_in(n0 + bcg * 8 + j) : (n0 + bcg * 8 + j);
    float acc[4][8], acc2[4][8];
#pragma unroll
    for (int i = 0; i < 4; ++i)
#pragma unroll
        for (int j = 0; j < 8; ++j) { acc[i][j] = 0.f; acc2[i][j] = 0.f; }
    for (int k0 = 0; k0 < K; k0 += 16) {
        const u32x2 av = *(const u32x2*)(ap + k0);
        float bv[8], bv2[8];
#pragma unroll
        for (int j = 0; j < 8; ++j) { bv[j] = B[(size_t)(k0 + bk) * ldb + scol[j]]; if (DUAL) bv2[j] = B2[(size_t)(k0 + bk) * ldb + scol[j]]; }
        __syncthreads();
        As[akq * 4 + 0][ar] = bflo(av.x); As[akq * 4 + 1][ar] = bfhi(av.x); As[akq * 4 + 2][ar] = bflo(av.y); As[akq * 4 + 3][ar] = bfhi(av.y);
#pragma unroll
        for (int j = 0; j < 8; ++j) { Bs[bk][bcg * 8 + j] = bv[j]; if (DUAL) B2s[bk][bcg * 8 + j] = bv2[j]; }
        __syncthreads();
#pragma unroll
        for (int kk = 0; kk < 16; ++kk) {
            const f32x4 a4 = *(const f32x4*)&As[kk][ty * 4];
            const f32x4 b0 = *(const f32x4*)&Bs[kk][tx * 8], b1 = *(const f32x4*)&Bs[kk][tx * 8 + 4];
            const float bb[8] = {b0[0], b0[1], b0[2], b0[3], b1[0], b1[1], b1[2], b1[3]};
#pragma unroll
            for (int i = 0; i < 4; ++i)
#pragma unroll
                for (int j = 0; j < 8; ++j) acc[i][j] += a4[i] * bb[j];
            if (DUAL) {
                const f32x4 c0 = *(const f32x4*)&B2s[kk][tx * 8], c1 = *(const f32x4*)&B2s[kk][tx * 8 + 4];
                const float cc[8] = {c0[0], c0[1], c0[2], c0[3], c1[0], c1[1], c1[2], c1[3]};
#pragma unroll
                for (int i = 0; i < 4; ++i)
#pragma unroll
                    for (int j = 0; j < 8; ++j) acc2[i][j] += a4[i] * cc[j];
            }
        }
    }
#pragma unroll
    for (int i = 0; i < 4; ++i) epi(z * Mz + r0 + ty * 4 + i, n0 + tx * 8, acc[i], acc2[i]);
}

__global__ void __launch_bounds__(256) k_attn_naive(const bf16_t* __restrict__ QD, const bf16_t* __restrict__ KD, const bf16_t* __restrict__ VD, float* __restrict__ On) {
    __shared__ __attribute__((aligned(16))) bf16_t Ks[32][64];
    __shared__ __attribute__((aligned(16))) bf16_t Vs[32][128];
    const int t = threadIdx.x, bid = blockIdx.x, qb = bid & 15, bhm = bid >> 4, bh = bhm >> 1;
    const int s = qb * 256 + t;
    float q[64], o[128];
    {
        const u32x4* qp = (const u32x4*)(QD + ((size_t)bhm * S + s) * 64);
#pragma unroll
        for (int c = 0; c < 8; ++c) { const u32x4 w = qp[c]; q[8 * c] = bflo(w.x); q[8 * c + 1] = bfhi(w.x); q[8 * c + 2] = bflo(w.y); q[8 * c + 3] = bfhi(w.y); q[8 * c + 4] = bflo(w.z); q[8 * c + 5] = bfhi(w.z); q[8 * c + 6] = bflo(w.w); q[8 * c + 7] = bfhi(w.w); }
    }
#pragma unroll
    for (int e = 0; e < 128; ++e) o[e] = 0.f;
    float mx = -1e30f, l = 0.f;
    for (int m0 = 0; m0 < S; m0 += 32) {
        __syncthreads();
        *(u32x4*)&Ks[t >> 3][(t & 7) * 8] = *(const u32x4*)(KD + ((size_t)bhm * S + m0 + (t >> 3)) * 64 + (t & 7) * 8);
#pragma unroll
        for (int i = 0; i < 2; ++i) { const int idx = t + 256 * i, row = idx >> 4, ch = idx & 15; *(u32x4*)&Vs[row][ch * 8] = *(const u32x4*)(VD + ((size_t)bh * S + m0 + row) * 128 + ch * 8); }
        __syncthreads();
        for (int mm = 0; mm < 32; ++mm) {
            float sc = 0.f;
#pragma unroll
            for (int c = 0; c < 8; ++c) { const u32x4 w = *(const u32x4*)&Ks[mm][c * 8];
                sc += q[8 * c] * bflo(w.x) + q[8 * c + 1] * bfhi(w.x) + q[8 * c + 2] * bflo(w.y) + q[8 * c + 3] * bfhi(w.y) + q[8 * c + 4] * bflo(w.z) + q[8 * c + 5] * bfhi(w.z) + q[8 * c + 6] * bflo(w.w) + q[8 * c + 7] * bfhi(w.w); }
            if (sc > mx) { const float f = exp2f(mx - sc); l *= f;
#pragma unroll
                for (int e = 0; e < 128; ++e) o[e] *= f;
                mx = sc; }
            const float p = exp2f(sc - mx); l += p;
#pragma unroll
            for (int c = 0; c < 16; ++c) { const u32x4 w = *(const u32x4*)&Vs[mm][c * 8];
                o[8 * c] += p * bflo(w.x); o[8 * c + 1] += p * bfhi(w.x); o[8 * c + 2] += p * bflo(w.y); o[8 * c + 3] += p * bfhi(w.y); o[8 * c + 4] += p * bflo(w.z); o[8 * c + 5] += p * bfhi(w.z); o[8 * c + 6] += p * bflo(w.w); o[8 * c + 7] += p * bfhi(w.w); }
        }
    }
    const float rl = 1.f / l;
    f32x4* op = (f32x4*)(On + ((size_t)bhm * S + s) * 128);
#pragma unroll
    for (int c = 0; c < 32; ++c) op[c] = (f32x4){o[4 * c] * rl, o[4 * c + 1] * rl, o[4 * c + 2] * rl, o[4 * c + 3] * rl};
}
DI float diff_lambda(const float* lq1, const float* lk1, const float* lq2, const float* lk2, int lane) {
    const float a = wave_sum(lq1[lane] * lk1[lane]), b = wave_sum(lq2[lane] * lk2[lane]);
    return __expf(a) - __expf(b) + LAM_INIT;
}
__global__ void __launch_bounds__(256) k_attn_combine(const float* __restrict__ On, const float* lq1, const float* lk1, const float* lq2, const float* lk2, const float* __restrict__ gain, bf16_t* __restrict__ MIXIN) {
    const int lane = threadIdx.x & 63, w = blockIdx.x * 4 + (threadIdx.x >> 6);
    const int bh = w >> 12, s = w & 4095, b = bh >> 3, h = bh & 7;
    const float lam = diff_lambda(lq1, lk1, lq2, lk2, lane);
    const f32x2 o1 = *(const f32x2*)(On + ((size_t)(bh * 2 + 0) * S + s) * 128 + 2 * lane), o2 = *(const f32x2*)(On + ((size_t)(bh * 2 + 1) * S + s) * 128 + 2 * lane);
    const float v0 = o1.x - lam * o2.x, v1 = o1.y - lam * o2.y;
    const float ss = wave_sum(v0 * v0 + v1 * v1);
    const float rs = rsqrtf(ss * (1.f / 128.f) + NORM_EPS) * (1.f - LAM_INIT);
    *(unsigned*)(MIXIN + ((size_t)(b * S + s)) * D + h * 128 + 2 * lane) = pk2(v0 * rs * gain[2 * lane], v1 * rs * gain[2 * lane + 1]);
}
__global__ void __launch_bounds__(256) k_ret_naive(const bf16_t* __restrict__ RQ, const bf16_t* __restrict__ RK, const bf16_t* __restrict__ RV, const float* __restrict__ logit, float* __restrict__ Oraw) {
    __shared__ __attribute__((aligned(16))) bf16_t Ks[32][128];
    __shared__ __attribute__((aligned(16))) bf16_t Vs[32][64];
    const int t = threadIdx.x, bid = blockIdx.x, sb = bid & 15, hf = (bid >> 4) & 1, bh = bid >> 5, h = bh & 7;
    const int s = sb * 256 + t;
    const float gf = 1.f / (1.f + __expf(-logit[h])), gb = 1.f / (1.f + __expf(-logit[8 + h]));
    const float lgf = log2f(gf), lgb = log2f(gb);
    float q[128], o[64];
    {
        const u32x4* qp = (const u32x4*)(RQ + ((size_t)bh * S + s) * 128);
#pragma unroll
        for (int c = 0; c < 16; ++c) { const u32x4 w = qp[c]; q[8 * c] = bflo(w.x); q[8 * c + 1] = bfhi(w.x); q[8 * c + 2] = bflo(w.y); q[8 * c + 3] = bfhi(w.y); q[8 * c + 4] = bflo(w.z); q[8 * c + 5] = bfhi(w.z); q[8 * c + 6] = bflo(w.w); q[8 * c + 7] = bfhi(w.w); }
    }
#pragma unroll
    for (int e = 0; e < 64; ++e) o[e] = 0.f;
    for (int m0 = 0; m0 < S; m0 += 32) {
        __syncthreads();
#pragma unroll
        for (int i = 0; i < 2; ++i) { const int idx = t + 256 * i, row = idx >> 4, ch = idx & 15; *(u32x4*)&Ks[row][ch * 8] = *(const u32x4*)(RK + ((size_t)bh * S + m0 + row) * 128 + ch * 8); }
        *(u32x4*)&Vs[t >> 3][(t & 7) * 8] = *(const u32x4*)(RV + ((size_t)bh * S + m0 + (t >> 3)) * 128 + hf * 64 + (t & 7) * 8);
        __syncthreads();
        for (int mm = 0; mm < 32; ++mm) {
            float sc = 0.f;
#pragma unroll
            for (int c = 0; c < 16; ++c) { const u32x4 w = *(const u32x4*)&Ks[mm][c * 8];
                sc += q[8 * c] * bflo(w.x) + q[8 * c + 1] * bfhi(w.x) + q[8 * c + 2] * bflo(w.y) + q[8 * c + 3] * bfhi(w.y) + q[8 * c + 4] * bflo(w.z) + q[8 * c + 5] * bfhi(w.z) + q[8 * c + 6] * bflo(w.w) + q[8 * c + 7] * bfhi(w.w); }
            const int dist = s - (m0 + mm);
            const float dec = dist >= 0 ? exp2f((float)dist * lgf) : exp2f((float)(-dist) * lgb);
            const float p = sc * dec;
#pragma unroll
            for (int c = 0; c < 8; ++c) { const u32x4 w = *(const u32x4*)&Vs[mm][c * 8];
                o[8 * c] += p * bflo(w.x); o[8 * c + 1] += p * bfhi(w.x); o[8 * c + 2] += p * bflo(w.y); o[8 * c + 3] += p * bfhi(w.y); o[8 * c + 4] += p * bflo(w.z); o[8 * c + 5] += p * bfhi(w.z); o[8 * c + 6] += p * bflo(w.w); o[8 * c + 7] += p * bfhi(w.w); }
        }
    }
    f32x4* op = (f32x4*)(Oraw + ((size_t)bh * S + s) * 128 + hf * 64);
#pragma unroll
    for (int c = 0; c < 16; ++c) op[c] = (f32x4){o[4 * c], o[4 * c + 1], o[4 * c + 2], o[4 * c + 3]};
}
__global__ void __launch_bounds__(256) k_ret_norm(const float* __restrict__ Oraw, const float* __restrict__ gain, const bf16_t* __restrict__ RG, bf16_t* __restrict__ MIXIN) {
    const int lane = threadIdx.x & 63, w = blockIdx.x * 4 + (threadIdx.x >> 6);
    const int bh = w >> 12, s = w & 4095, b = bh >> 3, h = bh & 7;
    const f32x2 v = *(const f32x2*)(Oraw + ((size_t)bh * S + s) * 128 + 2 * lane);
    const float mu = wave_sum(v.x + v.y) * (1.f / 128.f);
    const float d0 = v.x - mu, d1 = v.y - mu;
    const float var = wave_sum(d0 * d0 + d1 * d1) * (1.f / 128.f);
    const float rs = rsqrtf(var + NORM_EPS);
    const size_t tok = (size_t)b * S + s;
    const unsigned g = *(const unsigned*)(RG + tok * 1024 + h * 128 + 2 * lane);
    *(unsigned*)(MIXIN + tok * D + 1024 + h * 128 + 2 * lane) = pk2(d0 * rs * gain[h * 128 + 2 * lane] * bflo(g), d1 * rs * gain[h * 128 + 2 * lane + 1] * bfhi(g));
}

#define XB_TMO      128
#define XB_XCNT(j)  (256  + 64 * (j))
#define XB_XSUB(j)  (1280 + 64 * (j))
#define XB_XGEN(j)  (2304 + 64 * (j))
#define XB_TOP      3328
#define XB_TOPGEN   3392
#define XCD_BAR_WORDS 3456
#define XB_SPIN_CAP (1u << 18)
#define LAS __attribute__((address_space(3)))
#define GAS __attribute__((address_space(1)))

__device__ __forceinline__ unsigned xb_ld(unsigned* p)              { return __hip_atomic_load(p, __ATOMIC_RELAXED, __HIP_MEMORY_SCOPE_AGENT); }
__device__ __forceinline__ unsigned xb_add(unsigned* p, unsigned v) { return __hip_atomic_fetch_add(p, v, __ATOMIC_RELAXED, __HIP_MEMORY_SCOPE_AGENT); }
__device__ __forceinline__ unsigned xb_xcc_id() { return (unsigned)__builtin_amdgcn_s_getreg((3 << 11) | 20) & 0xFu; }
#define XB_SPIN(cond, bar) do { unsigned _sp = 0; while (cond) { __builtin_amdgcn_s_sleep(1); \
    if ((++_sp & 255u) == 0u) { if (xb_ld(&(bar)[XB_TMO])) break; if (_sp > XB_SPIN_CAP) { atomicAdd(&(bar)[XB_TMO], 1u); break; } } } } while (0)

struct XcdBarrier {
    unsigned* bar; unsigned x;
    volatile LAS unsigned* st;
    int wave;
};
__device__ __forceinline__ bool xb_leader(int wave) { return wave == 0 && lane_fresh() == 0; }
__device__ __forceinline__ XcdBarrier xcd_barrier_post(unsigned* bar, volatile LAS unsigned* st, int wave) {
    XcdBarrier b; b.bar = bar; b.x = xb_xcc_id(); b.st = st; b.wave = wave;
    if (xb_leader(wave)) (void)xb_add(&bar[XB_XCNT(b.x)], 1u);
    return b;
}
__device__ __forceinline__ void xcd_barrier_complete(unsigned* bar, unsigned x, unsigned& nloc, unsigned& nx) {
    const unsigned G = gridDim.x * gridDim.y * gridDim.z;
    unsigned sum, cnt, mine, sp = 0u;
    for (;;) {
        sum = 0u; cnt = 0u; mine = 0u;
#pragma unroll
        for (unsigned j = 0; j < 16; ++j) { const unsigned c = xb_ld(&bar[XB_XCNT(j)]); sum += c; cnt += (c > 0u) ? 1u : 0u; mine = (j == x) ? c : mine; }
        if (sum == G) break;
        __builtin_amdgcn_s_sleep(1);
        if ((++sp & 255u) == 0u) { if (xb_ld(&bar[XB_TMO])) break; if (sp > XB_SPIN_CAP) { atomicAdd(&bar[XB_TMO], 1u); break; } }
    }
    nloc = mine > 0u ? mine : 1u; nx = cnt > 0u ? cnt : 1u;
}
__device__ __forceinline__ void xcd_barrier(const XcdBarrier& b) {
    asm volatile("s_waitcnt vmcnt(0)" ::: "memory");
    __syncthreads();
    if (xb_leader(b.wave)) {
        unsigned* bar = b.bar;
        __builtin_amdgcn_s_waitcnt(0);
        unsigned nloc = b.st[0], nx = b.st[1];
        if (nloc == 0u) { xcd_barrier_complete(bar, b.x, nloc, nx); b.st[0] = nloc; b.st[1] = nx; }
        const unsigned old = xb_add(&bar[XB_XSUB(b.x)], 1u);
        const unsigned gen = old / nloc;
        if (old + 1u == (gen + 1u) * nloc) {
            __builtin_amdgcn_fence(__ATOMIC_RELEASE, "agent");
            asm volatile("s_waitcnt vmcnt(0)" ::: "memory");
            const unsigned og = xb_add(&bar[XB_TOP], 1u);
            const unsigned tg = og / nx;
            if (og + 1u == (tg + 1u) * nx) xb_add(&bar[XB_TOPGEN], 1u);
            else XB_SPIN(xb_ld(&bar[XB_TOPGEN]) == tg, bar);
            __builtin_amdgcn_fence(__ATOMIC_ACQUIRE, "agent");
            xb_add(&bar[XB_XGEN(b.x)], 1u);
            asm volatile("s_waitcnt vmcnt(0)" ::: "memory");
        } else {
            XB_SPIN(xb_ld(&bar[XB_XGEN(b.x)]) == gen, bar);
            __builtin_amdgcn_fence(__ATOMIC_ACQUIRE, "agent");
            asm volatile("s_waitcnt vmcnt(0)" ::: "memory");
        }
    }
    __syncthreads();
}


namespace pg8 {
#define PG8_LAS __attribute__((address_space(3)))
typedef short bf16x8 __attribute__((ext_vector_type(8)));
typedef int v4i_t __attribute__((ext_vector_type(4)));
typedef int v8i_t __attribute__((ext_vector_type(8)));
constexpr int BM = 256, BK = 64, HALF = 128, HTB = HALF * BK * 2, STAGE_BYTES = 8 * HTB, NXCD = 8, WGM = 8;
__host__ __device__ __forceinline__ int lds_byte(int r, int c) { const int st = (r >> 4) * 2 + (c >> 5), rr = r & 15, cc = c & 31, ob = rr * 64 + cc * 2; return st * 1024 + (ob ^ (((ob >> 9) & 1) << 5)); }
__host__ __device__ __forceinline__ void stage_rc(int b, int& R, int& C) { const int st = b / 1024, sb = b % 1024, swz = sb ^ (((sb >> 9) & 1) << 5); R = (st >> 1) * 16 + swz / 64; C = (st & 1) * 32 + (swz % 64) / 2; }
__host__ __device__ __forceinline__ int perm32(int rho) { const int n = rho >> 4, i = rho & 15; return 8 * (i >> 2) + 4 * n + (i & 3); }
__device__ __forceinline__ const char* uni(const char* p) { const unsigned long long v = (unsigned long long)p; const unsigned lo = __builtin_amdgcn_readfirstlane((unsigned)v), hi = __builtin_amdgcn_readfirstlane((unsigned)(v >> 32));
    return (const char*)(((unsigned long long)hi << 32) | lo); }
struct Unit { int pm, pn; };
struct Gemm { const bf16_t* A; const bf16_t* Bt; int K; };
struct StaticOrder {
    int nM, nN, nwg, G, c;
    __device__ void init(int M_, int N_, int G_, int c_) { nM = M_ / BM; nN = N_ / BM; nwg = nM * nN; G = G_; c = c_; }
    __device__ bool next(int i, Unit& u) const {
        const long L = (long)i * G + c; if (L >= nwg) return false;
        int wgid = (int)L; { const int q = nwg / NXCD, r = nwg % NXCD, xcd = wgid % NXCD, off = wgid / NXCD; wgid = (xcd < r ? xcd * (q + 1) : r * (q + 1) + (xcd - r) * q) + off; }
        const int nig = WGM * nN, gid = wgid / nig, fm = gid * WGM, gsz = (nM - fm) < WGM ? (nM - fm) : WGM;
        u.pm = fm + ((wgid % nig) % gsz); u.pn = (wgid % nig) / gsz; return true;
    }
};
template <int NPN> struct ExpertOrder {
    int G, c;
    __device__ void init(int G_, int c_) { G = G_; c = c_; }
    __device__ bool next(int i, Unit& u) const {
        constexpr int UPE = 8 * NPN, TOT = NE * UPE;
        if (G == 256) {
            constexpr int EPR = 256 / UPE, XPE = 8 / EPR;
            const int e = i * EPR + (c & 7) / XPE; if (e >= NE) return false;
            const int xx = (c & 7) % XPE, j = c >> 3;
            u.pm = e * 8 + (j & 7); u.pn = e * NPN + xx * 4 + (j >> 3); return true;
        }
        const long L = (long)i * G + c; if (L >= TOT) return false;
        const int e = (int)L / UPE, r = (int)L % UPE; u.pm = e * 8 + (r & 7); u.pn = e * NPN + (r >> 3); return true;
    }
};

template <class Epi, class Sched, bool GATHER, bool F8 = false, bool ALIGN_EPI = true, bool SP2 = true>
__device__ __forceinline__ void gemm_phase(PG8_LAS unsigned char* lds, const Gemm g, const Sched& S, const Epi& E, const PG8_LAS int* rmap, const int wave_s, const int sclB = 0x7F7F7F7F, const int sclA = 0x7F7F7F7F) {
    const int tid = tid_fresh(wave_s), wid = __builtin_amdgcn_readfirstlane(tid >> 6), lane = tid & 63, wr = wid >> 2, wc = wid & 3, fr = lane & 15, fq = lane >> 4;
    constexpr int ES = F8 ? 1 : 2;
    const int K = g.K, nt = K / (F8 ? 2 * BK : BK);
    unsigned voffA[2], voffB[2]; int stR[2], stC[2];
#pragma unroll
    for (int i = 0; i < 2; ++i) { int R, C; stage_rc(tid * 16 + i * 8192, R, C); const int Rb = Epi::PERM ? ((R & ~31) + perm32(R & 31)) : R;
        voffA[i] = (unsigned)(R * K * ES + C * 2); voffB[i] = (unsigned)(Rb * K * ES + C * 2); stR[i] = R; stC[i] = C; }
    const size_t kstep = (size_t)(BK * 2);
    const size_t hstep = (size_t)HALF * K * ES;
    const size_t tstep = 2 * hstep;
    const unsigned ldsw = (unsigned)wid * 1024u;
    const unsigned ldsb = (unsigned)__builtin_amdgcn_readfirstlane((unsigned)(size_t)lds + ldsw);
    const char* gA = F8 ? uni((const char*)g.A) : (const char*)g.A;
    const int fcol = F8 ? 32 * (fq >> 1) + 16 * (fq & 1) : fq * 8;
    const int aoff = lds_byte(wr * 64 + fr, fcol), boff = lds_byte(wc * 32 + fr, fcol);
#define PG8_SA(b, h) (((b) * 2 + (h)) * HTB)
#define PG8_SB(b, h) ((4 + (b) * 2 + (h)) * HTB)
#define PG8_GLDS(sbase, voff_, bufoff, i_) do { if constexpr (!F8) { __builtin_amdgcn_global_load_lds((const unsigned*)((sbase) + (voff_)), (PG8_LAS unsigned*)(lds + (bufoff) + ldsw + (i_) * 8192), 16, 0, 0); } else { asm volatile("s_mov_b32 m0, %2\n\ts_nop 0\n\tglobal_load_lds_dwordx4 %0, %1" \
        :: "v"(voff_), "s"(sbase), "s"(ldsb + (unsigned)((bufoff) + (i_) * 8192)) : "memory", "m0"); } } while (0)
#define PG8_STAGE(bufoff, gbase, voff) do { const char* sb_ = (gbase); _Pragma("unroll") for (int _i = 0; _i < 2; ++_i) PG8_GLDS(sb_, (voff)[_i], bufoff, _i); } while (0)
#define PG8_STAGE_A(bufoff, h, kb, NXT) do { if constexpr (GATHER) { const char* b_ = gA + (kb); const int sl_ = ((((NXT) ? uin : ui) & 1) * 4 + (h) * 2) * 512; \
            const unsigned o0_ = gofft[sl_], o1_ = gofft[sl_ + 512];     \
            PG8_GLDS(b_, o0_, bufoff, 0); PG8_GLDS(b_, o1_, bufoff, 1); } \
        else { const char* b_ = ((NXT) ? nA : cA) + (size_t)(h) * hstep + (kb); _Pragma("unroll") for (int _i = 0; _i < 2; ++_i) PG8_GLDS(b_, voffA[_i], bufoff, _i); } } while (0)
#define PG8_RD8(p_) __builtin_shufflevector(*(const PG8_LAS v4i_t*)(p_), *(const PG8_LAS v4i_t*)((p_) + 16), 0, 1, 2, 3, 4, 5, 6, 7)
#define PG8_LDA(dst, b, h) do { if constexpr (F8) { _Pragma("unroll") for (int m = 0; m < 4; ++m) dst##8[m] = PG8_RD8(lds + PG8_SA(b, h) + aoff + m * 2048); } else { \
        _Pragma("unroll") for (int m = 0; m < 4; ++m) _Pragma("unroll") for (int k = 0; k < 2; ++k) dst[m][k] = *(const PG8_LAS bf16x8*)(lds + PG8_SA(b, h) + aoff + m * 2048 + k * 1024); } } while (0)
#define PG8_LDB(dst, b, h) do { if constexpr (F8) { _Pragma("unroll") for (int n = 0; n < 2; ++n) dst##8[n] = PG8_RD8(lds + PG8_SB(b, h) + boff + n * 2048); } else { \
        _Pragma("unroll") for (int n = 0; n < 2; ++n) _Pragma("unroll") for (int k = 0; k < 2; ++k) dst[n][k] = *(const PG8_LAS bf16x8*)(lds + PG8_SB(b, h) + boff + n * 2048 + k * 1024); } } while (0)
#define PG8_MMA(ai, bj, At, Bt) do { __builtin_amdgcn_s_setprio(1); if constexpr (F8) { _Pragma("unroll") for (int m = 0; m < 4; ++m) _Pragma("unroll") for (int n = 0; n < 2; ++n) \
        acc[ai][bj][m][n] = __builtin_amdgcn_mfma_scale_f32_16x16x128_f8f6f4(Bt##8[n], At##8[m], acc[ai][bj][m][n], 0, 0, 0, sclB, 0, sclA); } else { \
        _Pragma("unroll") for (int m = 0; m < 4; ++m) _Pragma("unroll") for (int n = 0; n < 2; ++n) _Pragma("unroll") for (int k = 0; k < 2; ++k) \
        acc[ai][bj][m][n] = __builtin_amdgcn_mfma_f32_16x16x32_bf16(Bt[n][k], At[m][k], acc[ai][bj][m][n], 0, 0, 0); } __builtin_amdgcn_s_setprio(0); } while (0)
#define PG8_WAIT_V(n) asm volatile("s_waitcnt vmcnt(" #n ")" ::: "memory")
#define PG8_WAIT_L(n) asm volatile("s_waitcnt lgkmcnt(" #n ")" ::: "memory")
#define PG8_BAR __builtin_amdgcn_s_barrier()
#define PG8_SCHED __builtin_amdgcn_sched_barrier(0)
#define PG8_GOFF(dst, ui_) do { _Pragma("unroll") for (int h_ = 0; h_ < 2; ++h_) _Pragma("unroll") for (int i_ = 0; i_ < 2; ++i_) dst[h_][i_] = (unsigned)rmap[(ui_) * 256 + h_ * 128 + stR[i_]] * (unsigned)(K * ES) + (unsigned)stC[i_] * 2u; } while (0)
    Unit cur, nxt; int ui = 0;
    if (!S.next(0, cur)) return;
    f32x4 acc[2][2][4][2];
#pragma unroll
    for (int a = 0; a < 2; ++a)
#pragma unroll
        for (int b = 0; b < 2; ++b)
#pragma unroll
            for (int m = 0; m < 4; ++m)
#pragma unroll
                for (int n = 0; n < 2; ++n) acc[a][b][m][n] = (f32x4){0.f, 0.f, 0.f, 0.f};
    bf16x8 At[4][2], B0[2][2], B1[2][2];
    v8i_t At8[4], B08[2], B18[2];
    int uin = 0;
    PG8_LAS unsigned* gofft = (PG8_LAS unsigned*)((PG8_LAS unsigned char*)rmap + 8192) + tid;
#define PG8_GFILL(u_) do { const int tg_ = tid_fresh(wave_s); PG8_LAS unsigned* gt_ = (PG8_LAS unsigned*)((PG8_LAS unsigned char*)rmap + 8192) + tg_; \
        _Pragma("unroll") for (int i_ = 0; i_ < 2; ++i_) { int R_, C_; stage_rc(tg_ * 16 + i_ * 8192, R_, C_);     \
        _Pragma("unroll") for (int h_ = 0; h_ < 2; ++h_) gt_[((((u_) & 1) * 4 + h_ * 2 + i_)) * 512] = (unsigned)rmap[(u_) * 256 + h_ * 128 + R_] * (unsigned)(K * ES) + (unsigned)C_ * 2u; } } while (0)
    if constexpr (GATHER) { PG8_GFILL(0); }
#define PG8_UNI(x) (F8 ? uni(x) : (x))
    const char* cA = PG8_UNI((const char*)g.A + (size_t)cur.pm * tstep); const char* cB = PG8_UNI((const char*)g.Bt + (size_t)cur.pn * tstep);
    const char* nA = cA;
    if constexpr (SP2) {
        PG8_STAGE(PG8_SB(0, 0), cB, voffB); PG8_STAGE(PG8_SB(0, 1), cB + hstep, voffB); PG8_STAGE_A(PG8_SA(0, 0), 0, 0, false); PG8_STAGE_A(PG8_SA(0, 1), 1, 0, false);
        if (wr == 1) PG8_BAR;
        PG8_WAIT_V(2); PG8_BAR;
        PG8_STAGE(PG8_SB(1, 0), cB + kstep, voffB); PG8_STAGE_A(PG8_SA(1, 0), 0, kstep, false); PG8_STAGE(PG8_SB(1, 1), cB + hstep + kstep, voffB);
        PG8_WAIT_V(6); PG8_BAR;
    }
    for (;;) {
        const bool has_next = S.next(ui + 1, nxt);
        nA = PG8_UNI(has_next ? (const char*)g.A + (size_t)nxt.pm * tstep : cA); const char* nB = PG8_UNI(has_next ? (const char*)g.Bt + (size_t)nxt.pn * tstep : cB);
        uin = has_next ? ui + 1 : ui;
        if constexpr (GATHER) { if (has_next) { PG8_GFILL(ui + 1); } }
        for (int t = 0; t < nt; t += 2) {
            const bool last = (t == nt - 2);
            const size_t k1 = (size_t)(t + 1) * kstep;
            const size_t k2 = last ? 0 : (size_t)(t + 2) * kstep, k3 = k2 + kstep;
            const char* b2 = last ? nB : cB + (size_t)(t + 2) * kstep; const char* b3 = b2 + kstep;
            PG8_LDB(B0, 0, 0); PG8_LDB(B1, 0, 1); PG8_SCHED; PG8_LDA(At, 0, 0); PG8_STAGE_A(PG8_SA(1, 1), 1, k1, false);
            PG8_WAIT_V(8); PG8_WAIT_L(0); PG8_BAR; PG8_MMA(0, 0, At, B0); PG8_MMA(0, 1, At, B1); PG8_BAR; PG8_SCHED;
            PG8_LDA(At, 0, 1); PG8_STAGE(PG8_SB(0, 0), b2, voffB); PG8_STAGE(PG8_SB(0, 1), b2 + hstep, voffB); PG8_STAGE_A(PG8_SA(0, 0), 0, k2, last);
            PG8_WAIT_V(8); PG8_WAIT_L(0); PG8_BAR; PG8_MMA(1, 0, At, B0); PG8_MMA(1, 1, At, B1); PG8_BAR; PG8_SCHED;
            PG8_LDB(B0, 1, 0); PG8_LDB(B1, 1, 1); PG8_SCHED; PG8_LDA(At, 1, 0); PG8_STAGE_A(PG8_SA(0, 1), 1, k2, last);
            PG8_WAIT_V(8); PG8_WAIT_L(0); PG8_BAR; PG8_MMA(0, 0, At, B0); PG8_MMA(0, 1, At, B1); PG8_BAR; PG8_SCHED;
            PG8_LDA(At, 1, 1); PG8_STAGE(PG8_SB(1, 0), b3, voffB); PG8_STAGE(PG8_SB(1, 1), b3 + hstep, voffB); PG8_STAGE_A(PG8_SA(1, 0), 0, k3, last);
            PG8_WAIT_V(8); PG8_WAIT_L(0); PG8_BAR; PG8_MMA(1, 0, At, B0); PG8_MMA(1, 1, At, B1); PG8_BAR; PG8_SCHED;
        }
        if constexpr (ALIGN_EPI) { if (wr == 0) PG8_BAR; }
        { const int le_ = lane_fresh(); E(acc, cur, wr, wc, le_ & 15, le_ >> 4); }
        if (!has_next) break;
#pragma unroll
        for (int a = 0; a < 2; ++a)
#pragma unroll
            for (int b = 0; b < 2; ++b)
#pragma unroll
                for (int m = 0; m < 4; ++m)
#pragma unroll
                    for (int n = 0; n < 2; ++n) acc[a][b][m][n] = (f32x4){0.f, 0.f, 0.f, 0.f};
        cur = nxt; cA = nA; cB = nB; ++ui;
        if constexpr (ALIGN_EPI) { if (wr == 1) PG8_BAR; }
    }
    PG8_WAIT_V(0);
    if constexpr (!ALIGN_EPI) { if (wr == 0) PG8_BAR; }
    PG8_BAR;
#undef PG8_SA
#undef PG8_SB
#undef PG8_GLDS
#undef PG8_STAGE
#undef PG8_STAGE_A
#undef PG8_LDA
#undef PG8_LDB
#undef PG8_RD8
#undef PG8_MMA
#undef PG8_WAIT_V
#undef PG8_WAIT_L
#undef PG8_BAR
#undef PG8_SCHED
#undef PG8_GOFF
#undef PG8_GFILL
}
}

struct GEpiIn { static constexpr bool PERM = true; unsigned char* ws;
    DI void operator()(const f32x4 (&acc)[2][2][4][2], const pg8::Unit& u, int wr, int wc, int fr, int fq) const {
        const int row0 = u.pm * 256 + wr * 64 + fr, col0 = u.pn * 256 + wc * 32 + 8 * fq;
        if (epi_in_is_rope(col0)) {
            f32x4 t0[2][4], t1[2][4];
#pragma unroll
            for (int ai = 0; ai < 2; ++ai)
#pragma unroll
                for (int m = 0; m < 4; ++m) epi_in_table(ws, row0 + ai * 128 + m * 16, col0, t0[ai][m], t1[ai][m]);
#pragma unroll
            for (int ai = 0; ai < 2; ++ai)
#pragma unroll
                for (int m = 0; m < 4; ++m)
#pragma unroll
                    for (int bj = 0; bj < 2; ++bj) { const f32x4 a = acc[ai][bj][m][0], b = acc[ai][bj][m][1]; const float v[8] = {a[0], a[1], a[2], a[3], b[0], b[1], b[2], b[3]};
                        epi_in8_rope(ws, row0 + ai * 128 + m * 16, col0 + bj * 128, v, t0[ai][m], t1[ai][m]); }
            return;
        }
#pragma unroll
        for (int ai = 0; ai < 2; ++ai)
#pragma unroll
            for (int m = 0; m < 4; ++m)
#pragma unroll
                for (int bj = 0; bj < 2; ++bj) { const f32x4 a = acc[ai][bj][m][0], b = acc[ai][bj][m][1]; const float v[8] = {a[0], a[1], a[2], a[3], b[0], b[1], b[2], b[3]};
                    epi_in8(ws, row0 + ai * 128 + m * 16, col0 + bj * 128, v); }
    } };
struct GEpiOut { static constexpr bool PERM = true; unsigned char* ws;
    DI void operator()(const f32x4 (&acc)[2][2][4][2], const pg8::Unit& u, int wr, int wc, int fr, int fq) const {
        const int row0 = u.pm * 256 + wr * 64 + fr, col0 = u.pn * 256 + wc * 32 + 8 * fq;
#pragma unroll
        for (int ai = 0; ai < 2; ++ai)
#pragma unroll
            for (int m = 0; m < 4; ++m)
#pragma unroll
                for (int bj = 0; bj < 2; ++bj) { const f32x4 a = acc[ai][bj][m][0], b = acc[ai][bj][m][1]; const float v[8] = {a[0], a[1], a[2], a[3], b[0], b[1], b[2], b[3]};
                    store8_bf16((bf16_t*)(ws + WS_MIX) + (size_t)(row0 + ai * 128 + m * 16) * D + col0 + bj * 128, v); }
    } };
struct GEpiE1 { static constexpr bool PERM = true; unsigned char* ws;
    DI void operator()(const f32x4 (&acc)[2][2][4][2], const pg8::Unit& u, int wr, int wc, int fr, int fq) const {
        const int row0 = u.pm * 256 + wr * 64 + fr, col0 = (u.pn & 15) * 128 + wc * 32 + 8 * fq;
#pragma unroll
        for (int ai = 0; ai < 2; ++ai)
#pragma unroll
            for (int m = 0; m < 4; ++m) { const f32x4 g0 = acc[ai][0][m][0], g1 = acc[ai][0][m][1], u0 = acc[ai][1][m][0], u1 = acc[ai][1][m][1];
                const float v[8] = {silu_f(g0[0]) * u0[0], silu_f(g0[1]) * u0[1], silu_f(g0[2]) * u0[2], silu_f(g0[3]) * u0[3], silu_f(g1[0]) * u1[0], silu_f(g1[1]) * u1[1], silu_f(g1[2]) * u1[2], silu_f(g1[3]) * u1[3]};
#if F8_E2
                *(u32x2*)((unsigned char*)(ws + WS_HID) + (size_t)(row0 + ai * 128 + m * 16) * FF + col0) =
                    (u32x2){pk4_f8(v[0] * F8_HIDSCALE, v[1] * F8_HIDSCALE, v[2] * F8_HIDSCALE, v[3] * F8_HIDSCALE), pk4_f8(v[4] * F8_HIDSCALE, v[5] * F8_HIDSCALE, v[6] * F8_HIDSCALE, v[7] * F8_HIDSCALE)};
#else
                store8_bf16((bf16_t*)(ws + WS_HID) + (size_t)(row0 + ai * 128 + m * 16) * FF + col0, v);
#endif
            }
    } };
struct GEpiE2 { static constexpr bool PERM = true; unsigned char* ws;
    DI void operator()(const f32x4 (&acc)[2][2][4][2], const pg8::Unit& u, int wr, int wc, int fr, int fq) const {
        const int row0 = u.pm * 256 + wr * 64 + fr, col0 = (u.pn & 7) * 256 + wc * 32 + 8 * fq;
        const float* gatev = (const float*)(ws + WS_GATEV);
        float gtv[2][4];
#pragma unroll
        for (int ai = 0; ai < 2; ++ai)
#pragma unroll
            for (int m = 0; m < 4; ++m) gtv[ai][m] = gatev[row0 + ai * 128 + m * 16];
#pragma unroll
        for (int ai = 0; ai < 2; ++ai)
#pragma unroll
            for (int m = 0; m < 4; ++m) { const int row = row0 + ai * 128 + m * 16; const float gt = gtv[ai][m];
#pragma unroll
                for (int bj = 0; bj < 2; ++bj) { const f32x4 a = acc[ai][bj][m][0], b = acc[ai][bj][m][1]; const float v[8] = {a[0] * gt, a[1] * gt, a[2] * gt, a[3] * gt, b[0] * gt, b[1] * gt, b[2] * gt, b[3] * gt};
#if F8_Y
                    *(u32x2*)((unsigned char*)(ws + WS_Y) + (size_t)row * D + col0 + bj * 128) = (u32x2){pk4_f8(v[0] * F8_YSCALE, v[1] * F8_YSCALE, v[2] * F8_YSCALE, v[3] * F8_YSCALE), pk4_f8(v[4] * F8_YSCALE, v[5] * F8_YSCALE, v[6] * F8_YSCALE, v[7] * F8_YSCALE)};
#else
                    store8_bf16((bf16_t*)(ws + WS_Y) + (size_t)row * D + col0 + bj * 128, v);
#endif
                } }
    } };


constexpr int NWAVES = 8, NTHR = 512;
constexpr int RING_BYTES = 131072;
constexpr int LDSCTL_OFF = 162816, MISC_OFF = LDSCTL_OFF + 320;
constexpr int RMAP_OFF = RING_BYTES;
constexpr int GOFF_OFF = RMAP_OFF + 8192;
constexpr int LDS_BYTES = 163840;
constexpr int CW_BAR = 4096;
static_assert((size_t)(CW_BAR + XCD_BAR_WORDS) * 4 <= CTL_ZERO_BYTES, "the per-call memset must cover the barrier words");

enum { PH_PREP = 0, PH_PRENORM, PH_INPROJ, PH_ATTN, PH_RETOUT, PH_OUTPROJ, PH_ROWPASS, PH_TOPK, PH_E1, PH_E2, PH_FINAL, PH_COUNT };

struct Frame {
    unsigned char* lds;
    LAS unsigned char* ldsl;
    unsigned char* ws;
    const void* const* in;
    float* out;
    int tid, lane, wave, wg, nwg;
};

DI void ph_prep(const Frame& F) {
    const float* c = (const float*)F.in[I_C]; const float* w_ada = (const float*)F.in[I_WADA]; const float* b_ada = (const float*)F.in[I_BADA];
    float* mod = (float*)(F.ws + WS_MOD);
    float* sc = (float*)F.lds;
    float* red = (float*)(F.lds + 32768);
    {
        float cv_[16];
#pragma unroll
        for (int i = 0; i < 16; ++i) cv_[i] = c[F.tid + NTHR * i];
#pragma unroll
        for (int i = 0; i < 16; ++i) sc[F.tid + NTHR * i] = silu_f(cv_[i]);
    }
    __syncthreads();
    for (int u = F.wg; u < 256; u += F.nwg) {
        const int cbk = u >> 1, kh = u & 1, cg = F.tid % 24, ks = F.tid / 24;
        float acc[4][4];
#pragma unroll
        for (int b = 0; b < 4; ++b)
#pragma unroll
            for (int j = 0; j < 4; ++j) acc[b][j] = 0.f;
        if (ks < 21) {
            const float* wp = w_ada + (size_t)(kh * 1024) * (6 * D) + cbk * 96 + cg * 4;
            for (int k = ks; k < 1024; k += 21 * 7) {
                f32x4 w[7];
#pragma unroll
                for (int i = 0; i < 7; ++i) { const int ki = (k + 21 * i < 1024) ? k + 21 * i : ks; w[i] = __builtin_nontemporal_load((const f32x4*)(wp + (size_t)ki * (6 * D))); }
#pragma unroll
                for (int i = 0; i < 7; ++i) { const int ki = k + 21 * i; if (ki < 1024) {
#pragma unroll
                    for (int b = 0; b < 4; ++b) { const float a = sc[b * D + kh * 1024 + ki]; acc[b][0] += a * w[i][0]; acc[b][1] += a * w[i][1]; acc[b][2] += a * w[i][2]; acc[b][3] += a * w[i][3]; } } }
            }
#pragma unroll
            for (int b = 0; b < 4; ++b)
#pragma unroll
                for (int j = 0; j < 4; ++j) red[(ks * 24 + cg) * 16 + b * 4 + j] = acc[b][j];
        }
        __syncthreads();
        if (F.tid < 384) {
            const int cg2 = F.tid / 16, bj = F.tid % 16, b = bj >> 2, j = bj & 3;
            const int col = cbk * 96 + cg2 * 4 + j;
            float s = kh == 0 ? b_ada[col] : 0.f;
#pragma unroll
            for (int k2 = 0; k2 < 21; ++k2) s += red[(k2 * 24 + cg2) * 16 + bj];
            mod[(size_t)kh * MOD_HALF + b * (6 * D) + col] = s;
        }
        __syncthreads();
    }
    const int* pos = (const int*)F.in[I_POS];
    f32x2* rd = (f32x2*)(F.ws + WS_ROPED); f32x2* rr = (f32x2*)(F.ws + WS_ROPER);
    {
        static_assert(M * 96 == 12 * 256 * NTHR, "rope-table work split");
        const int base = F.wg * NTHR + F.tid, stride = F.nwg * NTHR;
        if (F.nwg == 256) {
            int pv[12];
#pragma unroll
            for (int i = 0; i < 12; ++i) pv[i] = pos[(base + stride * i) / 96];
#pragma unroll
            for (int i = 0; i < 12; ++i) {
                const int idx = base + stride * i, tok = idx / 96, f = idx % 96;
                const float p = (float)pv[i];
                float ex; if (f < 32) ex = (float)(2 * f) * (1.f / 64.f); else ex = (float)(2 * (f - 32)) * (1.f / 128.f);
                const float inv = exp2f(-ex * 13.287712379549449f);
                double rev = (double)(p * inv) * 0.15915494309189535; rev -= rint(rev);
                const float rv = (float)rev, sn = __builtin_amdgcn_sinf(rv), cs = __builtin_amdgcn_cosf(rv);
                if (f < 32) rd[(size_t)tok * 32 + f] = (f32x2){cs, sn}; else rr[(size_t)tok * 64 + (f - 32)] = (f32x2){cs, sn};
            }
        } else {
        for (int idx = F.wg * NTHR + F.tid; idx < M * 96; idx += F.nwg * NTHR) {
        const int tok = idx / 96, f = idx % 96;
        const float p = (float)pos[tok];
        float ex; if (f < 32) ex = (float)(2 * f) * (1.f / 64.f); else ex = (float)(2 * (f - 32)) * (1.f / 128.f);
        const float inv = exp2f(-ex * 13.287712379549449f);
        double rev = (double)(p * inv) * 0.15915494309189535; rev -= rint(rev);
        const float rv = (float)rev, sn = __builtin_amdgcn_sinf(rv), cs = __builtin_amdgcn_cosf(rv);
        if (f < 32) rd[(size_t)tok * 32 + f] = (f32x2){cs, sn}; else rr[(size_t)tok * 64 + (f - 32)] = (f32x2){cs, sn};
    }
        }
    }
}


DI unsigned cvt_pk_bf16(float lo, float hi) { unsigned r; asm volatile("v_cvt_pk_bf16_f32 %0, %1, %2" : "=v"(r) : "v"(lo), "v"(hi)); return r; }
struct MapIn   { DI int src(int n) const { return src_col_in(n); } DI int dst(int n) const { return n; } };
struct MapId   { DI int src(int n) const { return n; } DI int dst(int n) const { return n; } };
struct MapGU   { int up; DI int src(int n) const { return n; } DI int dst(int n) const { return ((n >> 7) << 8) + (n & 127) + up * 128; } };
template <class MapF>
DI void transpose_item(const float* __restrict__ W, int ldw, bf16_t* __restrict__ WT, LAS float* scr, int k0, int n0, int lane, const MapF f) {
    const int sc = f.src(n0 + (lane & 31));
#pragma unroll 8
    for (int i = 0; i < 32; ++i) { const int kk = 2 * i + (lane >> 5); scr[kk * 33 + (lane & 31)] = W[(size_t)(k0 + kk) * ldw + sc]; }
    asm volatile("s_waitcnt lgkmcnt(0)" ::: "memory");
    const int c = lane & 7;
#pragma unroll
    for (int j = 0; j < 4; ++j) { const int n = (lane >> 3) + 8 * j; const LAS float* sp = scr + (8 * c) * 33 + n;
        u32x4 o; o.x = cvt_pk_bf16(sp[0 * 33], sp[1 * 33]); o.y = cvt_pk_bf16(sp[2 * 33], sp[3 * 33]); o.z = cvt_pk_bf16(sp[4 * 33], sp[5 * 33]); o.w = cvt_pk_bf16(sp[6 * 33], sp[7 * 33]);
        *(u32x4*)(WT + (size_t)f.dst(n0 + n) * 2048 + k0 + 8 * c) = o; }
    asm volatile("s_waitcnt lgkmcnt(0)" ::: "memory");
}
struct CvItem { const float* src; bf16_t* dst; int up; };
DI CvItem cv_decode2(const Frame& F, int q, int kb, int nb, int lane);
DI CvItem cv_decode(const Frame& F, int it, int lane) { const int ii = it & 1023; return cv_decode2(F, it >> 10, ii >> 5, ii & 31, lane); }
DI CvItem cv_decode2(const Frame& F, int q, int kb, int nb, int lane) {
    const int ty = q >> 4, e = q & 15, n4 = lane & 15, kr = lane >> 4;
    CvItem c;
    const float* W = (const float*)F.in[ty == 0 ? I_WGATE : (ty == 1 ? I_WUP : I_WDOWN)] + (size_t)e * D * FF;
    c.src = W + (size_t)(kb * 64 + 16 * kr) * 2048 + nb * 64 + 4 * n4;
    bf16_t* WT = ty < 2 ? (bf16_t*)(F.ws + WS_W1T) + (size_t)e * 4096 * 2048 : (bf16_t*)(F.ws + WS_W2T) + (size_t)e * 2048 * 2048;
    const int n0 = nb * 64, r0 = ty < 2 ? ((n0 >> 7) << 8) + (n0 & 127) + ty * 128 : n0;
    c.up = ty;
    if ((ty < 2 && F8_E1) || (ty == 2 && F8_E2)) {
        unsigned char* WT8 = ty < 2 ? (unsigned char*)(F.ws + WS_W1T) + (size_t)e * 4096 * 2048 : (unsigned char*)(F.ws + WS_W2T) + (size_t)e * 2048 * 2048;
        c.dst = (bf16_t*)(WT8 + (size_t)r0 * 2048 + kb * 64);
    } else c.dst = WT + (size_t)r0 * 2048 + kb * 64;
    return c;
}
#define CV_LOAD(v, c) do { _Pragma("unroll") for (int i_ = 0; i_ < 16; ++i_) v[i_] = __builtin_nontemporal_load((const f32x4*)((c).src + (size_t)i_ * 2048)); } while (0)
DI void cv_store(const f32x4 (&v)[16], const CvItem& c, char* tl, int lane) {
    const int n4 = lane & 15, kr = lane >> 4;
  if ((c.up < 2 && F8_E1) || (c.up == 2 && F8_E2)) {
#pragma unroll
    for (int j = 0; j < 4; ++j) { const int n = 4 * n4 + j;
        u32x4 a;
        a.x = pk4_f8(v[0][j] * F8_WSCALE, v[1][j] * F8_WSCALE, v[2][j] * F8_WSCALE, v[3][j] * F8_WSCALE); a.y = pk4_f8(v[4][j] * F8_WSCALE, v[5][j] * F8_WSCALE, v[6][j] * F8_WSCALE, v[7][j] * F8_WSCALE);
        a.z = pk4_f8(v[8][j] * F8_WSCALE, v[9][j] * F8_WSCALE, v[10][j] * F8_WSCALE, v[11][j] * F8_WSCALE); a.w = pk4_f8(v[12][j] * F8_WSCALE, v[13][j] * F8_WSCALE, v[14][j] * F8_WSCALE, v[15][j] * F8_WSCALE);
        *(u32x4*)(tl + n * 64 + ((kr ^ (n4 & 3)) << 4)) = a; }
    asm volatile("s_waitcnt lgkmcnt(0)" ::: "memory");
#pragma unroll
    for (int r = 0; r < 4; ++r) { const int n = (lane >> 2) + 16 * r, cc = lane & 3;
        const u32x4 o = *(const u32x4*)(tl + n * 64 + ((cc ^ ((n >> 2) & 3)) << 4));
        __builtin_nontemporal_store(o, (u32x4*)((unsigned char*)c.dst + (size_t)n * 2048 + 16 * cc)); }
    asm volatile("s_waitcnt lgkmcnt(0)" ::: "memory");
    return;
  }
#pragma unroll
    for (int j = 0; j < 4; ++j) { const int n = 4 * n4 + j; char* row = tl + n * 128; const int sw = (n >> 2) & 7;
        u32x4 a, b;
        a.x = cvt_pk_bf16(v[0][j], v[1][j]); a.y = cvt_pk_bf16(v[2][j], v[3][j]); a.z = cvt_pk_bf16(v[4][j], v[5][j]); a.w = cvt_pk_bf16(v[6][j], v[7][j]);
        b.x = cvt_pk_bf16(v[8][j], v[9][j]); b.y = cvt_pk_bf16(v[10][j], v[11][j]); b.z = cvt_pk_bf16(v[12][j], v[13][j]); b.w = cvt_pk_bf16(v[14][j], v[15][j]);
        *(u32x4*)(row + (((2 * kr) ^ sw) << 4)) = a; *(u32x4*)(row + (((2 * kr + 1) ^ sw) << 4)) = b; }
    asm volatile("s_waitcnt lgkmcnt(0)" ::: "memory");
#pragma unroll
    for (int r = 0; r < 8; ++r) { const int n = (lane >> 3) + 8 * r, cc = lane & 7;
        const u32x4 o = *(const u32x4*)(tl + n * 128 + ((cc ^ ((n >> 2) & 7)) << 4));
        __builtin_nontemporal_store(o, (u32x4*)(c.dst + (size_t)n * 2048 + 8 * cc)); }
    asm volatile("s_waitcnt lgkmcnt(0)" ::: "memory");
}
DI void convert_experts_slice(const Frame& F) {
    char* tl = (char*)F.lds + F.wave * 8192;
    constexpr int NIT = 3 * NE * 1024;
    const int per = (NIT + F.nwg - 1) / F.nwg, lo = F.wg * per, hi = (lo + per < NIT) ? lo + per : NIT;
    f32x4 va[16], vb[16]; CvItem ca, cb;
    const int cnt = (hi - lo) / NWAVES, it0 = lo + F.wave;
    if (F.nwg == 256) {
#define CV_DEC(i_) cv_decode2(F, (6 * F.wg + ((i_) >> 2)) >> 5, (6 * F.wg + ((i_) >> 2)) & 31, 4 * F.wave + ((i_) & 3), F.lane)
        ca = CV_DEC(0); CV_LOAD(va, ca);
        for (int i = 0; i < 24; i += 2) {
            cb = CV_DEC(i + 1); CV_LOAD(vb, cb);
            cv_store(va, ca, tl, F.lane);
            const int i2 = (i + 2 < 24) ? i + 2 : 23;
            ca = CV_DEC(i2); CV_LOAD(va, ca);
            cv_store(vb, cb, tl, F.lane);
        }
#undef CV_DEC
    } else if ((hi - lo) == cnt * NWAVES && (cnt & 1) == 0 && cnt > 0) {
        ca = cv_decode(F, it0, F.lane); CV_LOAD(va, ca);
        for (int i = 0; i < cnt; i += 2) {
            cb = cv_decode(F, it0 + NWAVES * (i + 1), F.lane); CV_LOAD(vb, cb);
            cv_store(va, ca, tl, F.lane);
            const int i2 = (i + 2 < cnt) ? i + 2 : cnt - 1;
            ca = cv_decode(F, it0 + NWAVES * i2, F.lane); CV_LOAD(va, ca);
            cv_store(vb, cb, tl, F.lane);
        }
    } else {
        for (int it = it0; it < hi; it += NWAVES) { ca = cv_decode(F, it, F.lane); CV_LOAD(va, ca); cv_store(va, ca, tl, F.lane); }
    }
}
template <class MapF>
DI void transpose_item_f8(const float* __restrict__ W, int ldw, unsigned char* __restrict__ WT8, LAS float* scr, int k0, int n0, int lane, const MapF f) {
    const int sc = f.src(n0 + (lane & 31));
    float wv[32];
#pragma unroll
    for (int i = 0; i < 32; ++i) { const int kk = 2 * i + (lane >> 5); wv[i] = W[(size_t)(k0 + kk) * ldw + sc]; }
#pragma unroll
    for (int i = 0; i < 32; ++i) { const int kk = 2 * i + (lane >> 5); scr[kk * 33 + (lane & 31)] = wv[i]; }
    asm volatile("s_waitcnt lgkmcnt(0)" ::: "memory");
    const int c = lane & 3;
#pragma unroll
    for (int j = 0; j < 2; ++j) { const int n = (lane >> 2) + 16 * j; const LAS float* sp = scr + (16 * c) * 33 + n;
        u32x4 o;
        o.x = pk4_f8(sp[0 * 33] * F8_WSCALE, sp[1 * 33] * F8_WSCALE, sp[2 * 33] * F8_WSCALE, sp[3 * 33] * F8_WSCALE); o.y = pk4_f8(sp[4 * 33] * F8_WSCALE, sp[5 * 33] * F8_WSCALE, sp[6 * 33] * F8_WSCALE, sp[7 * 33] * F8_WSCALE);
        o.z = pk4_f8(sp[8 * 33] * F8_WSCALE, sp[9 * 33] * F8_WSCALE, sp[10 * 33] * F8_WSCALE, sp[11 * 33] * F8_WSCALE); o.w = pk4_f8(sp[12 * 33] * F8_WSCALE, sp[13 * 33] * F8_WSCALE, sp[14 * 33] * F8_WSCALE, sp[15 * 33] * F8_WSCALE);
        *(u32x4*)(WT8 + (size_t)f.dst(n0 + n) * 2048 + k0 + 16 * c) = o; }
    asm volatile("s_waitcnt lgkmcnt(0)" ::: "memory");
}
template <bool F8>
DI void cvw_item(const float* __restrict__ W, int ldw, void* WT, char* tl, int k0, int s0, int mode, int lane) {
    const int n4 = lane & 15, kr = lane >> 4;
    const float* src = W + (size_t)(k0 + 16 * kr) * ldw + s0 + 4 * n4;
    f32x4 v[16];
#pragma unroll
    for (int i = 0; i < 16; ++i) v[i] = __builtin_nontemporal_load((const f32x4*)(src + (size_t)i * ldw));
    const int hb = (s0 >> 6) & 1, g128 = s0 & ~127;
#define CVW_ROW(n_) (mode == 0 ? s0 + (n_) : (mode == 1 ? s0 + ((n_) < 32 ? 2 * (n_) : 2 * ((n_) - 32) + 1) : g128 + 2 * (n_) + hb))
    if (F8) {
#pragma unroll
        for (int j = 0; j < 4; ++j) { const int n = 4 * n4 + j;
            u32x4 a;
            a.x = pk4_f8(v[0][j] * F8_WSCALE, v[1][j] * F8_WSCALE, v[2][j] * F8_WSCALE, v[3][j] * F8_WSCALE); a.y = pk4_f8(v[4][j] * F8_WSCALE, v[5][j] * F8_WSCALE, v[6][j] * F8_WSCALE, v[7][j] * F8_WSCALE);
            a.z = pk4_f8(v[8][j] * F8_WSCALE, v[9][j] * F8_WSCALE, v[10][j] * F8_WSCALE, v[11][j] * F8_WSCALE); a.w = pk4_f8(v[12][j] * F8_WSCALE, v[13][j] * F8_WSCALE, v[14][j] * F8_WSCALE, v[15][j] * F8_WSCALE);
            *(u32x4*)(tl + n * 64 + ((kr ^ (n4 & 3)) << 4)) = a; }
        asm volatile("s_waitcnt lgkmcnt(0)" ::: "memory");
#pragma unroll
        for (int r = 0; r < 4; ++r) { const int n = (lane >> 2) + 16 * r, cc = lane & 3;
            const u32x4 o = *(const u32x4*)(tl + n * 64 + ((cc ^ ((n >> 2) & 3)) << 4));
            *(u32x4*)((unsigned char*)WT + (size_t)CVW_ROW(n) * 2048 + k0 + 16 * cc) = o; }
    } else {
#pragma unroll
        for (int j = 0; j < 4; ++j) { const int n = 4 * n4 + j; char* row = tl + n * 128; const int sw = (n >> 2) & 7;
            u32x4 a, b;
            a.x = cvt_pk_bf16(v[0][j], v[1][j]); a.y = cvt_pk_bf16(v[2][j], v[3][j]); a.z = cvt_pk_bf16(v[4][j], v[5][j]); a.w = cvt_pk_bf16(v[6][j], v[7][j]);
            b.x = cvt_pk_bf16(v[8][j], v[9][j]); b.y = cvt_pk_bf16(v[10][j], v[11][j]); b.z = cvt_pk_bf16(v[12][j], v[13][j]); b.w = cvt_pk_bf16(v[14][j], v[15][j]);
            *(u32x4*)(row + (((2 * kr) ^ sw) << 4)) = a; *(u32x4*)(row + (((2 * kr + 1) ^ sw) << 4)) = b; }
        asm volatile("s_waitcnt lgkmcnt(0)" ::: "memory");
#pragma unroll
        for (int r = 0; r < 8; ++r) { const int n = (lane >> 3) + 8 * r, cc = lane & 7;
            const u32x4 o = *(const u32x4*)(tl + n * 128 + ((cc ^ ((n >> 2) & 7)) << 4));
            *(u32x4*)((bf16_t*)WT + (size_t)CVW_ROW(n) * 2048 + k0 + 8 * cc) = o; }
    }
    asm volatile("s_waitcnt lgkmcnt(0)" ::: "memory");
#undef CVW_ROW
}
DI void ph_convert(const Frame& F) {
    __syncthreads();
#if F8_IN && OPT_IN && OPT_OUT
    {
        char* tl = (char*)F.lds + F.wave * 8192;
        const int gw0 = F.wg * NWAVES + F.wave, ngw0 = F.nwg * NWAVES;
        constexpr int NI_IN = 32 * (NCOL / 64), NI_OUT = 32 * (D / 64);
        for (int it = gw0; it < NI_IN + NI_OUT; it += ngw0) {
            if (it < NI_IN) { const int kb = it / (NCOL / 64), cb = it % (NCOL / 64), s0 = cb * 64, sec = s0 >> 10;
                cvw_item<true>((const float*)F.in[I_WIN], NCOL, F.ws + WS_WINT, tl, kb * 64, s0, sec <= 1 ? 1 : ((sec == 3 || sec == 4) ? 2 : 0), F.lane); }
            else { const int r = it - NI_IN, kb = r >> 5, cb = r & 31;
                cvw_item<false>((const float*)F.in[I_WOUT], D, F.ws + WS_WOUTT, tl, kb * 64, cb * 64, 0, F.lane); }
        }
        return;
    }
#endif
    LAS float* scr = (LAS float*)(F.ldsl + F.wave * 16384);
    const int gw = F.wg * NWAVES + F.wave, ngw = F.nwg * NWAVES;
    constexpr int I_IN = OPT_IN ? 32 * (NCOL / 32) : 0, I_OUT = OPT_OUT ? 32 * 64 : 0, I_E1 = 0, I_E2 = 0;
    for (int it = gw; it < I_IN + I_OUT + I_E1 + I_E2; it += ngw) {
        int r = it;
        if (r < I_IN) { const int kb = r / (NCOL / 32), nb = r % (NCOL / 32);
#if F8_IN
            transpose_item_f8((const float*)F.in[I_WIN], NCOL, (unsigned char*)(F.ws + WS_WINT), scr, kb * 64, nb * 32, F.lane, MapIn{});
#else
            transpose_item((const float*)F.in[I_WIN], NCOL, (bf16_t*)(F.ws + WS_WINT), scr, kb * 64, nb * 32, F.lane, MapIn{});
#endif
            continue; } r -= I_IN;
        if (r < I_OUT) { const int kb = r >> 6, nb = r & 63; transpose_item((const float*)F.in[I_WOUT], D, (bf16_t*)(F.ws + WS_WOUTT), scr, kb * 64, nb * 32, F.lane, MapId{}); continue; } r -= I_OUT;
        if (r < I_E1) { const int q = r >> 11, up = q >> 4, e = q & 15, ii = r & 2047, kb = ii >> 6, nb = ii & 63;
            transpose_item((const float*)F.in[up ? I_WUP : I_WGATE] + (size_t)e * D * FF, FF, (bf16_t*)(F.ws + WS_W1T) + (size_t)e * 4096 * 2048, scr, kb * 64, nb * 32, F.lane, MapGU{up}); continue; } r -= I_E1;
        { const int e = r >> 11, ii = r & 2047, kb = ii >> 6, nb = ii & 63;
            transpose_item((const float*)F.in[I_WDOWN] + (size_t)e * FF * D, D, (bf16_t*)(F.ws + WS_W2T) + (size_t)e * 2048 * 2048, scr, kb * 64, nb * 32, F.lane, MapId{}); }
    }
}
struct SubOrder { pg8::StaticOrder S; int i0, n; DI bool next(int i, pg8::Unit& u) const { return i < n && S.next(i0 + i, u); } };
DI void ph_inproj(const Frame& F) {
    pg8::Gemm g{(const bf16_t*)(F.ws + WS_H), (const bf16_t*)(F.ws + WS_WINT), D}; GEpiIn E{F.ws};
    pg8::StaticOrder S; S.init(M, NCOL, F.nwg, F.wg);
#if F8_IN
    pg8::gemm_phase<GEpiIn, pg8::StaticOrder, false, true>(F.ldsl, g, S, E, nullptr, F.wave, F8_WSCL, F8_HSCL);
#else
    pg8::gemm_phase<GEpiIn, pg8::StaticOrder, false>(F.ldsl, g, S, E, nullptr, F.wave);
#endif
}
DI void ph_outproj(const Frame& F) {
    pg8::Gemm g{(const bf16_t*)(F.ws + WS_MIXIN), (const bf16_t*)(F.ws + WS_WOUTT), D}; pg8::StaticOrder S; S.init(M, D, F.nwg, F.wg); GEpiOut E{F.ws};
    pg8::gemm_phase<GEpiOut, pg8::StaticOrder, false>(F.ldsl, g, S, E, nullptr, F.wave);
}
DI void ph_e1(const Frame& F) {
    LAS int* rm = (LAS int*)(F.ldsl + RMAP_OFF);
    const int* rowmap = (const int*)(F.ws + WS_ROWMAP);
    pg8::ExpertOrder<16> S; S.init(F.nwg, F.wg);
    pg8::Unit u;
    {
        int rv[8]; bool ok[8];
#pragma unroll
        for (int i = 0; i < 8; ++i) { ok[i] = S.next(i, u); rv[i] = (ok[i] && F.tid < 256) ? rowmap[u.pm * 256 + F.tid] : 0; }
#pragma unroll
        for (int i = 0; i < 8; ++i) if (ok[i] && F.tid < 256) rm[i * 256 + F.tid] = rv[i];
    }
    __syncthreads();
    pg8::Gemm g{(const bf16_t*)(F.ws + WS_H), (const bf16_t*)(F.ws + WS_W1T), D}; GEpiE1 E{F.ws};
#if F8_E1
    pg8::gemm_phase<GEpiE1, pg8::ExpertOrder<16>, true, true>(F.ldsl, g, S, E, rm, F.wave, F8_WSCL, F8_HSCL);
#else
    pg8::gemm_phase<GEpiE1, pg8::ExpertOrder<16>, true>(F.ldsl, g, S, E, rm, F.wave);
#endif
}
DI void ph_e2(const Frame& F) {
    pg8::Gemm g{(const bf16_t*)(F.ws + WS_HID), (const bf16_t*)(F.ws + WS_W2T), FF}; pg8::ExpertOrder<8> S; S.init(F.nwg, F.wg); GEpiE2 E{F.ws};
#if F8_E2
    pg8::gemm_phase<GEpiE2, pg8::ExpertOrder<8>, false, true>(F.ldsl, g, S, E, nullptr, F.wave, F8_WSCL, F8_HIDSCL);
#else
    pg8::gemm_phase<GEpiE2, pg8::ExpertOrder<8>, false>(F.ldsl, g, S, E, nullptr, F.wave);
#endif
}


namespace att {
using bf16x8 = __attribute__((ext_vector_type(8))) short;
using s16x4  = __attribute__((ext_vector_type(4))) short;
using f32x16 = __attribute__((ext_vector_type(16))) float;
constexpr int SHM_V = 16384, SHM_K = 8192, OFF_V = 0, OFF_K = 49152, OFF_ST = 73728;
constexpr float THRL = 8.f;
#define AT_KSWZ(row, colB) ((row) * 128 + ((colB) ^ ((((row) >> 1) & 7) << 4)))
#define AT_SBAR() __builtin_amdgcn_sched_barrier(0)
DI int crow(int r, int hi) { return (r & 3) + 8 * (r >> 2) + 4 * hi; }
DI unsigned cvtpk(float lo, float hi) { unsigned r; asm volatile("v_cvt_pk_bf16_f32 %0, %1, %2" : "=v"(r) : "v"(lo), "v"(hi)); return r; }
DI int v_st(int k, int c) { const int kk = (k & ~0xC) | ((k & 4) << 1) | ((k & 8) >> 1); return ((kk >> 3) * 4 + (c >> 5)) * 512 + ((kk & 7) * 32 + (c & 31)) * 2; }
DI int v_rd_base(int lane) { return ((lane & 3) << 3) | (((lane >> 2) & 3) << 6) | (((lane >> 4) & 1) << 5) | (((lane >> 5) & 1) << 8); }
constexpr int v_rd_off(int d0, int ks, int half) { return d0 * 512 + ks * 4096 + half * 2048; }
template <int OFF> DI s16x4 tr_read(int vb) { s16x4 r; asm volatile("ds_read_b64_tr_b16 %0, %1 offset:%2" : "=&v"(r) : "v"(vb), "i"(OFF) : "memory"); return r; }
DI void partialSM(f32x16& p0, f32x16& p1, float& m_ref, f32x16& negm, float& alpha) {
    float pmax = p0[0];
#pragma unroll
    for (int r = 1; r < 16; ++r) pmax = fmaxf(pmax, p0[r]);
#pragma unroll
    for (int r = 0; r < 16; ++r) pmax = fmaxf(pmax, p1[r]);
    { auto rr = __builtin_amdgcn_permlane32_swap(__float_as_uint(pmax), __float_as_uint(pmax), false, false); pmax = fmaxf(__uint_as_float(rr[0]), __uint_as_float(rr[1])); }
    alpha = 1.f;
    if (__builtin_expect(!__all(pmax <= THRL), 0)) {
        const float dl = fmaxf(pmax, 0.f); m_ref += dl; alpha = __builtin_amdgcn_exp2f(-dl);
#pragma unroll
        for (int r = 0; r < 16; ++r) { p0[r] -= dl; p1[r] -= dl; }
#pragma unroll
        for (int r = 0; r < 16; ++r) negm[r] = -m_ref;
    }
#pragma unroll
    for (int r = 0; r < 16; ++r) p0[r] = __builtin_amdgcn_exp2f(p0[r]);
}
DI void finishSM(f32x16& p0, f32x16& p1, float alpha, float& l_reg, bf16x8& pa0, bf16x8& pa1, bf16x8& pa2, bf16x8& pa3) {
#pragma unroll
    for (int r = 0; r < 16; ++r) p1[r] = __builtin_amdgcn_exp2f(p1[r]);
    float ps = 0;
#pragma unroll
    for (int r = 0; r < 16; ++r) ps += p0[r];
#pragma unroll
    for (int r = 0; r < 16; ++r) ps += p1[r];
    { auto rr = __builtin_amdgcn_permlane32_swap(__float_as_uint(ps), __float_as_uint(ps), false, false); ps = __uint_as_float(rr[0]) + __uint_as_float(rr[1]); }
    l_reg = l_reg * alpha + ps;
#define AT_PK4(P, BASE, OUT) do { unsigned a0 = cvtpk(P[BASE + 0], P[BASE + 1]), a1 = cvtpk(P[BASE + 2], P[BASE + 3]);   \
    unsigned b0 = cvtpk(P[BASE + 4], P[BASE + 5]), b1 = cvtpk(P[BASE + 6], P[BASE + 7]);                              \
    auto r0 = __builtin_amdgcn_permlane32_swap(a0, b0, false, false); auto r1 = __builtin_amdgcn_permlane32_swap(a1, b1, false, false); \
    u32x4 w = {r0[0], r1[0], r0[1], r1[1]}; OUT = __builtin_bit_cast(bf16x8, w); } while (0)
    AT_PK4(p0, 0, pa0); AT_PK4(p0, 8, pa1); AT_PK4(p1, 0, pa2); AT_PK4(p1, 8, pa3);
#undef AT_PK4
}
DI void qkt(f32x16& p0, f32x16& p1, const char* Ks, const bf16x8* qr, const f32x16& negm, int r32, int hi) {
#pragma unroll
    for (int d0 = 0; d0 < 4; ++d0) { const int cb = (d0 * 16 + hi * 8) * 2;
        const bf16x8 b0 = *reinterpret_cast<const bf16x8*>(Ks + AT_KSWZ(r32, cb));
        const bf16x8 b1 = *reinterpret_cast<const bf16x8*>(Ks + AT_KSWZ(32 + r32, cb));
        p0 = __builtin_amdgcn_mfma_f32_32x32x16_bf16(b0, qr[d0], d0 == 0 ? negm : p0, 0, 0, 0);
        p1 = __builtin_amdgcn_mfma_f32_32x32x16_bf16(b1, qr[d0], d0 == 0 ? negm : p1, 0, 0, 0); }
}
template <int D0> DI void pv_one(f32x16& od, int vb, bf16x8 pa0, bf16x8 pa1, bf16x8 pa2, bf16x8 pa3) {
    const s16x4 l0 = tr_read<v_rd_off(D0, 0, 0)>(vb), h0 = tr_read<v_rd_off(D0, 0, 1)>(vb), l1 = tr_read<v_rd_off(D0, 1, 0)>(vb), h1 = tr_read<v_rd_off(D0, 1, 1)>(vb);
    const s16x4 l2 = tr_read<v_rd_off(D0, 2, 0)>(vb), h2 = tr_read<v_rd_off(D0, 2, 1)>(vb), l3 = tr_read<v_rd_off(D0, 3, 0)>(vb), h3 = tr_read<v_rd_off(D0, 3, 1)>(vb);
    asm volatile("s_waitcnt lgkmcnt(0)" ::: "memory"); AT_SBAR();
#define AT_PK(L, H) (bf16x8){L[0], L[1], L[2], L[3], H[0], H[1], H[2], H[3]}
    od = __builtin_amdgcn_mfma_f32_32x32x16_bf16(AT_PK(l0, h0), pa0, od, 0, 0, 0);
    od = __builtin_amdgcn_mfma_f32_32x32x16_bf16(AT_PK(l1, h1), pa1, od, 0, 0, 0);
    od = __builtin_amdgcn_mfma_f32_32x32x16_bf16(AT_PK(l2, h2), pa2, od, 0, 0, 0);
    od = __builtin_amdgcn_mfma_f32_32x32x16_bf16(AT_PK(l3, h3), pa3, od, 0, 0, 0);
#undef AT_PK
}
DI void pv_all_sm(f32x16* o, int vb, bf16x8 pa0, bf16x8 pa1, bf16x8 pa2, bf16x8 pa3, f32x16& p0, f32x16& p1, float& m_ref, f32x16& negm, float& alpha) {
    pv_one<0>(o[0], vb, pa0, pa1, pa2, pa3);
    float pmax = p0[0];
#pragma unroll
    for (int r = 1; r < 16; ++r) pmax = fmaxf(pmax, p0[r]);
    pv_one<1>(o[1], vb, pa0, pa1, pa2, pa3);
#pragma unroll
    for (int r = 0; r < 16; ++r) pmax = fmaxf(pmax, p1[r]);
    { auto rr = __builtin_amdgcn_permlane32_swap(__float_as_uint(pmax), __float_as_uint(pmax), false, false); pmax = fmaxf(__uint_as_float(rr[0]), __uint_as_float(rr[1])); }
    pv_one<2>(o[2], vb, pa0, pa1, pa2, pa3);
    alpha = 1.f;
    if (__builtin_expect(!__all(pmax <= THRL), 0)) {
        const float dl = fmaxf(pmax, 0.f); m_ref += dl; alpha = __builtin_amdgcn_exp2f(-dl);
#pragma unroll
        for (int r = 0; r < 16; ++r) { p0[r] -= dl; p1[r] -= dl; }
#pragma unroll
        for (int r = 0; r < 16; ++r) negm[r] = -m_ref;
    }
    pv_one<3>(o[3], vb, pa0, pa1, pa2, pa3);
#pragma unroll
    for (int r = 0; r < 16; ++r) p0[r] = __builtin_amdgcn_exp2f(p0[r]);
}
DI void pv_all(f32x16* o, int vb, bf16x8 pa0, bf16x8 pa1, bf16x8 pa2, bf16x8 pa3) {
    pv_one<0>(o[0], vb, pa0, pa1, pa2, pa3); pv_one<1>(o[1], vb, pa0, pa1, pa2, pa3); pv_one<2>(o[2], vb, pa0, pa1, pa2, pa3); pv_one<3>(o[3], vb, pa0, pa1, pa2, pa3);
}
constexpr int OFF_CV = OFF_ST + 65536, CV_TILE = 64 * 68, CV_NITEM = 192;
struct CvRide { int ci, pend; };
DI void cv_ptrs(const Frame& F, int i, const float*& src, unsigned char*& dst) {
    const int p = 6 * F.wg + (i >> 5), nb = i & 31, q = p >> 5, kb = p & 31, ty = q >> 4, e = q & 15;
    const float* W = (const float*)F.in[ty == 0 ? I_WGATE : (ty == 1 ? I_WUP : I_WDOWN)] + (size_t)e * D * FF;
    src = W + (size_t)(kb * 64) * 2048 + nb * 64;
    const int n0 = nb * 64, r0 = ty < 2 ? ((n0 >> 7) << 8) + (n0 & 127) + ty * 128 : n0;
    unsigned char* WT8 = ty < 2 ? (unsigned char*)(F.ws + WS_W1T) + (size_t)e * 4096 * 2048 : (unsigned char*)(F.ws + WS_W2T) + (size_t)e * 2048 * 2048;
    dst = WT8 + (size_t)r0 * 2048 + kb * 64;
}
DI void attn_pass(const Frame& F, CvRide& cv, const bf16_t* __restrict__ Qb, const bf16_t* __restrict__ Kh, const bf16_t* __restrict__ Vh, char* lds, f32x16 (&o)[4], float& l_out, const int wave_s) {
    const int tid = tid_fresh(wave_s), wid = tid >> 6, lane = tid & 63, r32 = lane & 31, hi = lane >> 5;
    char* V_lds = lds + OFF_V; char* K_lds = lds + OFF_K;
    float m_ref = 0.f, l_reg = 0.f; bf16x8 qr[4]; f32x16 negm = f32x16{};
#pragma unroll
    for (int d = 0; d < 4; ++d) o[d] = f32x16{};
    const bf16_t* Qw = Qb + (size_t)(wid * 32 + r32) * 64 + hi * 8;
#pragma unroll
    for (int d0 = 0; d0 < 4; ++d0) qr[d0] = *reinterpret_cast<const bf16x8*>(Qw + d0 * 16);
    const int sr = tid >> 4, sc = (tid & 15) * 8, vst0 = v_st(sr, sc), vst1 = v_st(32 + sr, sc);
    const int kr = tid >> 3, kcb = (tid & 7) * 16, kst = AT_KSWZ(kr, kcb);
    const int vb0 = (int)(uintptr_t)V_lds + v_rd_base(lane);
    struct { bf16x8 vs0, vs1, ks0; } sr_[1];
#define AT_SLOAD(i, k0) do { sr_[i].vs0 = *reinterpret_cast<const bf16x8*>(&Vh[(size_t)((k0) + sr) * 128 + sc]); sr_[i].vs1 = *reinterpret_cast<const bf16x8*>(&Vh[(size_t)((k0) + 32 + sr) * 128 + sc]); \
    sr_[i].ks0 = *reinterpret_cast<const bf16x8*>(&Kh[(size_t)((k0) + kr) * 64 + (tid & 7) * 8]); } while (0)
#define AT_SWRITE(b, i) do { *(bf16x8*)(V_lds + (b) * SHM_V + vst0) = sr_[i].vs0; *(bf16x8*)(V_lds + (b) * SHM_V + vst1) = sr_[i].vs1; *(bf16x8*)(K_lds + (b) * SHM_K + kst) = sr_[i].ks0; } while (0)
#define AT_SWAIT() asm volatile("s_waitcnt vmcnt(0)" ::: "memory")
#define AT_RESC(a) do { if (__any((a) < 1.f)) { _Pragma("unroll") for (int d = 0; d < 4; ++d) _Pragma("unroll") for (int r = 0; r < 16; ++r) o[d][r] *= (a); } } while (0)
    const unsigned cv_ldo = (unsigned)(((tid >> 4) * 2 * 2048 + (tid & 15) * 4) * 4), cv_sto = (unsigned)((tid >> 3) * 2048 + 8 * (tid & 7));
    const int cv_lw = OFF_CV + (4 * (tid & 15)) * 68 + 2 * (tid >> 4), cv_lr = OFF_CV + (tid >> 3) * 68 + 8 * (tid & 7);
    f32x4 cvA = f32x4{}, cvB = f32x4{}; unsigned cvr0 = 0, cvr1 = 0;
#define AT_CVT2(x, y) __builtin_amdgcn_cvt_pk_fp8_f32(__builtin_amdgcn_fmed3f((x) * F8_WSCALE, -448.f, 448.f), __builtin_amdgcn_fmed3f((y) * F8_WSCALE, -448.f, 448.f), 0, false)
#define AT_CV_READ() do { if (cv.pend) { const char* t_ = lds + cv_lr + ((cv.ci - 1) & 1) * CV_TILE; cvr0 = *(const unsigned*)t_; cvr1 = *(const unsigned*)(t_ + 4); } } while (0)
#define AT_CV_LOAD() do { if (cv.ci < CV_NITEM) { const float* s_; unsigned char* d_; cv_ptrs(F, cv.ci, s_, d_); \
        cvA = __builtin_nontemporal_load((const f32x4*)((const char*)s_ + (size_t)cv_ldo)); cvB = __builtin_nontemporal_load((const f32x4*)((const char*)s_ + 8192 + (size_t)cv_ldo)); } } while (0)
#define AT_CV_STORE() do { if (cv.pend) { const float* s_; unsigned char* d_; cv_ptrs(F, cv.ci - 1, s_, d_); __builtin_nontemporal_store((u32x2){cvr0, cvr1}, (u32x2*)(d_ + (size_t)cv_sto)); cv.pend = 0; } } while (0)
#define AT_CV_TAIL() do { if (cv.ci < CV_NITEM) { char* t_ = lds + cv_lw + (cv.ci & 1) * CV_TILE; \
        _Pragma("unroll") for (int j_ = 0; j_ < 4; ++j_) *(unsigned short*)(t_ + j_ * 68) = (unsigned short)AT_CVT2(cvA[j_], cvB[j_]); cv.pend = 1; ++cv.ci; } } while (0)
    f32x16 pA0, pA1, pB0, pB1; float alA, alB; bf16x8 pa0, pa1, pa2, pa3; constexpr int NT = S / 64;
    constexpr int SE = 0;
    {
        bf16x8 v10 = *reinterpret_cast<const bf16x8*>(&Vh[(size_t)(64 + sr) * 128 + sc]), v11 = *reinterpret_cast<const bf16x8*>(&Vh[(size_t)(96 + sr) * 128 + sc]);
        bf16x8 k10 = *reinterpret_cast<const bf16x8*>(&Kh[(size_t)(64 + kr) * 64 + (tid & 7) * 8]);
        AT_SLOAD(SE, 0); asm volatile("s_waitcnt vmcnt(0)" ::: "memory");
        __syncthreads();
        AT_SWRITE(0, SE);
        *(bf16x8*)(V_lds + SHM_V + vst0) = v10; *(bf16x8*)(V_lds + SHM_V + vst1) = v11; *(bf16x8*)(K_lds + SHM_K + kst) = k10;
        __syncthreads();
    }
    qkt(pA0, pA1, K_lds, qr, negm, r32, hi); partialSM(pA0, pA1, m_ref, negm, alA);
    int s_prev = 0, s_cur = 1, s_next = 2;
#define AT_ROT() do { const int t_ = s_prev; s_prev = s_cur; s_cur = s_next; s_next = t_; } while (0)
#define AT_STEP(X0, X1, Y0, Y1, alX, alY, j_, LOADN) do { \
        AT_CV_READ(); AT_CV_LOAD(); AT_SBAR(); qkt(X0, X1, K_lds + s_cur * SHM_K, qr, negm, r32, hi); \
        finishSM(Y0, Y1, alY, l_reg, pa0, pa1, pa2, pa3); AT_SBAR(); \
        if (LOADN) { AT_SLOAD(SE, ((j_) + 1) * 64); } AT_CV_STORE(); AT_SBAR(); \
        pv_all_sm(o, vb0 + s_prev * SHM_V, pa0, pa1, pa2, pa3, X0, X1, m_ref, negm, alX); \
        AT_SWAIT(); if (LOADN) { AT_SWRITE(s_next, SE); } AT_CV_TAIL(); \
        AT_RESC(alX); __syncthreads(); AT_ROT(); } while (0)
    for (int j = 1; j + 2 < NT; j += 2) {
        AT_STEP(pB0, pB1, pA0, pA1, alB, alA, j, true);
        AT_STEP(pA0, pA1, pB0, pB1, alA, alB, j + 1, true);
    }
    AT_STEP(pB0, pB1, pA0, pA1, alB, alA, NT - 1, false);
    AT_CV_READ(); AT_CV_STORE();
    finishSM(pB0, pB1, alB, l_reg, pa0, pa1, pa2, pa3); AT_SBAR();
    pv_all(o, vb0 + s_prev * SHM_V, pa0, pa1, pa2, pa3);
#undef AT_STEP
#undef AT_ROT
    l_out = l_reg;
#undef AT_CVT2
#undef AT_CV_READ
#undef AT_CV_LOAD
#undef AT_CV_STORE
#undef AT_CV_TAIL
#undef AT_SLOAD
#undef AT_SWRITE
#undef AT_SWAIT
#undef AT_RESC
}
}

DI void attn_unit(const Frame& F, att::CvRide& cv, int bh, int qb, float lam) {
    using namespace att;
    const int tid = tid_fresh(F.wave), lane = tid & 63, wid = tid >> 6, r32 = lane & 31, hi = lane >> 5;
    const bf16_t* QD = (const bf16_t*)(F.ws + WS_QD); const bf16_t* KD = (const bf16_t*)(F.ws + WS_KD); const bf16_t* VD = (const bf16_t*)(F.ws + WS_VD);
    unsigned* stash = (unsigned*)(F.lds + OFF_ST) + wid * 2048;
    const bf16_t* Vh = VD + (size_t)bh * S * 128;
    f32x16 o[4]; float l;
    attn_pass(F, cv, QD + ((size_t)(bh * 2 + 0) * S + qb * 256) * 64, KD + (size_t)(bh * 2 + 0) * S * 64, Vh, (char*)F.lds, o, l, F.wave);
    { const float rl = 1.f / l;
#pragma unroll
      for (int d = 0; d < 4; ++d)
#pragma unroll
          for (int r = 0; r < 16; r += 2) stash[(d * 8 + (r >> 1)) * 64 + lane] = pk2(o[d][r] * rl, o[d][r + 1] * rl); }
    attn_pass(F, cv, QD + ((size_t)(bh * 2 + 1) * S + qb * 256) * 64, KD + (size_t)(bh * 2 + 1) * S * 64, Vh, (char*)F.lds, o, l, F.wave);
    { const float rl = lam / l; float ss = 0.f;
#pragma unroll
      for (int d = 0; d < 4; ++d)
#pragma unroll
          for (int r = 0; r < 16; r += 2) { const unsigned w = stash[(d * 8 + (r >> 1)) * 64 + lane]; o[d][r] = bflo(w) - o[d][r] * rl; o[d][r + 1] = bfhi(w) - o[d][r + 1] * rl; ss += o[d][r] * o[d][r] + o[d][r + 1] * o[d][r + 1]; }
      { auto rr = __builtin_amdgcn_permlane32_swap(__float_as_uint(ss), __float_as_uint(ss), false, false); ss = __uint_as_float(rr[0]) + __uint_as_float(rr[1]); }
      const float rs = rsqrtf(ss * (1.f / 128.f) + NORM_EPS) * (1.f - LAM_INIT);
      const float* gain = (const float*)F.in[I_SUBLN];
      const int b = bh >> 3, h = bh & 7;
      f32x4 gq[4][4];
#pragma unroll
      for (int d = 0; d < 4; ++d)
#pragma unroll
          for (int g = 0; g < 4; ++g) gq[d][g] = *(const f32x4*)(gain + 32 * d + 8 * g + 4 * hi);
      bf16_t* obase = (bf16_t*)(F.ws + WS_MIXIN) + (size_t)(b * S + qb * 256 + wid * 32) * D + h * 128;
      char* tb = (char*)stash;
#pragma unroll
      for (int hf = 0; hf < 2; ++hf) {
#pragma unroll
          for (int dd = 0; dd < 2; ++dd)
#pragma unroll
              for (int gp = 0; gp < 2; ++gp) { const int d = 2 * hf + dd, g0 = 2 * gp, g1 = g0 + 1; const f32x4 ga = gq[d][g0], gb = gq[d][g1];
                  const unsigned a0 = pk2(o[d][4 * g0] * rs * ga[0], o[d][4 * g0 + 1] * rs * ga[1]), a1 = pk2(o[d][4 * g0 + 2] * rs * ga[2], o[d][4 * g0 + 3] * rs * ga[3]);
                  const unsigned b0 = pk2(o[d][4 * g1] * rs * gb[0], o[d][4 * g1 + 1] * rs * gb[1]), b1 = pk2(o[d][4 * g1 + 2] * rs * gb[2], o[d][4 * g1 + 3] * rs * gb[3]);
                  auto r0 = __builtin_amdgcn_permlane32_swap(a0, b0, false, false); auto r1 = __builtin_amdgcn_permlane32_swap(a1, b1, false, false);
                  char* wp = tb + r32 * 136 + (32 * dd + 16 * gp + 8 * hi) * 2;
                  *(u32x2*)wp = (u32x2){r0[0], r1[0]}; *(u32x2*)(wp + 8) = (u32x2){r0[1], r1[1]}; }
          asm volatile("s_waitcnt lgkmcnt(0)" ::: "memory");
#pragma unroll
          for (int q = 0; q < 4; ++q) { const int row = (lane >> 3) + 8 * q, ch = lane & 7; const char* rp = tb + row * 136 + ch * 16;
              const u32x2 lo = *(const u32x2*)rp, hi2 = *(const u32x2*)(rp + 8);
              *(u32x4*)(obase + (size_t)row * D + hf * 64 + ch * 8) = (u32x4){lo.x, lo.y, hi2.x, hi2.y}; }
          asm volatile("s_waitcnt lgkmcnt(0)" ::: "memory");
      } }
}
DI void convert_experts_slice(const Frame& F);
DI void ph_attn(const Frame& F) {
    const float lam = diff_lambda((const float*)F.in[I_LQ1], (const float*)F.in[I_LK1], (const float*)F.in[I_LQ2], (const float*)F.in[I_LK2], F.lane);
    const int x = F.wg & 7, j = F.wg >> 3;
    if (F.nwg == 256) { att::CvRide cv{0, 0};
        attn_unit(F, cv, 0 * 16 + x * 2 + (j >> 4), j & 15, lam);
        attn_unit(F, cv, 1 * 16 + x * 2 + (j >> 4), j & 15, lam); }
    else { att::CvRide cv{att::CV_NITEM, 0}; for (int u = F.wg; u < NB * NH * 16; u += F.nwg) attn_unit(F, cv, u >> 4, u & 15, lam); __syncthreads(); convert_experts_slice(F); __syncthreads(); }
}


namespace ret {
using att::bf16x8; using att::s16x4; using att::f32x16; using att::crow; using att::cvtpk; using att::v_st; using att::v_rd_base; using att::v_rd_off; using att::tr_read;
#define RT_KSWZ(row, colB) ((row) * 256 + ((colB) ^ (((row) & 7) << 4)))
DI bf16x8 scale8(bf16x8 v, float s) { const u32x4 w = __builtin_bit_cast(u32x4, v); u32x4 o; o.x = cvtpk(bflo(w.x) * s, bfhi(w.x) * s); o.y = cvtpk(bflo(w.y) * s, bfhi(w.y) * s); o.z = cvtpk(bflo(w.z) * s, bfhi(w.z) * s); o.w = cvtpk(bflo(w.w) * s, bfhi(w.w) * s); return __builtin_bit_cast(bf16x8, o); }
#define RT_PK(L, H) (bf16x8){L[0], L[1], L[2], L[3], H[0], H[1], H[2], H[3]}
template <int TOFF> DI void kv_step4(f32x16& acc, int vbK, int vbV) {
    const s16x4 ka0 = tr_read<TOFF + v_rd_off(0, 0, 0)>(vbK), kb0 = tr_read<TOFF + v_rd_off(0, 0, 1)>(vbK), va0 = tr_read<TOFF + v_rd_off(0, 0, 0)>(vbV), vb0 = tr_read<TOFF + v_rd_off(0, 0, 1)>(vbV);
    const s16x4 ka1 = tr_read<TOFF + v_rd_off(0, 1, 0)>(vbK), kb1 = tr_read<TOFF + v_rd_off(0, 1, 1)>(vbK), va1 = tr_read<TOFF + v_rd_off(0, 1, 0)>(vbV), vb1 = tr_read<TOFF + v_rd_off(0, 1, 1)>(vbV);
    const s16x4 ka2 = tr_read<TOFF + v_rd_off(0, 2, 0)>(vbK), kb2 = tr_read<TOFF + v_rd_off(0, 2, 1)>(vbK), va2 = tr_read<TOFF + v_rd_off(0, 2, 0)>(vbV), vb2 = tr_read<TOFF + v_rd_off(0, 2, 1)>(vbV);
    const s16x4 ka3 = tr_read<TOFF + v_rd_off(0, 3, 0)>(vbK), kb3 = tr_read<TOFF + v_rd_off(0, 3, 1)>(vbK), va3 = tr_read<TOFF + v_rd_off(0, 3, 0)>(vbV), vb3 = tr_read<TOFF + v_rd_off(0, 3, 1)>(vbV);
    asm volatile("s_waitcnt lgkmcnt(0)" ::: "memory"); __builtin_amdgcn_sched_barrier(0);
    acc = __builtin_amdgcn_mfma_f32_32x32x16_bf16(RT_PK(ka0, kb0), RT_PK(va0, vb0), acc, 0, 0, 0);
    acc = __builtin_amdgcn_mfma_f32_32x32x16_bf16(RT_PK(ka1, kb1), RT_PK(va1, vb1), acc, 0, 0, 0);
    acc = __builtin_amdgcn_mfma_f32_32x32x16_bf16(RT_PK(ka2, kb2), RT_PK(va2, vb2), acc, 0, 0, 0);
    acc = __builtin_amdgcn_mfma_f32_32x32x16_bf16(RT_PK(ka3, kb3), RT_PK(va3, vb3), acc, 0, 0, 0);
}
}

DI void state_unit(const Frame& F, int u) {
    using namespace ret;
    const int tid = tid_fresh(F.wave), lane = tid & 63, hi = lane >> 5;
    const int eh = u & 1, dkh = (u >> 1) & 1, dir = (u >> 2) & 1, bh = u >> 3, h = bh & 7;
    const float* logit = (const float*)F.in[I_DECAY];
    const float lg = log2f(1.f / (1.f + __expf(-logit[dir * 8 + h])));
    const float cd = exp2f(128.f * lg);
    char* lds = (char*)F.lds;
    const bf16_t* RK = (const bf16_t*)(F.ws + WS_RK) + (size_t)bh * S * 128 + dkh * 64; const bf16_t* RV = (const bf16_t*)(F.ws + WS_RV) + (size_t)bh * S * 128 + eh * 64;
    bf16_t* ST = (bf16_t*)(F.ws + WS_ST) + (size_t)((bh * 2 + dir) * 32) * 16384;
    const int srow = tid >> 3, sch = tid & 7;
    float kdec[2];
#pragma unroll
    for (int i = 0; i < 2; ++i) { const int j = srow + 64 * i; kdec[i] = exp2f(lg * (float)(dir ? j : 127 - j)); }
    int kst[2], vst[2];
#pragma unroll
    for (int i = 0; i < 2; ++i) { const int j = srow + 64 * i; kst[i] = (j >> 6) * 16384 + v_st(j & 63, 8 * sch); vst[i] = 32768 + (j >> 6) * 16384 + v_st(j & 63, 8 * sch); }
    const int grp = F.wave >> 2;
    const int rb = (F.wave >> 1) & 1, cb = F.wave & 1;
    const int vbK = (int)(uintptr_t)lds + v_rd_base(lane) + rb * 512, vbV = (int)(uintptr_t)(lds + 32768) + v_rd_base(lane) + cb * 512;
    f32x16 acc = f32x16{};
    bf16x8 kA[2], vA[2], kB[2], vB[2], kC[2], vC[2];
    const unsigned goff = (unsigned)((srow * 128 + 8 * sch) * 2);
#define ST_LOAD(KR, VR, it_) do { const int itc_ = (it_) < 32 ? (it_) : 31; const int n_ = dir ? 31 - itc_ : itc_; unsigned o_ = goff; asm volatile("" : "+v"(o_)); \
    const GAS char* kp_ = (const GAS char*)(RK + (size_t)n_ * 16384); const GAS char* vp_ = (const GAS char*)(RV + (size_t)n_ * 16384); \
    KR[0] = *(const GAS bf16x8*)(kp_ + (size_t)o_); KR[1] = *(const GAS bf16x8*)(kp_ + 16384 + (size_t)o_); VR[0] = *(const GAS bf16x8*)(vp_ + (size_t)o_); VR[1] = *(const GAS bf16x8*)(vp_ + 16384 + (size_t)o_); } while (0)
#define ST_STEP(KR, VR, it_) do { const int n = dir ? 31 - (it_) : (it_); \
        _Pragma("unroll") for (int i = 0; i < 2; ++i) { *(bf16x8*)(lds + kst[i]) = scale8(KR[i], kdec[i]); *(bf16x8*)(lds + vst[i]) = VR[i]; } \
        {   \
              \
            char* sw_ = lds + 65536 + grp * 8704 + (cb * 32 + (lane & 31)) * 136 + (rb * 32 + 4 * hi) * 2; \
            _Pragma("unroll") for (int g = 0; g < 4; ++g) *(u32x2*)(sw_ + 16 * g) = (u32x2){cvtpk(acc[4 * g], acc[4 * g + 1]), cvtpk(acc[4 * g + 2], acc[4 * g + 3])}; } \
        __syncthreads(); \
        ST_LOAD(KR, VR, (it_) + 3); \
        { const char* sr_ = lds + 65536 + srow * 136 + sch * 16; const u32x2 l0_ = *(const u32x2*)sr_, h0_ = *(const u32x2*)(sr_ + 8), l1_ = *(const u32x2*)(sr_ + 8704), h1_ = *(const u32x2*)(sr_ + 8712); \
          *(u32x4*)(ST + (size_t)n * 16384 + (size_t)(eh * 64 + srow) * 128 + dkh * 64 + sch * 8) = \
              (u32x4){cvtpk(bflo(l0_.x) + bflo(l1_.x), bfhi(l0_.x) + bfhi(l1_.x)), cvtpk(bflo(l0_.y) + bflo(l1_.y), bfhi(l0_.y) + bfhi(l1_.y)), \
                      cvtpk(bflo(h0_.x) + bflo(h1_.x), bfhi(h0_.x) + bfhi(h1_.x)), cvtpk(bflo(h0_.y) + bflo(h1_.y), bfhi(h0_.y) + bfhi(h1_.y))}; } \
        { _Pragma("unroll") for (int r = 0; r < 16; ++r) acc[r] *= cd; \
          if (grp == 0) kv_step4<0>(acc, vbK, vbV); else kv_step4<16384>(acc, vbK, vbV); } \
        __syncthreads(); } while (0)
    ST_LOAD(kA, vA, 0); ST_LOAD(kB, vB, 1); ST_LOAD(kC, vC, 2);
    for (int it = 0; it < 30; it += 3) { ST_STEP(kA, vA, it); ST_STEP(kB, vB, it + 1); ST_STEP(kC, vC, it + 2); }
    ST_STEP(kA, vA, 30); ST_STEP(kB, vB, 31);
#undef ST_STEP
#undef ST_LOAD
}

DI void retout_unit(const Frame& F, int u) {
    using namespace ret;
    const int tid = tid_fresh(F.wave), lane = tid & 63, wid = tid >> 6, r32 = lane & 31, hi = lane >> 5;
    const int bh = u >> 4, h = bh & 7, b = bh >> 3, cs = F.wave >> 2, w4 = F.wave & 3, n = 2 * (u & 15) + cs;
    (void)wid;
    const float* logit = (const float*)F.in[I_DECAY];
    const float lgf = log2f(1.f / (1.f + __expf(-logit[h]))), lgb = log2f(1.f / (1.f + __expf(-logit[8 + h])));
    char* lds = (char*)F.lds; char* Kc = lds + cs * 65536; char* Vc = Kc + 32768;
    const bf16_t* RQ = (const bf16_t*)(F.ws + WS_RQ) + ((size_t)bh * S + n * 128) * 128; const bf16_t* RK = (const bf16_t*)(F.ws + WS_RK) + ((size_t)bh * S + n * 128) * 128;
    const bf16_t* RV = (const bf16_t*)(F.ws + WS_RV) + ((size_t)bh * S + n * 128) * 128;
    const int js = w4 * 32 + r32;
    const size_t tok = (size_t)b * S + n * 128 + js;
    {
        const int t2 = tid & 255;
#pragma unroll
        for (int i = 0; i < 8; ++i) { const int p = t2 + 256 * i, row = p >> 4, ch = p & 15;
            *(bf16x8*)(Kc + RT_KSWZ(row, ch * 16)) = *reinterpret_cast<const bf16x8*>(RK + (size_t)row * 128 + 8 * ch);
            *(bf16x8*)(Vc + (row >> 6) * 16384 + v_st(row & 63, 8 * ch)) = *reinterpret_cast<const bf16x8*>(RV + (size_t)row * 128 + 8 * ch); }
    }
    bf16x8 qr[8];
    { const bf16_t* Qw = RQ + (size_t)(w4 * 32 + r32) * 128 + hi * 8;
#pragma unroll
      for (int ks = 0; ks < 8; ++ks) qr[ks] = *reinterpret_cast<const bf16x8*>(Qw + ks * 16); }
    f32x16 acc[4];
#pragma unroll
    for (int d = 0; d < 4; ++d) acc[d] = f32x16{};
    int kad[4];
#pragma unroll
    for (int kl = 0; kl < 4; ++kl) kad[kl] = RT_KSWZ(r32, (kl * 16 + hi * 8) * 2);
    __syncthreads();
#pragma unroll
    for (int t = 0; t < 2; ++t) {
        f32x16 p0 = f32x16{}, p1 = f32x16{};
#pragma unroll
        for (int ks = 0; ks < 8; ++ks) {
            const bf16x8 k0 = *reinterpret_cast<const bf16x8*>(Kc + kad[ks & 3] + (ks >> 2) * 128 + t * 16384);
            const bf16x8 k1 = *reinterpret_cast<const bf16x8*>(Kc + kad[ks & 3] + (ks >> 2) * 128 + t * 16384 + 8192);
            p0 = __builtin_amdgcn_mfma_f32_32x32x16_bf16(k0, qr[ks], p0, 0, 0, 0);
            p1 = __builtin_amdgcn_mfma_f32_32x32x16_bf16(k1, qr[ks], p1, 0, 0, 0);
            if (ks & 1) asm volatile("" ::: "memory"); }
#pragma unroll
        for (int r = 0; r < 16; ++r) { const int jm = t * 64 + crow(r, hi); const int d0 = js - jm, d1 = d0 - 32;
            p0[r] *= __builtin_amdgcn_exp2f((d0 >= 0 ? lgf : -lgb) * (float)d0);
            p1[r] *= __builtin_amdgcn_exp2f((d1 >= 0 ? lgf : -lgb) * (float)d1); }
        bf16x8 pa0, pa1, pa2, pa3;
#define RT_PK4(P, BASE, OUT) do { unsigned a0 = cvtpk(P[BASE + 0], P[BASE + 1]), a1 = cvtpk(P[BASE + 2], P[BASE + 3]);   \
    unsigned b0 = cvtpk(P[BASE + 4], P[BASE + 5]), b1 = cvtpk(P[BASE + 6], P[BASE + 7]);                              \
    auto r0 = __builtin_amdgcn_permlane32_swap(a0, b0, false, false); auto r1 = __builtin_amdgcn_permlane32_swap(a1, b1, false, false); \
    u32x4 w = {r0[0], r1[0], r0[1], r1[1]}; OUT = __builtin_bit_cast(bf16x8, w); } while (0)
        RT_PK4(p0, 0, pa0); RT_PK4(p0, 8, pa1); RT_PK4(p1, 0, pa2); RT_PK4(p1, 8, pa3);
#undef RT_PK4
        att::pv_all(acc, (int)(uintptr_t)(Vc + t * 16384) + v_rd_base(lane), pa0, pa1, pa2, pa3);
    }
    __syncthreads();
    {
        const bf16_t* Sf = (const bf16_t*)(F.ws + WS_ST) + (size_t)((bh * 2 + 0) * 32 + n) * 16384;
        const bf16_t* Sb = (const bf16_t*)(F.ws + WS_ST) + (size_t)((bh * 2 + 1) * 32 + n) * 16384;
        const char* sfb = pg8::uni((const char*)Sf); const char* sbb = pg8::uni((const char*)Sb);
        const unsigned ldk = (unsigned)__builtin_amdgcn_readfirstlane((unsigned)(uintptr_t)Kc + (unsigned)w4 * 8192u), ldv = (unsigned)__builtin_amdgcn_readfirstlane((unsigned)(uintptr_t)Vc + (unsigned)w4 * 8192u);
        unsigned vo[2];
#pragma unroll
        for (int par = 0; par < 2; ++par) { const int rowl = par * 4 + (lane >> 4); vo[par] = (unsigned)((lane >> 4) * 256 + (((lane & 15) ^ (rowl & 7)) << 4)); }
#pragma unroll
        for (int i = 0; i < 8; ++i) {
            asm volatile("s_mov_b32 m0, %2\n\ts_nop 0\n\tglobal_load_lds_dwordx4 %0, %1" :: "v"(vo[i & 1]), "s"(sfb + (size_t)(w4 * 8 + i) * 1024), "s"(ldk + (unsigned)i * 1024u) : "memory", "m0");
            asm volatile("s_mov_b32 m0, %2\n\ts_nop 0\n\tglobal_load_lds_dwordx4 %0, %1" :: "v"(vo[i & 1]), "s"(sbb + (size_t)(w4 * 8 + i) * 1024), "s"(ldv + (unsigned)i * 1024u) : "memory", "m0");
        }
    }
    const float* gain = (const float*)F.in[I_RETG] + h * 128;
    const bf16_t* grow = (const bf16_t*)(F.ws + WS_RG) + tok * 1024 + h * 128;
    asm volatile("s_waitcnt vmcnt(0)" ::: "memory");
    __syncthreads();
    const float rsf = exp2f(lgf * (float)(js + 1)), rsb = exp2f(lgb * (float)(128 - js));
#pragma unroll
    for (int dir = 0; dir < 2; ++dir) {
        const char* img = dir ? Vc : Kc; const float rs = dir ? rsb : rsf;
#pragma unroll
        for (int t = 0; t < 2; ++t) {
            f32x16 c0 = f32x16{}, c1 = f32x16{};
#pragma unroll
            for (int ks = 0; ks < 8; ++ks) {
                const bf16x8 s0 = *reinterpret_cast<const bf16x8*>(img + kad[ks & 3] + (ks >> 2) * 128 + t * 16384);
                const bf16x8 s1 = *reinterpret_cast<const bf16x8*>(img + kad[ks & 3] + (ks >> 2) * 128 + t * 16384 + 8192);
                c0 = __builtin_amdgcn_mfma_f32_32x32x16_bf16(s0, qr[ks], c0, 0, 0, 0);
                c1 = __builtin_amdgcn_mfma_f32_32x32x16_bf16(s1, qr[ks], c1, 0, 0, 0);
                if (ks & 1) asm volatile("" ::: "memory"); }
#pragma unroll
            for (int r = 0; r < 16; ++r) { acc[2 * t][r] += rs * c0[r]; acc[2 * t + 1][r] += rs * c1[r]; }
        }
    }
    f32x4 gq[4][4];
#pragma unroll
    for (int d = 0; d < 4; ++d)
#pragma unroll
        for (int g = 0; g < 4; ++g) gq[d][g] = *(const f32x4*)(gain + 32 * d + 8 * g + 4 * hi);
    u32x2 gtq[4][4];
#pragma unroll
    for (int d = 0; d < 4; ++d)
#pragma unroll
        for (int g = 0; g < 4; ++g) gtq[d][g] = *(const u32x2*)(grow + 32 * d + 8 * g + 4 * hi);
    float sm = 0.f;
#pragma unroll
    for (int d = 0; d < 4; ++d)
#pragma unroll
        for (int r = 0; r < 16; ++r) sm += acc[d][r];
    { auto rr = __builtin_amdgcn_permlane32_swap(__float_as_uint(sm), __float_as_uint(sm), false, false); sm = __uint_as_float(rr[0]) + __uint_as_float(rr[1]); }
    const float mu = sm * (1.f / 128.f); float sq = 0.f;
#pragma unroll
    for (int d = 0; d < 4; ++d)
#pragma unroll
        for (int r = 0; r < 16; ++r) { acc[d][r] -= mu; sq += acc[d][r] * acc[d][r]; }
    { auto rr = __builtin_amdgcn_permlane32_swap(__float_as_uint(sq), __float_as_uint(sq), false, false); sq = __uint_as_float(rr[0]) + __uint_as_float(rr[1]); }
    const float rs = rsqrtf(sq * (1.f / 128.f) + NORM_EPS);
    bf16_t* orow = (bf16_t*)(F.ws + WS_MIXIN) + tok * D + 1024 + h * 128;
#pragma unroll
    for (int d = 0; d < 4; ++d)
#pragma unroll
        for (int gp = 0; gp < 2; ++gp) { const int g0 = 2 * gp, g1 = g0 + 1; const f32x4 ga = gq[d][g0], gb = gq[d][g1]; const u32x2 ta = gtq[d][g0], tb = gtq[d][g1];
            const unsigned a0 = pk2(acc[d][4 * g0] * rs * ga[0] * bflo(ta.x), acc[d][4 * g0 + 1] * rs * ga[1] * bfhi(ta.x)), a1 = pk2(acc[d][4 * g0 + 2] * rs * ga[2] * bflo(ta.y), acc[d][4 * g0 + 3] * rs * ga[3] * bfhi(ta.y));
            const unsigned b0 = pk2(acc[d][4 * g1] * rs * gb[0] * bflo(tb.x), acc[d][4 * g1 + 1] * rs * gb[1] * bfhi(tb.x)), b1 = pk2(acc[d][4 * g1 + 2] * rs * gb[2] * bflo(tb.y), acc[d][4 * g1 + 3] * rs * gb[3] * bfhi(tb.y));
            auto r0 = __builtin_amdgcn_permlane32_swap(a0, b0, false, false); auto r1 = __builtin_amdgcn_permlane32_swap(a1, b1, false, false);
            *(u32x4*)(orow + 32 * d + 16 * gp + 8 * hi) = (u32x4){r0[0], r1[0], r0[1], r1[1]}; }
    __syncthreads();
}
DI void ph_state(const Frame& F) {
    for (int v = F.wg; v < NB * NH * 8; v += F.nwg) { const int x = v & 7, idx = v >> 3; state_unit(F, (x + 8 * (idx >> 3)) * 8 + (idx & 7)); } }
DI void ph_retout(const Frame& F) { for (int u = F.wg; u < NB * NH * 16; u += F.nwg) retout_unit(F, u); }

DI void ph_prenorm(const Frame& F) {
    const float* x = (const float*)F.in[I_X]; const float* g = (const float*)F.in[I_GPREMIX];
    const float* mod = (const float*)(F.ws + WS_MOD);
    bf16_t* H = (bf16_t*)(F.ws + WS_H);
    const int gw = F.wg * NWAVES + F.wave, ngw = F.nwg * NWAVES;
    for (int r0 = gw * 8; r0 < M; r0 += ngw * 8) {
        const int b = r0 >> 12;
        const float* shift = mod + (size_t)b * 6 * D, * scale = shift + D;
        f32x4 pg[8], ps[8];
#pragma unroll
        for (int j = 0; j < 8; ++j) { const int d0 = 4 * F.lane + 256 * j; const f32x4 gg = *(const f32x4*)(g + d0), sc = *(const f32x4*)(scale + d0) + *(const f32x4*)(scale + MOD_HALF + d0); ps[j] = *(const f32x4*)(shift + d0) + *(const f32x4*)(shift + MOD_HALF + d0);
#pragma unroll
            for (int i = 0; i < 4; ++i) pg[j][i] = gg[i] * (1.f + sc[i]); }
        for (int m = r0; m < r0 + 8; m += 2) {
            const f32x4* xr = (const f32x4*)(x + (size_t)m * D) + F.lane;
            f32x4 v[8], w[8]; float ss = 0.f, ss2 = 0.f;
#pragma unroll
            for (int j = 0; j < 8; ++j) { v[j] = __builtin_nontemporal_load(xr + 64 * j); w[j] = __builtin_nontemporal_load(xr + 512 + 64 * j); }
#pragma unroll
            for (int j = 0; j < 8; ++j) { ss += (v[j][0] * v[j][0] + v[j][1] * v[j][1]) + (v[j][2] * v[j][2] + v[j][3] * v[j][3]); ss2 += (w[j][0] * w[j][0] + w[j][1] * w[j][1]) + (w[j][2] * w[j][2] + w[j][3] * w[j][3]); }
            const float rstd = rsqrtf(wave_sum(ss) * (1.f / D) + NORM_EPS), rstd2 = rsqrtf(wave_sum(ss2) * (1.f / D) + NORM_EPS);
#pragma unroll
            for (int j = 0; j < 8; ++j) {
                float o[4], o2[4];
#pragma unroll
                for (int i = 0; i < 4; ++i) { o[i] = v[j][i] * rstd * pg[j][i] + ps[j][i]; o2[i] = w[j][i] * rstd2 * pg[j][i] + ps[j][i]; }
#if F8_IN
                ((unsigned*)((unsigned char*)H + (size_t)m * D))[F.lane + 64 * j] = pk4_f8(o[0] * F8_HSCALE, o[1] * F8_HSCALE, o[2] * F8_HSCALE, o[3] * F8_HSCALE);
                ((unsigned*)((unsigned char*)H + (size_t)(m + 1) * D))[F.lane + 64 * j] = pk4_f8(o2[0] * F8_HSCALE, o2[1] * F8_HSCALE, o2[2] * F8_HSCALE, o2[3] * F8_HSCALE);
#else
                ((u32x2*)(H + (size_t)m * D) + F.lane)[64 * j] = (u32x2){pk2(o[0], o[1]), pk2(o[2], o[3])};
                ((u32x2*)(H + (size_t)(m + 1) * D) + F.lane)[64 * j] = (u32x2){pk2(o2[0], o2[1]), pk2(o2[2], o2[3])};
#endif
            }
        }
    }
}

DI void ph_rowpass(const Frame& F) {
    const float* x = (const float*)F.in[I_X]; const float* gpm = (const float*)F.in[I_GPOSTMIX]; const float* gpf = (const float*)F.in[I_GPREFFN];
    const float* wr = (const float*)F.in[I_WROUTER];
    const float* mod = (const float*)(F.ws + WS_MOD);
    const bf16_t* MIX = (const bf16_t*)(F.ws + WS_MIX);
    bf16_t* X1 = (bf16_t*)(F.ws + WS_X1); bf16_t* H2 = (bf16_t*)(F.ws + WS_H); float* AFF = (float*)(F.ws + WS_AFF);
    f32x4* wl = (f32x4*)F.lds;
    {
        f32x4 wt[16];
#pragma unroll
        for (int i = 0; i < 16; ++i) wt[i] = ((const f32x4*)wr)[F.tid + NTHR * i];
#pragma unroll
        for (int i = 0; i < 16; ++i) { const int si = F.tid + NTHR * i, d = si >> 2, q = si & 3; wl[((((d >> 8) * 4 + (d & 3)) * 4 + q) << 6) + ((d & 255) >> 2)] = wt[i]; }
    }
    f32x4* pgm = (f32x4*)(F.lds + 131072); f32x4* pgf = pgm + 512; f32x4* psh = pgf + 512;
    for (int blk = F.wg; blk < M / 64; blk += F.nwg) {
        const int bb = (blk * 64) >> 12; const float* mb = mod + (size_t)bb * 6 * D;
        __syncthreads();
        { const int d4 = F.tid; const f32x4 a = ((const f32x4*)gpm)[d4], g1 = ((const f32x4*)(mb + 2 * D))[d4] + ((const f32x4*)(mb + MOD_HALF + 2 * D))[d4], c = ((const f32x4*)gpf)[d4], sc = ((const f32x4*)(mb + 4 * D))[d4] + ((const f32x4*)(mb + MOD_HALF + 4 * D))[d4];
          pgm[d4] = a * g1; pgf[d4] = c * (1.f + sc); psh[d4] = ((const f32x4*)(mb + 3 * D))[d4] + ((const f32x4*)(mb + MOD_HALF + 3 * D))[d4]; }
        if ((blk & 63) == 0) { const int d4 = F.tid; ((f32x4*)((float*)(F.ws + WS_MOD) + 2 * MOD_HALF + (size_t)bb * D))[d4] = ((const f32x4*)(mb + 5 * D))[d4] + ((const f32x4*)(mb + MOD_HALF + 5 * D))[d4]; }
        __syncthreads();
      for (int m = blk * 64 + F.wave * 8; m < blk * 64 + F.wave * 8 + 8; ++m) {
        const int b = m >> 12, s = m & 4095;
        const u32x2* mr = (const u32x2*)(MIX + (size_t)m * D) + F.lane;
        f32x4 v[8]; float ss = 0.f;
#pragma unroll
        for (int j = 0; j < 8; ++j) { const u32x2 w = __builtin_nontemporal_load(mr + 64 * j); v[j] = (f32x4){bflo(w.x), bfhi(w.x), bflo(w.y), bfhi(w.y)}; ss += (v[j][0] * v[j][0] + v[j][1] * v[j][1]) + (v[j][2] * v[j][2] + v[j][3] * v[j][3]); }
        const f32x4* xr = (const f32x4*)(x + (size_t)m * D) + F.lane;
        f32x4 xc[8];
#pragma unroll
        for (int j = 0; j < 8; ++j) xc[j] = __builtin_nontemporal_load(xr + 64 * j);
        const float rstd = rsqrtf(wave_sum(ss) * (1.f / D) + NORM_EPS);
        u32x2* x1r = (u32x2*)(X1 + (size_t)m * D) + F.lane;
        float ss2 = 0.f;
#pragma unroll
        for (int j = 0; j < 8; ++j) {
            const f32x4 gg = pgm[F.lane + 64 * j], xv = xc[j];
#pragma unroll
            for (int i = 0; i < 4; ++i) v[j][i] = xv[i] + (v[j][i] * rstd) * gg[i];
            x1r[64 * j] = (u32x2){pk2(v[j][0], v[j][1]), pk2(v[j][2], v[j][3])};
            ss2 += (v[j][0] * v[j][0] + v[j][1] * v[j][1]) + (v[j][2] * v[j][2] + v[j][3] * v[j][3]);
        }
        const float rstd2 = rsqrtf(wave_sum(ss2) * (1.f / D) + NORM_EPS);
        u32x2* h2r = (u32x2*)(H2 + (size_t)m * D) + F.lane;
        f32x2 lgp[8];
#pragma unroll
        for (int e = 0; e < 8; ++e) lgp[e] = (f32x2){0.f, 0.f};
#pragma unroll
        for (int j = 0; j < 8; ++j) {
            const f32x4 gg = pgf[F.lane + 64 * j], sh = psh[F.lane + 64 * j];
            float h[4];
#pragma unroll
            for (int i = 0; i < 4; ++i) h[i] = v[j][i] * rstd2 * gg[i] + sh[i];
#if F8_E1
            ((unsigned*)((unsigned char*)H2 + (size_t)m * D))[F.lane + 64 * j] = pk4_f8(h[0] * F8_HSCALE, h[1] * F8_HSCALE, h[2] * F8_HSCALE, h[3] * F8_HSCALE);
#else
            h2r[64 * j] = (u32x2){pk2(h[0], h[1]), pk2(h[2], h[3])};
#endif
#pragma unroll
            for (int i = 0; i < 4; ++i) v[j][i] = h[i];
        }
        {
            f32x4 wq0[4], wq1[4], wq2[4];
#define RT_LD(W, t_) do { _Pragma("unroll") for (int q = 0; q < 4; ++q) W[q] = wl[((((t_)) * 4 + q) << 6) + F.lane]; } while (0)
#define RT_FMA(W, t_) do { const float hv_ = v[(t_) >> 2][(t_) & 3]; const f32x2 hh = {hv_, hv_}; _Pragma("unroll") for (int q = 0; q < 4; ++q) { \
                lgp[2 * q] = __builtin_elementwise_fma(hh, (f32x2){W[q][0], W[q][1]}, lgp[2 * q]); lgp[2 * q + 1] = __builtin_elementwise_fma(hh, (f32x2){W[q][2], W[q][3]}, lgp[2 * q + 1]); } \
                asm volatile("" ::: "memory"); } while (0)
            RT_LD(wq0, 0); RT_LD(wq1, 1);
#pragma unroll
            for (int t = 0; t < 30; t += 3) { RT_LD(wq2, t + 2); RT_FMA(wq0, t); RT_LD(wq0, t + 3); RT_FMA(wq1, t + 1); RT_LD(wq1, t + 4); RT_FMA(wq2, t + 2); }
            RT_FMA(wq0, 30); RT_FMA(wq1, 31);
#undef RT_LD
#undef RT_FMA
        }
        float mx = -1e30f; float lg[16];
#pragma unroll
        for (int e = 0; e < 16; ++e) { lg[e] = wave_sum(lgp[e >> 1][e & 1]); mx = fmaxf(mx, lg[e]); }
        float den = 0.f;
#pragma unroll
        for (int e = 0; e < 16; ++e) { lg[e] = __expf(lg[e] - mx); den += lg[e]; }
        const float rden = 1.f / den;
        float mine = 0.f;
#pragma unroll
        for (int e = 0; e < 16; ++e) mine = (F.lane == e) ? lg[e] * rden : mine;
        if (F.lane < 16) AFF[((size_t)b * NE + F.lane) * S + s] = mine;
      }
    }
}

DI int block_scan_incl(int v, volatile LAS int* sw, int tid) {
    const int lane = tid & 63, wid = tid >> 6;
#pragma unroll
    for (int o = 1; o < 64; o <<= 1) { const int t = __shfl_up(v, o); if (lane >= o) v += t; }
    if (lane == 63) sw[wid] = v;
    __syncthreads();
    int off = 0;
    for (int i = 0; i < wid; ++i) off += sw[i];
    __syncthreads();
    return v + off;
}
DI void ph_topk(const Frame& F) {
    const float* AFF = (const float*)(F.ws + WS_AFF);
    int* rowmap = (int*)(F.ws + WS_ROWMAP); float* gatev = (float*)(F.ws + WS_GATEV); int* sel = (int*)(F.ws + WS_SEL);
    volatile LAS int* hist = (volatile LAS int*)F.ldsl;
    volatile LAS int* sw = (volatile LAS int*)(F.ldsl + 1024);
    volatile LAS int* bc = (volatile LAS int*)(F.ldsl + 1024 + 64);
    for (int u = F.wg; u < NB * NE; u += F.nwg) {
        const int b = u >> 4, e = u & 15;
        const float* a = AFF + (size_t)u * S;
        unsigned key[8];
        { const u32x4 k0 = *(const u32x4*)(a + F.tid * 8), k1 = *(const u32x4*)(a + F.tid * 8 + 4); key[0] = k0.x; key[1] = k0.y; key[2] = k0.z; key[3] = k0.w; key[4] = k1.x; key[5] = k1.y; key[6] = k1.z; key[7] = k1.w; }
        unsigned prefix = 0u; int krem = CAP;
#pragma unroll
        for (int pass = 0; pass < 4; ++pass) {
            const int shift = 24 - 8 * pass;
            if (F.tid < 256) hist[F.tid] = 0;
            __syncthreads();
#pragma unroll
            for (int j = 0; j < 8; ++j) { const bool match = (pass == 0) || ((key[j] >> (shift + 8)) == prefix); if (match) __hip_atomic_fetch_add((LAS int*)&hist[(key[j] >> shift) & 255u], 1, __ATOMIC_RELAXED, __HIP_MEMORY_SCOPE_WORKGROUP); }
            __syncthreads();
            const int mybin = 255 - F.tid;
            const int my = F.tid < 256 ? hist[mybin] : 0;
            const int suf = block_scan_incl(my, sw, F.tid);
            if (F.tid < 256 && suf >= krem && suf - my < krem) { bc[0] = mybin; bc[1] = krem - (suf - my); }
            __syncthreads();
            prefix = (prefix << 8) | (unsigned)bc[0]; krem = bc[1];
            __syncthreads();
        }
        int neq = 0;
#pragma unroll
        for (int j = 0; j < 8; ++j) neq += (key[j] == prefix) ? 1 : 0;
        int eqbase = block_scan_incl(neq, sw, F.tid) - neq;
        int nsel = 0; bool flag[8];
#pragma unroll
        for (int j = 0; j < 8; ++j) { const bool eq = key[j] == prefix; flag[j] = key[j] > prefix || (eq && eqbase < krem); eqbase += eq ? 1 : 0; nsel += flag[j] ? 1 : 0; }
        int slot = block_scan_incl(nsel, sw, F.tid) - nsel;
        int slv[8];
#pragma unroll
        for (int j = 0; j < 8; ++j) {
            const int s = F.tid * 8 + j;
            int sl = -1;
            if (flag[j]) { sl = slot++; if (sl < CAP) { rowmap[e * 2048 + b * CAP + sl] = b * S + s; gatev[e * 2048 + b * CAP + sl] = __uint_as_float(key[j]); } else sl = -1; }
            slv[j] = sl;
        }
        { u32x4* sp = (u32x4*)(sel + (size_t)u * S + F.tid * 8);
          sp[0] = (u32x4){(unsigned)slv[0], (unsigned)slv[1], (unsigned)slv[2], (unsigned)slv[3]}; sp[1] = (u32x4){(unsigned)slv[4], (unsigned)slv[5], (unsigned)slv[6], (unsigned)slv[7]}; }
        __syncthreads();
    }
}

DI void ph_final(const Frame& F) {
    const bf16_t* X1 = (const bf16_t*)(F.ws + WS_X1); const bf16_t* Y = (const bf16_t*)(F.ws + WS_Y); const int* sel = (const int*)(F.ws + WS_SEL);
    const float* mod = (const float*)(F.ws + WS_MOD); const float* g = (const float*)F.in[I_GPOSTFFN];
    const int gw = F.wg * NWAVES + F.wave, ngw = F.nwg * NWAVES;
    for (int r0 = 8 * gw; r0 < M; r0 += 8 * ngw) {
      const int b = r0 >> 12;
      const float* g2 = mod + 2 * MOD_HALF + (size_t)b * D;
      f32x4 ggt[8];
#pragma unroll
      for (int j = 0; j < 8; ++j) { const int d0 = 4 * F.lane + 256 * j; ggt[j] = *(const f32x4*)(g + d0) * *(const f32x4*)(g2 + d0); }
      int slots[8];
      { const u32x4* sp = (const u32x4*)(sel + ((size_t)b * NE + (F.lane & 15)) * S + (r0 & 4095)); const u32x4 s0 = sp[0], s1 = sp[1];
        slots[0] = (int)s0.x; slots[1] = (int)s0.y; slots[2] = (int)s0.z; slots[3] = (int)s0.w; slots[4] = (int)s1.x; slots[5] = (int)s1.y; slots[6] = (int)s1.z; slots[7] = (int)s1.w; }
#pragma unroll
      for (int pr = 0; pr < 4; ++pr) {
        const int m = r0 + 2 * pr;
        f32x4 acc[2][8];
#pragma unroll
        for (int rw = 0; rw < 2; ++rw)
#pragma unroll
            for (int j = 0; j < 8; ++j) acc[rw][j] = (f32x4){0.f, 0.f, 0.f, 0.f};
        const int myslot0 = slots[2 * pr], myslot1 = slots[2 * pr + 1];
        u32x2 xw[2][8];
#pragma unroll
        for (int rw = 0; rw < 2; ++rw)
#pragma unroll
            for (int j = 0; j < 8; ++j) xw[rw][j] = __builtin_nontemporal_load((const u32x2*)(X1 + (size_t)(m + rw) * D) + F.lane + 64 * j);
        unsigned m0 = (unsigned)(__ballot(myslot0 >= 0) & 0xFFFFull), m1 = (unsigned)(__ballot(myslot1 >= 0) & 0xFFFFull);
        while (m0 | m1) {
            int e_[4] = {0, 0, 0, 0}, s_[4] = {-1, -1, -1, -1};
            if (m0) { e_[0] = __builtin_ctz(m0); m0 &= m0 - 1; s_[0] = __builtin_amdgcn_readlane(myslot0, e_[0]); }
            if (m0) { e_[1] = __builtin_ctz(m0); m0 &= m0 - 1; s_[1] = __builtin_amdgcn_readlane(myslot0, e_[1]); }
            if (m1) { e_[2] = __builtin_ctz(m1); m1 &= m1 - 1; s_[2] = __builtin_amdgcn_readlane(myslot1, e_[2]); }
            if (m1) { e_[3] = __builtin_ctz(m1); m1 &= m1 - 1; s_[3] = __builtin_amdgcn_readlane(myslot1, e_[3]); }
#if F8_Y
            unsigned yv[4][8];
#pragma unroll
            for (int t = 0; t < 4; ++t) { const unsigned* yr = (const unsigned*)((const unsigned char*)Y + ((size_t)e_[t] * 2048 + b * CAP + (s_[t] < 0 ? 0 : s_[t])) * D) + F.lane;
#pragma unroll
                for (int j = 0; j < 8; ++j) yv[t][j] = __builtin_nontemporal_load(yr + 64 * j); }
#pragma unroll
            for (int t = 0; t < 4; ++t) { const float wt = s_[t] < 0 ? 0.f : 1.f;
#pragma unroll
                for (int j = 0; j < 8; ++j) { const int w = (int)yv[t][j]; const f32x2 lo = __builtin_amdgcn_cvt_pk_f32_fp8(w, false), hi = __builtin_amdgcn_cvt_pk_f32_fp8(w, true);
                    acc[t >> 1][j][0] += wt * lo.x; acc[t >> 1][j][1] += wt * lo.y; acc[t >> 1][j][2] += wt * hi.x; acc[t >> 1][j][3] += wt * hi.y; } }
#else
            u32x2 yv[4][8];
#pragma unroll
            for (int t = 0; t < 4; ++t) { const u32x2* yr = (const u32x2*)(Y + ((size_t)e_[t] * 2048 + b * CAP + (s_[t] < 0 ? 0 : s_[t])) * D) + F.lane;
#pragma unroll
                for (int j = 0; j < 8; ++j) yv[t][j] = yr[64 * j]; }
#pragma unroll
            for (int t = 0; t < 4; ++t) { const float wt = s_[t] < 0 ? 0.f : 1.f;
#pragma unroll
                for (int j = 0; j < 8; ++j) { const u32x2 w = yv[t][j]; acc[t >> 1][j][0] += wt * bflo(w.x); acc[t >> 1][j][1] += wt * bfhi(w.x); acc[t >> 1][j][2] += wt * bflo(w.y); acc[t >> 1][j][3] += wt * bfhi(w.y); } }
#endif
        }
#pragma unroll
        for (int rw = 0; rw < 2; ++rw) {
            float ss = 0.f;
#if F8_Y
#pragma unroll
            for (int j = 0; j < 8; ++j) acc[rw][j] = acc[rw][j] * (1.f / F8_YSCALE);
#endif
#pragma unroll
            for (int j = 0; j < 8; ++j) ss += (acc[rw][j][0] * acc[rw][j][0] + acc[rw][j][1] * acc[rw][j][1]) + (acc[rw][j][2] * acc[rw][j][2] + acc[rw][j][3] * acc[rw][j][3]);
            const float rstd = rsqrtf(wave_sum(ss) * (1.f / D) + NORM_EPS);
            f32x4* orow = (f32x4*)(F.out + (size_t)(m + rw) * D) + F.lane;
#pragma unroll
            for (int j = 0; j < 8; ++j) {
                const f32x4 xv = (f32x4){bflo(xw[rw][j].x), bfhi(xw[rw][j].x), bflo(xw[rw][j].y), bfhi(xw[rw][j].y)};
                f32x4 o;
#pragma unroll
                for (int i = 0; i < 4; ++i) { o[i] = xv[i] + (acc[rw][j][i] * rstd) * ggt[j][i]; }
                __builtin_nontemporal_store(o, orow + 64 * j);
            }
        }
      }
    }
}

__global__ void __launch_bounds__(NTHR, 2) mega(Args a) {
    extern __shared__ __attribute__((aligned(16))) unsigned char lds[];
    Frame F;
    F.lds = lds; F.ldsl = (LAS unsigned char*)lds; F.ws = a.ws; F.in = a.in; F.out = a.out;
    F.wg = blockIdx.x; F.nwg = gridDim.x;
    F.wave = __builtin_amdgcn_readfirstlane(threadIdx.x >> 6);
#define REFRESH() do { F.tid = tid_fresh(F.wave); F.lane = F.tid & 63; } while (0)
    REFRESH();
    for (int u = F.tid; u < (LDS_BYTES - LDSCTL_OFF) / 4; u += NTHR) ((unsigned*)(lds + LDSCTL_OFF))[u] = 0u;
    __syncthreads();
    const int lo = a.ph_lo, hi = a.ph_hi;
    XcdBarrier bar; bar.bar = (unsigned*)(a.ws + WS_CTL) + CW_BAR; bar.x = 0; bar.st = nullptr; bar.wave = F.wave;
    if (hi - lo > 1) bar = xcd_barrier_post((unsigned*)(a.ws + WS_CTL) + CW_BAR, (volatile LAS unsigned*)(lds + MISC_OFF + 32), F.wave);
#define IN(k) (lo <= (k) && (k) < hi)
#define SEAM(k) do { if (IN(k) && IN((k) + 1)) xcd_barrier(bar); } while (0)
    if (IN(PH_PREP)) { for (int rep_ = 0; rep_ < REP_PREP; ++rep_) { REFRESH(); ph_prep(F); } for (int rep_ = 0; rep_ < REP_CONV; ++rep_) { REFRESH(); ph_convert(F); } SEAM(PH_PREP); }
    if (IN(PH_PRENORM)) { for (int rep_ = 0; rep_ < REP_PRENORM; ++rep_) { REFRESH(); ph_prenorm(F); } SEAM(PH_PRENORM); }
#if OPT_IN
    if (IN(PH_INPROJ)) { for (int rep_ = 0; rep_ < REP_IN; ++rep_) { REFRESH(); ph_inproj(F); } SEAM(PH_INPROJ); }
#endif
    if (IN(PH_ATTN)) {
#if OPT_RET
        for (int rep_ = 0; rep_ < REP_STATE; ++rep_) { REFRESH(); ph_state(F); }
#endif
#if OPT_ATTN
        for (int rep_ = 0; rep_ < REP_ATTN; ++rep_) { REFRESH(); ph_attn(F); }
#endif
        SEAM(PH_ATTN); }
#if OPT_RET
    if (IN(PH_RETOUT)) { for (int rep_ = 0; rep_ < REP_RETOUT; ++rep_) { REFRESH(); ph_retout(F); } SEAM(PH_RETOUT); }
#endif
#if OPT_OUT
    if (IN(PH_OUTPROJ)) { REFRESH(); ph_outproj(F); SEAM(PH_OUTPROJ); }
#endif
    if (IN(PH_ROWPASS)) { for (int rep_ = 0; rep_ < REP_ROWPASS; ++rep_) { REFRESH(); ph_rowpass(F); } SEAM(PH_ROWPASS); }
    if (IN(PH_TOPK)) { for (int rep_ = 0; rep_ < REP_TOPK; ++rep_) { REFRESH(); ph_topk(F); } SEAM(PH_TOPK); }
#if OPT_E1
    if (IN(PH_E1)) { for (int rep_ = 0; rep_ < REP_E1; ++rep_) { REFRESH(); ph_e1(F); } SEAM(PH_E1); }
#endif
#if OPT_E2
    if (IN(PH_E2)) { REFRESH(); ph_e2(F); SEAM(PH_E2); }
#endif
    if (IN(PH_FINAL)) { for (int rep_ = 0; rep_ < REP_FINAL; ++rep_) { REFRESH(); ph_final(F); } }
#undef IN
#undef SEAM
}

static void launch_mega(const Args& base, int lo, int hi, int grid, hipStream_t stream) {
    Args a = base; a.ph_lo = lo; a.ph_hi = hi;
    hipLaunchKernelGGL(mega, dim3(grid), dim3(NTHR), LDS_BYTES, stream, a);
}
extern "C" void kernel_launch(void* const* d_in, const int* in_sizes, int n_in, void* d_out, int out_size, void* d_ws, size_t ws_size, hipStream_t stream) {
    static int grid = 0;
    if (grid == 0) {
        if (n_in != 22 || out_size != M * D || ws_size < WS_END) { fprintf(stderr, "kernel_launch: unexpected shapes (n_in %d out %d ws %zu)\n", n_in, out_size, ws_size); grid = -1; return; }
        int dev = 0, cus = 0;
        if (hipGetDevice(&dev) != hipSuccess || hipDeviceGetAttribute(&cus, hipDeviceAttributeMultiprocessorCount, dev) != hipSuccess) { grid = -1; return; }
        if (hipFuncSetAttribute((const void*)mega, hipFuncAttributeMaxDynamicSharedMemorySize, LDS_BYTES) != hipSuccess) { fprintf(stderr, "kernel_launch: hipFuncSetAttribute failed\n"); grid = -1; return; }
        (void)hipGetLastError();
        grid = cus;
    }
    if (grid < 0) return;
    unsigned char* ws = (unsigned char*)d_ws;
    (void)hipMemsetAsync(ws + WS_CTL, 0, CTL_ZERO_BYTES, stream);
    Args a{};
    for (int i = 0; i < 22; ++i) a.in[i] = d_in[i];
    a.out = (float*)d_out; a.ws = ws; a.ph_lo = 0; a.ph_hi = 0;

#if OPT_IN && OPT_OUT && OPT_E1 && OPT_E2 && OPT_ATTN && OPT_RET && !defined(MK_PER_PHASE)
    launch_mega(a, 0, PH_COUNT, grid, stream);
    { const hipError_t le1 = hipPeekAtLastError(); if (le1 != hipSuccess) fprintf(stderr, "kernel_launch: launch failed: %s\n", hipGetErrorName(le1)); }
    return;
#endif
    launch_mega(a, PH_PREP, PH_PREP + 1, grid, stream);
    launch_mega(a, PH_PRENORM, PH_PRENORM + 1, grid, stream);
#if OPT_IN
    launch_mega(a, PH_INPROJ, PH_INPROJ + 1, grid, stream);
#else
    hipLaunchKernelGGL((k_gemm_naive<EpiIn, false, true>), dim3(NCOL / 128, M / 64, 1), dim3(256), 0, stream,
                       (const bf16_t*)(ws + WS_H), D, (const int*)nullptr, (const float*)d_in[I_WIN], (const float*)nullptr, NCOL, D, M, 0L, EpiIn{ws});
#endif
#if OPT_ATTN || OPT_RET
    launch_mega(a, PH_ATTN, PH_ATTN + 1, grid, stream);
#endif
#if !OPT_ATTN
    hipLaunchKernelGGL(k_attn_naive, dim3(NB * NH * 2 * 16), dim3(256), 0, stream, (const bf16_t*)(ws + WS_QD), (const bf16_t*)(ws + WS_KD), (const bf16_t*)(ws + WS_VD), (float*)(ws + WS_ON));
    hipLaunchKernelGGL(k_attn_combine, dim3(NB * NH * S / 4), dim3(256), 0, stream, (const float*)(ws + WS_ON), (const float*)d_in[I_LQ1], (const float*)d_in[I_LK1], (const float*)d_in[I_LQ2], (const float*)d_in[I_LK2],
                       (const float*)d_in[I_SUBLN], (bf16_t*)(ws + WS_MIXIN));
#endif
#if OPT_RET
    launch_mega(a, PH_RETOUT, PH_RETOUT + 1, grid, stream);
#else
    hipLaunchKernelGGL(k_ret_naive, dim3(NB * NH * 2 * 16), dim3(256), 0, stream, (const bf16_t*)(ws + WS_RQ), (const bf16_t*)(ws + WS_RK), (const bf16_t*)(ws + WS_RV), (const float*)d_in[I_DECAY], (float*)(ws + WS_RAW));
    hipLaunchKernelGGL(k_ret_norm, dim3(NB * NH * S / 4), dim3(256), 0, stream, (const float*)(ws + WS_RAW), (const float*)d_in[I_RETG], (const bf16_t*)(ws + WS_RG), (bf16_t*)(ws + WS_MIXIN));
#endif
#if OPT_OUT
    launch_mega(a, PH_OUTPROJ, PH_OUTPROJ + 1, grid, stream);
#else
    hipLaunchKernelGGL((k_gemm_naive<EpiOut, false, false>), dim3(D / 128, M / 64, 1), dim3(256), 0, stream,
                       (const bf16_t*)(ws + WS_MIXIN), D, (const int*)nullptr, (const float*)d_in[I_WOUT], (const float*)nullptr, D, D, M, 0L, EpiOut{ws});
#endif
    launch_mega(a, PH_ROWPASS, PH_ROWPASS + 1, grid, stream);
    launch_mega(a, PH_TOPK, PH_TOPK + 1, grid, stream);
#if OPT_E1
    launch_mega(a, PH_E1, PH_E1 + 1, grid, stream);
#else
    hipLaunchKernelGGL((k_gemm_naive<EpiE1, true, false>), dim3(FF / 128, 2048 / 64, NE), dim3(256), 0, stream,
                       (const bf16_t*)(ws + WS_H), D, (const int*)(ws + WS_ROWMAP), (const float*)d_in[I_WGATE], (const float*)d_in[I_WUP], FF, D, 2048, (long)D * FF, EpiE1{ws});
#endif
#if OPT_E2
    launch_mega(a, PH_E2, PH_E2 + 1, grid, stream);
#else
    hipLaunchKernelGGL((k_gemm_naive<EpiE2, false, false>), dim3(D / 128, 2048 / 64, NE), dim3(256), 0, stream,
                       (const bf16_t*)(ws + WS_HID), FF, (const int*)nullptr, (const float*)d_in[I_WDOWN], (const float*)nullptr, D, FF, 2048, (long)FF * D, EpiE2{ws});
#endif
    launch_mega(a, PH_FINAL, PH_FINAL + 1, grid, stream);
    const hipError_t le = hipPeekAtLastError();
    if (le != hipSuccess) fprintf(stderr, "kernel_launch: launch failed: %s\n", hipGetErrorName(le));
}
```

```cpp
#include <hip/hip_runtime.h>
#include <cstdio>
#include <cstdint>

#ifndef OPT_IN
#define OPT_IN 1
#endif
#ifndef OPT_OUT
#define OPT_OUT 1
#endif
#ifndef OPT_E1
#define OPT_E1 1
#endif
#ifndef OPT_E2
#define OPT_E2 1
#endif
#ifndef OPT_ATTN
#define OPT_ATTN 1
#endif
#ifndef OPT_RET
#define OPT_RET 1
#endif
#ifndef F8_E1
#define F8_E1 1
#endif
#ifndef F8_E2
#define F8_E2 1
#endif
#ifndef F8_Y
#define F8_Y 1
#endif
#ifndef F8_IN
#define F8_IN 1
#endif
#ifndef EXP_F8
#define EXP_F8 (F8_E1 || F8_E2)
#endif
#ifndef REP_CONV
#define REP_CONV 1
#endif
#ifndef REP_IN
#define REP_IN 1
#endif
#ifndef REP_ATTN
#define REP_ATTN 1
#endif
#ifndef REP_E1
#define REP_E1 1
#endif
#ifndef REP_MISC
#define REP_MISC 1
#endif
#ifndef REP_SLICE
#define REP_SLICE 1
#endif
#ifndef REP_PRENORM
#define REP_PRENORM 1
#endif
#ifndef REP_ROWPASS
#define REP_ROWPASS 1
#endif
#ifndef REP_FINAL
#define REP_FINAL 1
#endif
#ifndef REP_RETOUT
#define REP_RETOUT 1
#endif
#ifndef REP_STATE
#define REP_STATE 1
#endif
#ifndef REP_TOPK
#define REP_TOPK 1
#endif
#ifndef REP_PREP
#define REP_PREP 1
#endif


constexpr int D = 2048, NB = 4, S = 4096, M = NB * S;
constexpr int NCOL = 7168;
constexpr int NE = 16, CAP = 512, FF = 2048;
constexpr int NH = 8;
constexpr float NORM_EPS = 1e-6f;
constexpr float LAM_INIT = 0.2f;
constexpr float QSCALE = 0.125f * 1.4426950408889634f;
constexpr float RKSCALE = 0.08838834764831845f;

constexpr size_t MiB = 1u << 20;
constexpr size_t WS_CTL = 0, CTL_ZERO_BYTES = 32768;
constexpr size_t WS_MOD = 1 * MiB;
constexpr int MOD_HALF = 4 * 6 * 2048;
constexpr size_t WS_AFF = 2 * MiB;
constexpr size_t WS_ROWMAP = 3 * MiB;
constexpr size_t WS_GATEV = 3 * MiB + 256 * 1024;
constexpr size_t WS_SEL = 4 * MiB;
constexpr size_t WS_ROPED = 6 * MiB;
constexpr size_t WS_ROPER = 10 * MiB;
constexpr size_t WS_WINT = 20 * MiB;
constexpr size_t WS_WOUTT = 48 * MiB;
constexpr size_t WS_W1T = 56 * MiB;
constexpr size_t WS_W2T = 312 * MiB;
constexpr size_t WS_H = 440 * MiB;
constexpr size_t WS_QD = 504 * MiB;
constexpr size_t WS_KD = 536 * MiB;
constexpr size_t WS_VD = 568 * MiB;
constexpr size_t WS_RQ = 600 * MiB;
constexpr size_t WS_RK = 632 * MiB;
constexpr size_t WS_RV = 664 * MiB;
constexpr size_t WS_RG = 696 * MiB;
constexpr size_t WS_HID = 504 * MiB;
constexpr size_t WS_ST = 728 * MiB;
constexpr size_t WS_MIXIN = 792 * MiB;
constexpr size_t WS_Y = 728 * MiB;
constexpr size_t WS_MIX = 856 * MiB;
constexpr size_t WS_X1 = 920 * MiB;
constexpr size_t WS_END = 1048 * MiB;
constexpr size_t WS_ON = WS_X1;
constexpr size_t WS_RAW = WS_MIX;

typedef unsigned short bf16_t;
typedef float f32x4 __attribute__((ext_vector_type(4)));
typedef float f32x2 __attribute__((ext_vector_type(2)));
typedef unsigned u32x4 __attribute__((ext_vector_type(4)));
typedef unsigned u32x2 __attribute__((ext_vector_type(2)));
#define DI __device__ __forceinline__

DI int lane_fresh() { int l; asm volatile("v_mbcnt_lo_u32_b32 %0, -1, 0\n\tv_mbcnt_hi_u32_b32 %0, -1, %0" : "=v"(l)); return l; }
DI int tid_fresh(int wave) { return wave * 64 + lane_fresh(); }
DI float bf2f(bf16_t v) { return __uint_as_float((unsigned)v << 16); }
DI float bflo(unsigned w) { return __uint_as_float(w << 16); }
DI float bfhi(unsigned w) { return __uint_as_float(w & 0xffff0000u); }
DI unsigned f2bf(float f) { unsigned u = __float_as_uint(f); return (u + 0x7fffu + ((u >> 16) & 1u)) >> 16; }
DI unsigned pk2(float lo, float hi) { unsigned r; asm("v_cvt_pk_bf16_f32 %0, %1, %2" : "=v"(r) : "v"(lo), "v"(hi)); return r; }
DI unsigned pk4_f8(float a, float b, float c, float d) {
    a = __builtin_amdgcn_fmed3f(a, -448.f, 448.f); b = __builtin_amdgcn_fmed3f(b, -448.f, 448.f); c = __builtin_amdgcn_fmed3f(c, -448.f, 448.f); d = __builtin_amdgcn_fmed3f(d, -448.f, 448.f);
    int w = __builtin_amdgcn_cvt_pk_fp8_f32(a, b, 0, false); w = __builtin_amdgcn_cvt_pk_fp8_f32(c, d, w, true); return (unsigned)w; }
constexpr float F8_WSCALE = 512.f, F8_HSCALE = 8.f, F8_HIDSCALE = 4.f, F8_YSCALE = 64.f;
constexpr int F8_WSCL = 0x76767676, F8_HSCL = 0x7C7C7C7C, F8_HIDSCL = 0x7D7D7D7D;
DI float silu_f(float v) { return v * __builtin_amdgcn_rcpf(1.f + __builtin_amdgcn_exp2f(-1.4426950408889634f * v)); }
DI float wave_sum(float v) {
    v += __builtin_bit_cast(float, __builtin_amdgcn_mov_dpp(__builtin_bit_cast(int, v), 0xB1, 0xF, 0xF, true));
    v += __builtin_bit_cast(float, __builtin_amdgcn_mov_dpp(__builtin_bit_cast(int, v), 0x4E, 0xF, 0xF, true));
    v += __builtin_bit_cast(float, __builtin_amdgcn_mov_dpp(__builtin_bit_cast(int, v), 0x141, 0xF, 0xF, true));
    v += __builtin_bit_cast(float, __builtin_amdgcn_mov_dpp(__builtin_bit_cast(int, v), 0x140, 0xF, 0xF, true));
    v += __builtin_bit_cast(float, __builtin_amdgcn_ds_swizzle(__builtin_bit_cast(int, v), 0x401F));
    { auto rr = __builtin_amdgcn_permlane32_swap(__float_as_uint(v), __float_as_uint(v), false, false); v = __uint_as_float(rr[0]) + __uint_as_float(rr[1]); }
    return v;
}

DI float dpp_f(float v, int ctrl) { switch (ctrl) {
    case 0x128: return __builtin_bit_cast(float, __builtin_amdgcn_mov_dpp(__builtin_bit_cast(int, v), 0x128, 0xF, 0xF, true));
    case 0x141: return __builtin_bit_cast(float, __builtin_amdgcn_mov_dpp(__builtin_bit_cast(int, v), 0x141, 0xF, 0xF, true));
    case 0x140: return __builtin_bit_cast(float, __builtin_amdgcn_mov_dpp(__builtin_bit_cast(int, v), 0x140, 0xF, 0xF, true));
    case 0xB1:  return __builtin_bit_cast(float, __builtin_amdgcn_mov_dpp(__builtin_bit_cast(int, v), 0xB1, 0xF, 0xF, true));
    default:    return __builtin_bit_cast(float, __builtin_amdgcn_mov_dpp(__builtin_bit_cast(int, v), 0x4E, 0xF, 0xF, true)); } }
DI float swz16_f(float v) { return __builtin_bit_cast(float, __builtin_amdgcn_ds_swizzle(__builtin_bit_cast(int, v), 0x401F)); }
DI float expert_totals16(const f32x2 (&p)[8], int lane) {
    float y[8];
#pragma unroll
    for (int i = 0; i < 8; ++i) { const float a = p[i >> 1][i & 1], b = p[(i + 8) >> 1][i & 1];
        auto r = __builtin_amdgcn_permlane32_swap(__float_as_uint(a), __float_as_uint(b), false, false); y[i] = __uint_as_float(r[0]) + __uint_as_float(r[1]); }
    const bool b4 = (lane & 16) != 0, b3 = (lane & 8) != 0, b2 = (lane & 4) != 0;
    float z[4];
#pragma unroll
    for (int i = 0; i < 4; ++i) { const float send = b4 ? y[i] : y[i + 4], keep = b4 ? y[i + 4] : y[i]; z[i] = keep + swz16_f(send); }
    float w[2];
#pragma unroll
    for (int i = 0; i < 2; ++i) { const float send = b3 ? z[i] : z[i + 2], keep = b3 ? z[i + 2] : z[i]; w[i] = keep + dpp_f(send, 0x128); }
    float v; { const float send = b2 ? w[0] : w[1], keep = b2 ? w[1] : w[0]; v = keep + dpp_f(send, 0x141); }
    v += dpp_f(v, 0xB1); v += dpp_f(v, 0x4E);
    return v;
}
DI float experts_max(float v) { v = fmaxf(v, dpp_f(v, 0x141)); v = fmaxf(v, dpp_f(v, 0x140)); v = fmaxf(v, swz16_f(v));
    auto r = __builtin_amdgcn_permlane32_swap(__float_as_uint(v), __float_as_uint(v), false, false); return fmaxf(__uint_as_float(r[0]), __uint_as_float(r[1])); }
DI float experts_sum(float v) { v += dpp_f(v, 0x141); v += dpp_f(v, 0x140); v += swz16_f(v);
    auto r = __builtin_amdgcn_permlane32_swap(__float_as_uint(v), __float_as_uint(v), false, false); return __uint_as_float(r[0]) + __uint_as_float(r[1]); }

struct Args {
    const void* in[22];
    float* out;
    unsigned char* ws;
    int ph_lo, ph_hi;
};
enum { I_X = 0, I_C, I_POS, I_WADA, I_BADA, I_GPREMIX, I_GPOSTMIX, I_WIN, I_LQ1, I_LK1, I_LQ2, I_LK2, I_SUBLN, I_DECAY, I_RETG, I_WOUT, I_GPREFFN, I_GPOSTFFN, I_WROUTER, I_WGATE, I_WUP, I_WDOWN };

__host__ __device__ __forceinline__ int src_col_in(int n) {
    const int sec = n >> 10, r = n & 1023;
    if (sec <= 1) { const int g = r >> 6, j = r & 63; return (sec << 10) + (g << 6) + (j >> 1) + ((j & 1) << 5); }
    if (sec == 3 || sec == 4) { const int g = r >> 7, j = r & 127; return (sec << 10) + (g << 7) + (j >> 1) + ((j & 1) << 6); }
    return n;
}

DI void epi_in8(unsigned char* ws, int row, int col0, const float (&v)[8]) {
    const int sec = col0 >> 10, r = col0 & 1023, b = row >> 12, s = row & 4095;
    float o[8];
    bf16_t* dst;
    if (sec <= 1) {
        const int hm = r >> 6, j0 = r & 63;
        const f32x4* rt = (const f32x4*)(ws + WS_ROPED + ((size_t)row * 32 + (j0 >> 1)) * 8);
        const f32x4 t0 = rt[0], t1 = rt[1];
        const float cs[4] = {t0[0], t0[2], t1[0], t1[2]}, sn[4] = {t0[1], t0[3], t1[1], t1[3]};
        const float sc = sec == 0 ? QSCALE : 1.f;
#pragma unroll
        for (int t = 0; t < 4; ++t) { const float x1 = v[2 * t], x2 = v[2 * t + 1]; o[2 * t] = (x1 * cs[t] - x2 * sn[t]) * sc; o[2 * t + 1] = (x2 * cs[t] + x1 * sn[t]) * sc; }
        dst = (bf16_t*)(ws + (sec == 0 ? WS_QD : WS_KD)) + (((size_t)(b * 16 + hm) * S + s) * 64 + j0);
    } else if (sec == 3 || sec == 4) {
        const int h = r >> 7, j0 = r & 127;
        const f32x4* rt = (const f32x4*)(ws + WS_ROPER + ((size_t)row * 64 + (j0 >> 1)) * 8);
        const f32x4 t0 = rt[0], t1 = rt[1];
        const float cs[4] = {t0[0], t0[2], t1[0], t1[2]}, sn[4] = {t0[1], t0[3], t1[1], t1[3]};
        const float sc = sec == 4 ? RKSCALE : 1.f;
#pragma unroll
        for (int t = 0; t < 4; ++t) { const float x1 = v[2 * t], x2 = v[2 * t + 1]; o[2 * t] = (x1 * cs[t] - x2 * sn[t]) * sc; o[2 * t + 1] = (x2 * cs[t] + x1 * sn[t]) * sc; }
        dst = (bf16_t*)(ws + (sec == 3 ? WS_RQ : WS_RK)) + (((size_t)(b * 8 + h) * S + s) * 128 + j0);
    } else if (sec == 6) {
#pragma unroll
        for (int t = 0; t < 8; ++t) o[t] = silu_f(v[t]);
        dst = (bf16_t*)(ws + WS_RG) + ((size_t)row * 1024 + r);
    } else {
        const int h = r >> 7, j0 = r & 127;
#pragma unroll
        for (int t = 0; t < 8; ++t) o[t] = v[t];
        dst = (bf16_t*)(ws + (sec == 2 ? WS_VD : WS_RV)) + (((size_t)(b * 8 + h) * S + s) * 128 + j0);
    }
    u32x4 w; w.x = pk2(o[0], o[1]); w.y = pk2(o[2], o[3]); w.z = pk2(o[4], o[5]); w.w = pk2(o[6], o[7]);
    *(u32x4*)dst = w;
}
DI bool epi_in_is_rope(int col0) { const int sec = col0 >> 10; return sec <= 1 || sec == 3 || sec == 4; }
DI void epi_in_table(const unsigned char* ws, int row, int col0, f32x4& t0, f32x4& t1) {
    const int sec = col0 >> 10, r = col0 & 1023;
    const f32x4* rt = sec <= 1 ? (const f32x4*)(ws + WS_ROPED + ((size_t)row * 32 + ((r & 63) >> 1)) * 8) : (const f32x4*)(ws + WS_ROPER + ((size_t)row * 64 + ((r & 127) >> 1)) * 8);
    t0 = rt[0]; t1 = rt[1];
}
DI void epi_in8_rope(unsigned char* ws, int row, int col0, const float (&v)[8], const f32x4 t0, const f32x4 t1) {
    const int sec = col0 >> 10, r = col0 & 1023, b = row >> 12, s = row & 4095;
    float o[8];
    const float cs[4] = {t0[0], t0[2], t1[0], t1[2]}, sn[4] = {t0[1], t0[3], t1[1], t1[3]};
    const float sc = sec == 0 ? QSCALE : (sec == 4 ? RKSCALE : 1.f);
#pragma unroll
    for (int t = 0; t < 4; ++t) { const float x1 = v[2 * t], x2 = v[2 * t + 1]; o[2 * t] = (x1 * cs[t] - x2 * sn[t]) * sc; o[2 * t + 1] = (x2 * cs[t] + x1 * sn[t]) * sc; }
    bf16_t* dst;
    if (sec <= 1) { const int hm = r >> 6, j0 = r & 63; dst = (bf16_t*)(ws + (sec == 0 ? WS_QD : WS_KD)) + (((size_t)(b * 16 + hm) * S + s) * 64 + j0); }
    else { const int h = r >> 7, j0 = r & 127; dst = (bf16_t*)(ws + (sec == 3 ? WS_RQ : WS_RK)) + (((size_t)(b * 8 + h) * S + s) * 128 + j0); }
    u32x4 w; w.x = pk2(o[0], o[1]); w.y = pk2(o[2], o[3]); w.z = pk2(o[4], o[5]); w.w = pk2(o[6], o[7]);
    *(u32x4*)dst = w;
}
DI void store8_bf16(bf16_t* dst, const float (&o)[8]) {
    u32x4 w; w.x = pk2(o[0], o[1]); w.y = pk2(o[2], o[3]); w.z = pk2(o[4], o[5]); w.w = pk2(o[6], o[7]);
    *(u32x4*)dst = w;
}

struct EpiIn  { unsigned char* ws; DI void operator()(int row, int col0, const float (&v)[8], const float (&)[8]) const { epi_in8(ws, row, col0, v); } };
struct EpiOut { unsigned char* ws; DI void operator()(int row, int col0, const float (&v)[8], const float (&)[8]) const { store8_bf16((bf16_t*)(ws + WS_MIX) + (size_t)row * D + col0, v); } };
struct EpiE1  { unsigned char* ws; DI void operator()(int row, int col0, const float (&g)[8], const float (&u)[8]) const {
    float o[8];
#pragma unroll
    for (int t = 0; t < 8; ++t) o[t] = silu_f(g[t]) * u[t];
    store8_bf16((bf16_t*)(ws + WS_HID) + (size_t)row * FF + col0, o); } };
struct EpiE2  { unsigned char* ws; DI void operator()(int row, int col0, const float (&v)[8], const float (&)[8]) const {
    const float gt = ((const float*)(ws + WS_GATEV))[row]; float o[8];
#pragma unroll
    for (int t = 0; t < 8; ++t) o[t] = v[t] * gt;
    store8_bf16((bf16_t*)(ws + WS_Y) + (size_t)row * D + col0, o); } };

template <class Epi, bool DUAL, bool PERMIN>
__global__ void __launch_bounds__(256) k_gemm_naive(const bf16_t* __restrict__ A, int lda, const int* __restrict__ rowmap, const float* __restrict__ Bm, const float* __restrict__ B2m,
                                                     int ldb, int K, int Mz, long zB, Epi epi) {
    __shared__ __attribute__((aligned(16))) float As[16][68];
    __shared__ __attribute__((aligned(16))) float Bs[16][128];
    __shared__ __attribute__((aligned(16))) float B2s[DUAL ? 16 : 1][128];
    const int t = threadIdx.x, tx = t & 15, ty = t >> 4, z = blockIdx.z;
    const int n0 = blockIdx.x * 128, r0 = blockIdx.y * 64;
    const float* B = Bm + (size_t)z * zB; const float* B2 = DUAL ? B2m + (size_t)z * zB : nullptr;
    const int ar = t >> 2, akq = t & 3;
    const int grow = z * Mz + r0 + ar;
    const size_t arow = rowmap ? (size_t)rowmap[grow] : (size_t)grow;
    const bf16_t* ap = A + arow * lda + akq * 4;
    const int bk = t >> 4, bcg = t & 15;
    int scol[8];
#pragma unroll
    for (int j = 0; j < 8; ++j) scol[j] = PERMIN ? src_col_in(n0 + bcg * 8 + j) : (n0 + bcg * 8 + j);
    float acc[4][8], acc2[4][8];
#pragma unroll
    for (int i = 0; i < 4; ++i)
#pragma unroll
        for (int j = 0; j < 8; ++j) { acc[i][j] = 0.f; acc2[i][j] = 0.f; }
    for (int k0 = 0; k0 < K; k0 += 16) {
        const u32x2 av = *(const u32x2*)(ap + k0);
        float bv[8], bv2[8];
#pragma unroll
        for (int j = 0; j < 8; ++j) { bv[j] = B[(size_t)(k0 + bk) * ldb + scol[j]]; if (DUAL) bv2[j] = B2[(size_t)(k0 + bk) * ldb + scol[j]]; }
        __syncthreads();
        As[akq * 4 + 0][ar] = bflo(av.x); As[akq * 4 + 1][ar] = bfhi(av.x); As[akq * 4 + 2][ar] = bflo(av.y); As[akq * 4 + 3][ar] = bfhi(av.y);
#pragma unroll
        for (int j = 0; j < 8; ++j) { Bs[bk][bcg * 8 + j] = bv[j]; if (DUAL) B2s[bk][bcg * 8 + j] = bv2[j]; }
        __syncthreads();
#pragma unroll
        for (int kk = 0; kk < 16; ++kk) {
            const f32x4 a4 = *(const f32x4*)&As[kk][ty * 4];
            const f32x4 b0 = *(const f32x4*)&Bs[kk][tx * 8], b1 = *(const f32x4*)&Bs[kk][tx * 8 + 4];
            const float bb[8] = {b0[0], b0[1], b0[2], b0[3], b1[0], b1[1], b1[2], b1[3]};
#pragma unroll
            for (int i = 0; i < 4; ++i)
#pragma unroll
                for (int j = 0; j < 8; ++j) acc[i][j] += a4[i] * bb[j];
            if (DUAL) {
                const f32x4 c0 = *(const f32x4*)&B2s[kk][tx * 8], c1 = *(const f32x4*)&B2s[kk][tx * 8 + 4];
                const float cc[8] = {c0[0], c0[1], c0[2], c0[3], c1[0], c1[1], c1[2], c1[3]};
#pragma unroll
                for (int i = 0; i < 4; ++i)
#pragma unroll
                    for (int j = 0; j < 8; ++j) acc2[i][j] += a4[i] * cc[j];
            }
        }
    }
#pragma unroll
    for (int i = 0; i < 4; ++i) epi(z * Mz + r0 + ty * 4 + i, n0 + tx * 8, acc[i], acc2[i]);
}

__global__ void __launch_bounds__(256) k_attn_naive(const bf16_t* __restrict__ QD, const bf16_t* __restrict__ KD, const bf16_t* __restrict__ VD, float* __restrict__ On) {
    __shared__ __attribute__((aligned(16))) bf16_t Ks[32][64];
    __shared__ __attribute__((aligned(16))) bf16_t Vs[32][128];
    const int t = threadIdx.x, bid = blockIdx.x, qb = bid & 15, bhm = bid >> 4, bh = bhm >> 1;
    const int s = qb * 256 + t;
    float q[64], o[128];
    {
        const u32x4* qp = (const u32x4*)(QD + ((size_t)bhm * S + s) * 64);
#pragma unroll
        for (int c = 0; c < 8; ++c) { const u32x4 w = qp[c]; q[8 * c] = bflo(w.x); q[8 * c + 1] = bfhi(w.x); q[8 * c + 2] = bflo(w.y); q[8 * c + 3] = bfhi(w.y); q[8 * c + 4] = bflo(w.z); q[8 * c + 5] = bfhi(w.z); q[8 * c + 6] = bflo(w.w); q[8 * c + 7] = bfhi(w.w); }
    }
#pragma unroll
    for (int e = 0; e < 128; ++e) o[e] = 0.f;
    float mx = -1e30f, l = 0.f;
    for (int m0 = 0; m0 < S; m0 += 32) {
        __syncthreads();
        *(u32x4*)&Ks[t >> 3][(t & 7) * 8] = *(const u32x4*)(KD + ((size_t)bhm * S + m0 + (t >> 3)) * 64 + (t & 7) * 8);
#pragma unroll
        for (int i = 0; i < 2; ++i) { const int idx = t + 256 * i, row = idx >> 4, ch = idx & 15; *(u32x4*)&Vs[row][ch * 8] = *(const u32x4*)(VD + ((size_t)bh * S + m0 + row) * 128 + ch * 8); }
        __syncthreads();
        for (int mm = 0; mm < 32; ++mm) {
            float sc = 0.f;
#pragma unroll
            for (int c = 0; c < 8; ++c) { const u32x4 w = *(const u32x4*)&Ks[mm][c * 8];
                sc += q[8 * c] * bflo(w.x) + q[8 * c + 1] * bfhi(w.x) + q[8 * c + 2] * bflo(w.y) + q[8 * c + 3] * bfhi(w.y) + q[8 * c + 4] * bflo(w.z) + q[8 * c + 5] * bfhi(w.z) + q[8 * c + 6] * bflo(w.w) + q[8 * c + 7] * bfhi(w.w); }
            if (sc > mx) { const float f = exp2f(mx - sc); l *= f;
#pragma unroll
                for (int e = 0; e < 128; ++e) o[e] *= f;
                mx = sc; }
            const float p = exp2f(sc - mx); l += p;
#pragma unroll
            for (int c = 0; c < 16; ++c) { const u32x4 w = *(const u32x4*)&Vs[mm][c * 8];
                o[8 * c] += p * bflo(w.x); o[8 * c + 1] += p * bfhi(w.x); o[8 * c + 2] += p * bflo(w.y); o[8 * c + 3] += p * bfhi(w.y); o[8 * c + 4] += p * bflo(w.z); o[8 * c + 5] += p * bfhi(w.z); o[8 * c + 6] += p * bflo(w.w); o[8 * c + 7] += p * bfhi(w.w); }
        }
    }
    const float rl = 1.f / l;
    f32x4* op = (f32x4*)(On + ((size_t)bhm * S + s) * 128);
#pragma unroll
    for (int c = 0; c < 32; ++c) op[c] = (f32x4){o[4 * c] * rl, o[4 * c + 1] * rl, o[4 * c + 2] * rl, o[4 * c + 3] * rl};
}
DI float diff_lambda(const float* lq1, const float* lk1, const float* lq2, const float* lk2, int lane) {
    const float a = wave_sum(lq1[lane] * lk1[lane]), b = wave_sum(lq2[lane] * lk2[lane]);
    return __expf(a) - __expf(b) + LAM_INIT;
}
__global__ void __launch_bounds__(256) k_attn_combine(const float* __restrict__ On, const float* lq1, const float* lk1, const float* lq2, const float* lk2, const float* __restrict__ gain, bf16_t* __restrict__ MIXIN) {
    const int lane = threadIdx.x & 63, w = blockIdx.x * 4 + (threadIdx.x >> 6);
    const int bh = w >> 12, s = w & 4095, b = bh >> 3, h = bh & 7;
    const float lam = diff_lambda(lq1, lk1, lq2, lk2, lane);
    const f32x2 o1 = *(const f32x2*)(On + ((size_t)(bh * 2 + 0) * S + s) * 128 + 2 * lane), o2 = *(const f32x2*)(On + ((size_t)(bh * 2 + 1) * S + s) * 128 + 2 * lane);
    const float v0 = o1.x - lam * o2.x, v1 = o1.y - lam * o2.y;
    const float ss = wave_sum(v0 * v0 + v1 * v1);
    const float rs = rsqrtf(ss * (1.f / 128.f) + NORM_EPS) * (1.f - LAM_INIT);
    *(unsigned*)(MIXIN + ((size_t)(b * S + s)) * D + h * 128 + 2 * lane) = pk2(v0 * rs * gain[2 * lane], v1 * rs * gain[2 * lane + 1]);
}
__global__ void __launch_bounds__(256) k_ret_naive(const bf16_t* __restrict__ RQ, const bf16_t* __restrict__ RK, const bf16_t* __restrict__ RV, const float* __restrict__ logit, float* __restrict__ Oraw) {
    __shared__ __attribute__((aligned(16))) bf16_t Ks[32][128];
    __shared__ __attribute__((aligned(16))) bf16_t Vs[32][64];
    const int t = threadIdx.x, bid = blockIdx.x, sb = bid & 15, hf = (bid >> 4) & 1, bh = bid >> 5, h = bh & 7;
    const int s = sb * 256 + t;
    const float gf = 1.f / (1.f + __expf(-logit[h])), gb = 1.f / (1.f + __expf(-logit[8 + h]));
    const float lgf = log2f(gf), lgb = log2f(gb);
    float q[128], o[64];
    {
        const u32x4* qp = (const u32x4*)(RQ + ((size_t)bh * S + s) * 128);
#pragma unroll
        for (int c = 0; c < 16; ++c) { const u32x4 w = qp[c]; q[8 * c] = bflo(w.x); q[8 * c + 1] = bfhi(w.x); q[8 * c + 2] = bflo(w.y); q[8 * c + 3] = bfhi(w.y); q[8 * c + 4] = bflo(w.z); q[8 * c + 5] = bfhi(w.z); q[8 * c + 6] = bflo(w.w); q[8 * c + 7] = bfhi(w.w); }
    }
#pragma unroll
    for (int e = 0; e < 64; ++e) o[e] = 0.f;
    for (int m0 = 0; m0 < S; m0 += 32) {
        __syncthreads();
#pragma unroll
        for (int i = 0; i < 2; ++i) { const int idx = t + 256 * i, row = idx >> 4, ch = idx & 15; *(u32x4*)&Ks[row][ch * 8] = *(const u32x4*)(RK + ((size_t)bh * S + m0 + row) * 128 + ch * 8); }
        *(u32x4*)&Vs[t >> 3][(t & 7) * 8] = *(const u32x4*)(RV + ((size_t)bh * S + m0 + (t >> 3)) * 128 + hf * 64 + (t & 7) * 8);
        __syncthreads();
        for (int mm = 0; mm < 32; ++mm) {
            float sc = 0.f;
#pragma unroll
            for (int c = 0; c < 16; ++c) { const u32x4 w = *(const u32x4*)&Ks[mm][c * 8];
                sc += q[8 * c] * bflo(w.x) + q[8 * c + 1] * bfhi(w.x) + q[8 * c + 2] * bflo(w.y) + q[8 * c + 3] * bfhi(w.y) + q[8 * c + 4] * bflo(w.z) + q[8 * c + 5] * bfhi(w.z) + q[8 * c + 6] * bflo(w.w) + q[8 * c + 7] * bfhi(w.w); }
            const int dist = s - (m0 + mm);
            const float dec = dist >= 0 ? exp2f((float)dist * lgf) : exp2f((float)(-dist) * lgb);
            const float p = sc * dec;
#pragma unroll
            for (int c = 0; c < 8; ++c) { const u32x4 w = *(const u32x4*)&Vs[mm][c * 8];
                o[8 * c] += p * bflo(w.x); o[8 * c + 1] += p * bfhi(w.x); o[8 * c + 2] += p * bflo(w.y); o[8 * c + 3] += p * bfhi(w.y); o[8 * c + 4] += p * bflo(w.z); o[8 * c + 5] += p * bfhi(w.z); o[8 * c + 6] += p * bflo(w.w); o[8 * c + 7] += p * bfhi(w.w); }
        }
    }
    f32x4* op = (f32x4*)(Oraw + ((size_t)bh * S + s) * 128 + hf * 64);
#pragma unroll
    for (int c = 0; c < 16; ++c) op[c] = (f32x4){o[4 * c], o[4 * c + 1], o[4 * c + 2], o[4 * c + 3]};
}
__global__ void __launch_bounds__(256) k_ret_norm(const float* __restrict__ Oraw, const float* __restrict__ gain, const bf16_t* __restrict__ RG, bf16_t* __restrict__ MIXIN) {
    const int lane = threadIdx.x & 63, w = blockIdx.x * 4 + (threadIdx.x >> 6);
    const int bh = w >> 12, s = w & 4095, b = bh >> 3, h = bh & 7;
    const f32x2 v = *(const f32x2*)(Oraw + ((size_t)bh * S + s) * 128 + 2 * lane);
    const float mu = wave_sum(v.x + v.y) * (1.f / 128.f);
    const float d0 = v.x - mu, d1 = v.y - mu;
    const float var = wave_sum(d0 * d0 + d1 * d1) * (1.f / 128.f);
    const float rs = rsqrtf(var + NORM_EPS);
    const size_t tok = (size_t)b * S + s;
    const unsigned g = *(const unsigned*)(RG + tok * 1024 + h * 128 + 2 * lane);
    *(unsigned*)(MIXIN + tok * D + 1024 + h * 128 + 2 * lane) = pk2(d0 * rs * gain[h * 128 + 2 * lane] * bflo(g), d1 * rs * gain[h * 128 + 2 * lane + 1] * bfhi(g));
}

#define XB_TMO      128
#define XB_XCNT(j)  (256  + 64 * (j))
#define XB_XSUB(j)  (1280 + 64 * (j))
#define XB_XGEN(j)  (2304 + 64 * (j))
#define XB_TOP      3328
#define XB_TOPGEN   3392
#define XCD_BAR_WORDS 3456
#define XB_SPIN_CAP (1u << 18)
#define LAS __attribute__((address_space(3)))
#define GAS __attribute__((address_space(1)))

__device__ __forceinline__ unsigned xb_ld(unsigned* p)              { return __hip_atomic_load(p, __ATOMIC_RELAXED, __HIP_MEMORY_SCOPE_AGENT); }
__device__ __forceinline__ unsigned xb_add(unsigned* p, unsigned v) { return __hip_atomic_fetch_add(p, v, __ATOMIC_RELAXED, __HIP_MEMORY_SCOPE_AGENT); }
__device__ __forceinline__ unsigned xb_xcc_id() { return (unsigned)__builtin_amdgcn_s_getreg((3 << 11) | 20) & 0xFu; }
#define XB_SPIN(cond, bar) do { unsigned _sp = 0; while (cond) { __builtin_amdgcn_s_sleep(1); \
    if ((++_sp & 255u) == 0u) { if (xb_ld(&(bar)[XB_TMO])) break; if (_sp > XB_SPIN_CAP) { atomicAdd(&(bar)[XB_TMO], 1u); break; } } } } while (0)

struct XcdBarrier {
    unsigned* bar; unsigned x;
    volatile LAS unsigned* st;
    int wave;
};
__device__ __forceinline__ bool xb_leader(int wave) { return wave == 0 && lane_fresh() == 0; }
__device__ __forceinline__ XcdBarrier xcd_barrier_post(unsigned* bar, volatile LAS unsigned* st, int wave) {
    XcdBarrier b; b.bar = bar; b.x = xb_xcc_id(); b.st = st; b.wave = wave;
    if (xb_leader(wave)) (void)xb_add(&bar[XB_XCNT(b.x)], 1u);
    return b;
}
__device__ __forceinline__ void xcd_barrier_complete(unsigned* bar, unsigned x, unsigned& nloc, unsigned& nx) {
    const unsigned G = gridDim.x * gridDim.y * gridDim.z;
    unsigned sum, cnt, mine, sp = 0u;
    for (;;) {
        sum = 0u; cnt = 0u; mine = 0u;
#pragma unroll
        for (unsigned j = 0; j < 16; ++j) { const unsigned c = xb_ld(&bar[XB_XCNT(j)]); sum += c; cnt += (c > 0u) ? 1u : 0u; mine = (j == x) ? c : mine; }
        if (sum == G) break;
        __builtin_amdgcn_s_sleep(1);
        if ((++sp & 255u) == 0u) { if (xb_ld(&bar[XB_TMO])) break; if (sp > XB_SPIN_CAP) { atomicAdd(&bar[XB_TMO], 1u); break; } }
    }
    nloc = mine > 0u ? mine : 1u; nx = cnt > 0u ? cnt : 1u;
}
__device__ __forceinline__ void xcd_barrier(const XcdBarrier& b) {
    asm volatile("s_waitcnt vmcnt(0)" ::: "memory");
    __syncthreads();
    if (xb_leader(b.wave)) {
        unsigned* bar = b.bar;
        __builtin_amdgcn_s_waitcnt(0);
        unsigned nloc = b.st[0], nx = b.st[1];
        if (nloc == 0u) { xcd_barrier_complete(bar, b.x, nloc, nx); b.st[0] = nloc; b.st[1] = nx; }
        const unsigned old = xb_add(&bar[XB_XSUB(b.x)], 1u);
        const unsigned gen = old / nloc;
        if (old + 1u == (gen + 1u) * nloc) {
            __builtin_amdgcn_fence(__ATOMIC_RELEASE, "agent");
            asm volatile("s_waitcnt vmcnt(0)" ::: "memory");
            const unsigned og = xb_add(&bar[XB_TOP], 1u);
            const unsigned tg = og / nx;
            if (og + 1u == (tg + 1u) * nx) xb_add(&bar[XB_TOPGEN], 1u);
            else XB_SPIN(xb_ld(&bar[XB_TOPGEN]) == tg, bar);
            __builtin_amdgcn_fence(__ATOMIC_ACQUIRE, "agent");
            xb_add(&bar[XB_XGEN(b.x)], 1u);
            asm volatile("s_waitcnt vmcnt(0)" ::: "memory");
        } else {
            XB_SPIN(xb_ld(&bar[XB_XGEN(b.x)]) == gen, bar);
            __builtin_amdgcn_fence(__ATOMIC_ACQUIRE, "agent");
            asm volatile("s_waitcnt vmcnt(0)" ::: "memory");
        }
    }
    __syncthreads();
}


namespace pg8 {
#define PG8_LAS __attribute__((address_space(3)))
typedef short bf16x8 __attribute__((ext_vector_type(8)));
typedef int v4i_t __attribute__((ext_vector_type(4)));
typedef int v8i_t __attribute__((ext_vector_type(8)));
constexpr int BM = 256, BK = 64, HALF = 128, HTB = HALF * BK * 2, STAGE_BYTES = 8 * HTB, NXCD = 8, WGM = 8;
__host__ __device__ __forceinline__ int lds_byte(int r, int c) { const int st = (r >> 4) * 2 + (c >> 5), rr = r & 15, cc = c & 31, ob = rr * 64 + cc * 2; return st * 1024 + (ob ^ (((ob >> 9) & 1) << 5)); }
__host__ __device__ __forceinline__ void stage_rc(int b, int& R, int& C) { const int st = b / 1024, sb = b % 1024, swz = sb ^ (((sb >> 9) & 1) << 5); R = (st >> 1) * 16 + swz / 64; C = (st & 1) * 32 + (swz % 64) / 2; }
__host__ __device__ __forceinline__ int perm32(int rho) { const int n = rho >> 4, i = rho & 15; return 8 * (i >> 2) + 4 * n + (i & 3); }
__device__ __forceinline__ const char* uni(const char* p) { const unsigned long long v = (unsigned long long)p; const unsigned lo = __builtin_amdgcn_readfirstlane((unsigned)v), hi = __builtin_amdgcn_readfirstlane((unsigned)(v >> 32));
    return (const char*)(((unsigned long long)hi << 32) | lo); }
struct Unit { int pm, pn; };
struct Gemm { const bf16_t* A; const bf16_t* Bt; int K; };
struct StaticOrder {
    int nM, nN, nwg, G, c;
    __device__ void init(int M_, int N_, int G_, int c_) { nM = M_ / BM; nN = N_ / BM; nwg = nM * nN; G = G_; c = c_; }
    __device__ bool next(int i, Unit& u) const {
        const long L = (long)i * G + c; if (L >= nwg) return false;
        int wgid = (int)L; { const int q = nwg / NXCD, r = nwg % NXCD, xcd = wgid % NXCD, off = wgid / NXCD; wgid = (xcd < r ? xcd * (q + 1) : r * (q + 1) + (xcd - r) * q) + off; }
        const int nig = WGM * nN, gid = wgid / nig, fm = gid * WGM, gsz = (nM - fm) < WGM ? (nM - fm) : WGM;
        u.pm = fm + ((wgid % nig) % gsz); u.pn = (wgid % nig) / gsz; return true;
    }
};
template <int NPN> struct ExpertOrder {
    int G, c;
    __device__ void init(int G_, int c_) { G = G_; c = c_; }
    __device__ bool next(int i, Unit& u) const {
        constexpr int UPE = 8 * NPN, TOT = NE * UPE;
        if (G == 256) {
            constexpr int EPR = 256 / UPE, XPE = 8 / EPR;
            const int e = i * EPR + (c & 7) / XPE; if (e >= NE) return false;
            const int xx = (c & 7) % XPE, j = c >> 3;
            u.pm = e * 8 + (j & 7); u.pn = e * NPN + xx * 4 + (j >> 3); return true;
        }
        const long L = (long)i * G + c; if (L >= TOT) return false;
        const int e = (int)L / UPE, r = (int)L % UPE; u.pm = e * 8 + (r & 7); u.pn = e * NPN + (r >> 3); return true;
    }
};

template <class Epi, class Sched, bool GATHER, bool F8 = false, bool ALIGN_EPI = true, bool SP2 = true>
__device__ __forceinline__ void gemm_phase(PG8_LAS unsigned char* lds, const Gemm g, const Sched& S, const Epi& E, const PG8_LAS int* rmap, const int wave_s, const int sclB = 0x7F7F7F7F, const int sclA = 0x7F7F7F7F) {
    const int tid = tid_fresh(wave_s), wid = __builtin_amdgcn_readfirstlane(tid >> 6), lane = tid & 63, wr = wid >> 2, wc = wid & 3, fr = lane & 15, fq = lane >> 4;
    constexpr int ES = F8 ? 1 : 2;
    const int K = g.K, nt = K / (F8 ? 2 * BK : BK);
    unsigned voffA[2], voffB[2]; int stR[2], stC[2];
#pragma unroll
    for (int i = 0; i < 2; ++i) { int R, C; stage_rc(tid * 16 + i * 8192, R, C); const int Rb = Epi::PERM ? ((R & ~31) + perm32(R & 31)) : R;
        voffA[i] = (unsigned)(R * K * ES + C * 2); voffB[i] = (unsigned)(Rb * K * ES + C * 2); stR[i] = R; stC[i] = C; }
    const size_t kstep = (size_t)(BK * 2);
    const size_t hstep = (size_t)HALF * K * ES;
    const size_t tstep = 2 * hstep;
    const unsigned ldsw = (unsigned)wid * 1024u;
    const unsigned ldsb = (unsigned)__builtin_amdgcn_readfirstlane((unsigned)(size_t)lds + ldsw);
    const char* gA = F8 ? uni((const char*)g.A) : (const char*)g.A;
    const int fcol = F8 ? 32 * (fq >> 1) + 16 * (fq & 1) : fq * 8;
    const int aoff = lds_byte(wr * 64 + fr, fcol), boff = lds_byte(wc * 32 + fr, fcol);
#define PG8_SA(b, h) (((b) * 2 + (h)) * HTB)
#define PG8_SB(b, h) ((4 + (b) * 2 + (h)) * HTB)
#define PG8_GLDS(sbase, voff_, bufoff, i_) do { if constexpr (!F8) { __builtin_amdgcn_global_load_lds((const unsigned*)((sbase) + (voff_)), (PG8_LAS unsigned*)(lds + (bufoff) + ldsw + (i_) * 8192), 16, 0, 0); } else { asm volatile("s_mov_b32 m0, %2\n\ts_nop 0\n\tglobal_load_lds_dwordx4 %0, %1" \
        :: "v"(voff_), "s"(sbase), "s"(ldsb + (unsigned)((bufoff) + (i_) * 8192)) : "memory", "m0"); } } while (0)
#define PG8_STAGE(bufoff, gbase, voff) do { const char* sb_ = (gbase); _Pragma("unroll") for (int _i = 0; _i < 2; ++_i) PG8_GLDS(sb_, (voff)[_i], bufoff, _i); } while (0)
#define PG8_STAGE_A(bufoff, h, kb, NXT) do { if constexpr (GATHER) { const char* b_ = gA + (kb); const int sl_ = ((((NXT) ? uin : ui) & 1) * 4 + (h) * 2) * 512; \
            const unsigned o0_ = gofft[sl_], o1_ = gofft[sl_ + 512];     \
            PG8_GLDS(b_, o0_, bufoff, 0); PG8_GLDS(b_, o1_, bufoff, 1); } \
        else { const char* b_ = ((NXT) ? nA : cA) + (size_t)(h) * hstep + (kb); _Pragma("unroll") for (int _i = 0; _i < 2; ++_i) PG8_GLDS(b_, voffA[_i], bufoff, _i); } } while (0)
#define PG8_RD8(p_) __builtin_shufflevector(*(const PG8_LAS v4i_t*)(p_), *(const PG8_LAS v4i_t*)((p_) + 16), 0, 1, 2, 3, 4, 5, 6, 7)
#define PG8_LDA(dst, b, h) do { if constexpr (F8) { _Pragma("unroll") for (int m = 0; m < 4; ++m) dst##8[m] = PG8_RD8(lds + PG8_SA(b, h) + aoff + m * 2048); } else { \
        _Pragma("unroll") for (int m = 0; m < 4; ++m) _Pragma("unroll") for (int k = 0; k < 2; ++k) dst[m][k] = *(const PG8_LAS bf16x8*)(lds + PG8_SA(b, h) + aoff + m * 2048 + k * 1024); } } while (0)
#define PG8_LDB(dst, b, h) do { if constexpr (F8) { _Pragma("unroll") for (int n = 0; n < 2; ++n) dst##8[n] = PG8_RD8(lds + PG8_SB(b, h) + boff + n * 2048); } else { \
        _Pragma("unroll") for (int n = 0; n < 2; ++n) _Pragma("unroll") for (int k = 0; k < 2; ++k) dst[n][k] = *(const PG8_LAS bf16x8*)(lds + PG8_SB(b, h) + boff + n * 2048 + k * 1024); } } while (0)
#define PG8_MMA(ai, bj, At, Bt) do { __builtin_amdgcn_s_setprio(1); if constexpr (F8) { _Pragma("unroll") for (int m = 0; m < 4; ++m) _Pragma("unroll") for (int n = 0; n < 2; ++n) \
        acc[ai][bj][m][n] = __builtin_amdgcn_mfma_scale_f32_16x16x128_f8f6f4(Bt##8[n], At##8[m], acc[ai][bj][m][n], 0, 0, 0, sclB, 0, sclA); } else { \
        _Pragma("unroll") for (int m = 0; m < 4; ++m) _Pragma("unroll") for (int n = 0; n < 2; ++n) _Pragma("unroll") for (int k = 0; k < 2; ++k) \
        acc[ai][bj][m][n] = __builtin_amdgcn_mfma_f32_16x16x32_bf16(Bt[n][k], At[m][k], acc[ai][bj][m][n], 0, 0, 0); } __builtin_amdgcn_s_setprio(0); } while (0)
#define PG8_WAIT_V(n) asm volatile("s_waitcnt vmcnt(" #n ")" ::: "memory")
#define PG8_WAIT_L(n) asm volatile("s_waitcnt lgkmcnt(" #n ")" ::: "memory")
#define PG8_BAR __builtin_amdgcn_s_barrier()
#define PG8_SCHED __builtin_amdgcn_sched_barrier(0)
#define PG8_GOFF(dst, ui_) do { _Pragma("unroll") for (int h_ = 0; h_ < 2; ++h_) _Pragma("unroll") for (int i_ = 0; i_ < 2; ++i_) dst[h_][i_] = (unsigned)rmap[(ui_) * 256 + h_ * 128 + stR[i_]] * (unsigned)(K * ES) + (unsigned)stC[i_] * 2u; } while (0)
    Unit cur, nxt; int ui = 0;
    if (!S.next(0, cur)) return;
    f32x4 acc[2][2][4][2];
#pragma unroll
    for (int a = 0; a < 2; ++a)
#pragma unroll
        for (int b = 0; b < 2; ++b)
#pragma unroll
            for (int m = 0; m < 4; ++m)
#pragma unroll
                for (int n = 0; n < 2; ++n) acc[a][b][m][n] = (f32x4){0.f, 0.f, 0.f, 0.f};
    bf16x8 At[4][2], B0[2][2], B1[2][2];
    v8i_t At8[4], B08[2], B18[2];
    int uin = 0;
    PG8_LAS unsigned* gofft = (PG8_LAS unsigned*)((PG8_LAS unsigned char*)rmap + 8192) + tid;
#define PG8_GFILL(u_) do { const int tg_ = tid_fresh(wave_s); PG8_LAS unsigned* gt_ = (PG8_LAS unsigned*)((PG8_LAS unsigned char*)rmap + 8192) + tg_; \
        _Pragma("unroll") for (int i_ = 0; i_ < 2; ++i_) { int R_, C_; stage_rc(tg_ * 16 + i_ * 8192, R_, C_);     \
        _Pragma("unroll") for (int h_ = 0; h_ < 2; ++h_) gt_[((((u_) & 1) * 4 + h_ * 2 + i_)) * 512] = (unsigned)rmap[(u_) * 256 + h_ * 128 + R_] * (unsigned)(K * ES) + (unsigned)C_ * 2u; } } while (0)
    if constexpr (GATHER) { PG8_GFILL(0); }
#define PG8_UNI(x) (F8 ? uni(x) : (x))
    const char* cA = PG8_UNI((const char*)g.A + (size_t)cur.pm * tstep); const char* cB = PG8_UNI((const char*)g.Bt + (size_t)cur.pn * tstep);
    const char* nA = cA;
    if constexpr (SP2) {
        PG8_STAGE(PG8_SB(0, 0), cB, voffB); PG8_STAGE(PG8_SB(0, 1), cB + hstep, voffB); PG8_STAGE_A(PG8_SA(0, 0), 0, 0, false); PG8_STAGE_A(PG8_SA(0, 1), 1, 0, false);
        if (wr == 1) PG8_BAR;
        PG8_WAIT_V(2); PG8_BAR;
        PG8_STAGE(PG8_SB(1, 0), cB + kstep, voffB); PG8_STAGE_A(PG8_SA(1, 0), 0, kstep, false); PG8_STAGE(PG8_SB(1, 1), cB + hstep + kstep, voffB);
        PG8_WAIT_V(6); PG8_BAR;
    }
    for (;;) {
        const bool has_next = S.next(ui + 1, nxt);
        nA = PG8_UNI(has_next ? (const char*)g.A + (size_t)nxt.pm * tstep : cA); const char* nB = PG8_UNI(has_next ? (const char*)g.Bt + (size_t)nxt.pn * tstep : cB);
        uin = has_next ? ui + 1 : ui;
        if constexpr (GATHER) { if (has_next) { PG8_GFILL(ui + 1); } }
        for (int t = 0; t < nt; t += 2) {
            const bool last = (t == nt - 2);
            const size_t k1 = (size_t)(t + 1) * kstep;
            const size_t k2 = last ? 0 : (size_t)(t + 2) * kstep, k3 = k2 + kstep;
            const char* b2 = last ? nB : cB + (size_t)(t + 2) * kstep; const char* b3 = b2 + kstep;
            PG8_LDB(B0, 0, 0); PG8_LDB(B1, 0, 1); PG8_SCHED; PG8_LDA(At, 0, 0); PG8_STAGE_A(PG8_SA(1, 1), 1, k1, false);
            PG8_WAIT_V(8); PG8_WAIT_L(0); PG8_BAR; PG8_MMA(0, 0, At, B0); PG8_MMA(0, 1, At, B1); PG8_BAR; PG8_SCHED;
            PG8_LDA(At, 0, 1); PG8_STAGE(PG8_SB(0, 0), b2, voffB); PG8_STAGE(PG8_SB(0, 1), b2 + hstep, voffB); PG8_STAGE_A(PG8_SA(0, 0), 0, k2, last);
            PG8_WAIT_V(8); PG8_WAIT_L(0); PG8_BAR; PG8_MMA(1, 0, At, B0); PG8_MMA(1, 1, At, B1); PG8_BAR; PG8_SCHED;
            PG8_LDB(B0, 1, 0); PG8_LDB(B1, 1, 1); PG8_SCHED; PG8_LDA(At, 1, 0); PG8_STAGE_A(PG8_SA(0, 1), 1, k2, last);
            PG8_WAIT_V(8); PG8_WAIT_L(0); PG8_BAR; PG8_MMA(0, 0, At, B0); PG8_MMA(0, 1, At, B1); PG8_BAR; PG8_SCHED;
            PG8_LDA(At, 1, 1); PG8_STAGE(PG8_SB(1, 0), b3, voffB); PG8_STAGE(PG8_SB(1, 1), b3 + hstep, voffB); PG8_STAGE_A(PG8_SA(1, 0), 0, k3, last);
            PG8_WAIT_V(8); PG8_WAIT_L(0); PG8_BAR; PG8_MMA(1, 0, At, B0); PG8_MMA(1, 1, At, B1); PG8_BAR; PG8_SCHED;
        }
        if constexpr (ALIGN_EPI) { if (wr == 0) PG8_BAR; }
        { const int le_ = lane_fresh(); E(acc, cur, wr, wc, le_ & 15, le_ >> 4); }
        if (!has_next) break;
#pragma unroll
        for (int a = 0; a < 2; ++a)
#pragma unroll
            for (int b = 0; b < 2; ++b)
#pragma unroll
                for (int m = 0; m < 4; ++m)
#pragma unroll
                    for (int n = 0; n < 2; ++n) acc[a][b][m][n] = (f32x4){0.f, 0.f, 0.f, 0.f};
        cur = nxt; cA = nA; cB = nB; ++ui;
        if constexpr (ALIGN_EPI) { if (wr == 1) PG8_BAR; }
    }
    PG8_WAIT_V(0);
    if constexpr (!ALIGN_EPI) { if (wr == 0) PG8_BAR; }
    PG8_BAR;
#undef PG8_SA
#undef PG8_SB
#undef PG8_GLDS
#undef PG8_STAGE
#undef PG8_STAGE_A
#undef PG8_LDA
#undef PG8_LDB
#undef PG8_RD8
#undef PG8_MMA
#undef PG8_WAIT_V
#undef PG8_WAIT_L
#undef PG8_BAR
#undef PG8_SCHED
#undef PG8_GOFF
#undef PG8_GFILL
}
}

struct GEpiIn { static constexpr bool PERM = true; unsigned char* ws;
    DI void operator()(const f32x4 (&acc)[2][2][4][2], const pg8::Unit& u, int wr, int wc, int fr, int fq) const {
        const int row0 = u.pm * 256 + wr * 64 + fr, col0 = u.pn * 256 + wc * 32 + 8 * fq;
        if (epi_in_is_rope(col0)) {
            f32x4 t0[2][4], t1[2][4];
#pragma unroll
            for (int ai = 0; ai < 2; ++ai)
#pragma unroll
                for (int m = 0; m < 4; ++m) epi_in_table(ws, row0 + ai * 128 + m * 16, col0, t0[ai][m], t1[ai][m]);
#pragma unroll
            for (int ai = 0; ai < 2; ++ai)
#pragma unroll
                for (int m = 0; m < 4; ++m)
#pragma unroll
                    for (int bj = 0; bj < 2; ++bj) { const f32x4 a = acc[ai][bj][m][0], b = acc[ai][bj][m][1]; const float v[8] = {a[0], a[1], a[2], a[3], b[0], b[1], b[2], b[3]};
                        epi_in8_rope(ws, row0 + ai * 128 + m * 16, col0 + bj * 128, v, t0[ai][m], t1[ai][m]); }
            return;
        }
#pragma unroll
        for (int ai = 0; ai < 2; ++ai)
#pragma unroll
            for (int m = 0; m < 4; ++m)
#pragma unroll
                for (int bj = 0; bj < 2; ++bj) { const f32x4 a = acc[ai][bj][m][0], b = acc[ai][bj][m][1]; const float v[8] = {a[0], a[1], a[2], a[3], b[0], b[1], b[2], b[3]};
                    epi_in8(ws, row0 + ai * 128 + m * 16, col0 + bj * 128, v); }
    } };
struct GEpiOut { static constexpr bool PERM = true; unsigned char* ws;
    DI void operator()(const f32x4 (&acc)[2][2][4][2], const pg8::Unit& u, int wr, int wc, int fr, int fq) const {
        const int row0 = u.pm * 256 + wr * 64 + fr, col0 = u.pn * 256 + wc * 32 + 8 * fq;
#pragma unroll
        for (int ai = 0; ai < 2; ++ai)
#pragma unroll
            for (int m = 0; m < 4; ++m)
#pragma unroll
                for (int bj = 0; bj < 2; ++bj) { const f32x4 a = acc[ai][bj][m][0], b = acc[ai][bj][m][1]; const float v[8] = {a[0], a[1], a[2], a[3], b[0], b[1], b[2], b[3]};
                    store8_bf16((bf16_t*)(ws + WS_MIX) + (size_t)(row0 + ai * 128 + m * 16) * D + col0 + bj * 128, v); }
    } };
struct GEpiE1 { static constexpr bool PERM = true; unsigned char* ws;
    DI void operator()(const f32x4 (&acc)[2][2][4][2], const pg8::Unit& u, int wr, int wc, int fr, int fq) const {
        const int row0 = u.pm * 256 + wr * 64 + fr, col0 = (u.pn & 15) * 128 + wc * 32 + 8 * fq;
#pragma unroll
        for (int ai = 0; ai < 2; ++ai)
#pragma unroll
            for (int m = 0; m < 4; ++m) { const f32x4 g0 = acc[ai][0][m][0], g1 = acc[ai][0][m][1], u0 = acc[ai][1][m][0], u1 = acc[ai][1][m][1];
                const float v[8] = {silu_f(g0[0]) * u0[0], silu_f(g0[1]) * u0[1], silu_f(g0[2]) * u0[2], silu_f(g0[3]) * u0[3], silu_f(g1[0]) * u1[0], silu_f(g1[1]) * u1[1], silu_f(g1[2]) * u1[2], silu_f(g1[3]) * u1[3]};
#if F8_E2
                *(u32x2*)((unsigned char*)(ws + WS_HID) + (size_t)(row0 + ai * 128 + m * 16) * FF + col0) =
                    (u32x2){pk4_f8(v[0] * F8_HIDSCALE, v[1] * F8_HIDSCALE, v[2] * F8_HIDSCALE, v[3] * F8_HIDSCALE), pk4_f8(v[4] * F8_HIDSCALE, v[5] * F8_HIDSCALE, v[6] * F8_HIDSCALE, v[7] * F8_HIDSCALE)};
#else
                store8_bf16((bf16_t*)(ws + WS_HID) + (size_t)(row0 + ai * 128 + m * 16) * FF + col0, v);
#endif
            }
    } };
struct GEpiE2 { static constexpr bool PERM = true; unsigned char* ws;
    DI void operator()(const f32x4 (&acc)[2][2][4][2], const pg8::Unit& u, int wr, int wc, int fr, int fq) const {
        const int row0 = u.pm * 256 + wr * 64 + fr, col0 = (u.pn & 7) * 256 + wc * 32 + 8 * fq;
        const float* gatev = (const float*)(ws + WS_GATEV);
        float gtv[2][4];
#pragma unroll
        for (int ai = 0; ai < 2; ++ai)
#pragma unroll
            for (int m = 0; m < 4; ++m) gtv[ai][m] = gatev[row0 + ai * 128 + m * 16];
#pragma unroll
        for (int ai = 0; ai < 2; ++ai)
#pragma unroll
            for (int m = 0; m < 4; ++m) { const int row = row0 + ai * 128 + m * 16; const float gt = gtv[ai][m];
#pragma unroll
                for (int bj = 0; bj < 2; ++bj) { const f32x4 a = acc[ai][bj][m][0], b = acc[ai][bj][m][1]; const float v[8] = {a[0] * gt, a[1] * gt, a[2] * gt, a[3] * gt, b[0] * gt, b[1] * gt, b[2] * gt, b[3] * gt};
#if F8_Y
                    *(u32x2*)((unsigned char*)(ws + WS_Y) + (size_t)row * D + col0 + bj * 128) = (u32x2){pk4_f8(v[0] * F8_YSCALE, v[1] * F8_YSCALE, v[2] * F8_YSCALE, v[3] * F8_YSCALE), pk4_f8(v[4] * F8_YSCALE, v[5] * F8_YSCALE, v[6] * F8_YSCALE, v[7] * F8_YSCALE)};
#else
                    store8_bf16((bf16_t*)(ws + WS_Y) + (size_t)row * D + col0 + bj * 128, v);
#endif
                } }
    } };


constexpr int NWAVES = 8, NTHR = 512;
constexpr int RING_BYTES = 131072;
constexpr int LDSCTL_OFF = 162816, MISC_OFF = LDSCTL_OFF + 320;
constexpr int RMAP_OFF = RING_BYTES;
constexpr int GOFF_OFF = RMAP_OFF + 8192;
constexpr int LDS_BYTES = 163840;
constexpr int CW_BAR = 4096;
static_assert((size_t)(CW_BAR + XCD_BAR_WORDS) * 4 <= CTL_ZERO_BYTES, "the per-call memset must cover the barrier words");

enum { PH_PREP = 0, PH_PRENORM, PH_INPROJ, PH_ATTN, PH_RETOUT, PH_OUTPROJ, PH_ROWPASS, PH_TOPK, PH_E1, PH_E2, PH_FINAL, PH_COUNT };

struct Frame {
    unsigned char* lds;
    LAS unsigned char* ldsl;
    unsigned char* ws;
    const void* const* in;
    float* out;
    int tid, lane, wave, wg, nwg;
};

DI void ph_prep(const Frame& F) {
    const float* c = (const float*)F.in[I_C]; const float* w_ada = (const float*)F.in[I_WADA]; const float* b_ada = (const float*)F.in[I_BADA];
    float* mod = (float*)(F.ws + WS_MOD);
    float* sc = (float*)F.lds;
    float* red = (float*)(F.lds + 32768);
    {
        float cv_[16];
#pragma unroll
        for (int i = 0; i < 16; ++i) cv_[i] = c[F.tid + NTHR * i];
#pragma unroll
        for (int i = 0; i < 16; ++i) sc[F.tid + NTHR * i] = silu_f(cv_[i]);
    }
    __syncthreads();
    for (int u = F.wg; u < 256; u += F.nwg) {
        const int cbk = u >> 1, kh = u & 1, cg = F.tid % 24, ks = F.tid / 24;
        float acc[4][4];
#pragma unroll
        for (int b = 0; b < 4; ++b)
#pragma unroll
            for (int j = 0; j < 4; ++j) acc[b][j] = 0.f;
        if (ks < 21) {
            const float* wp = w_ada + (size_t)(kh * 1024) * (6 * D) + cbk * 96 + cg * 4;
            for (int k = ks; k < 1024; k += 21 * 7) {
                f32x4 w[7];
#pragma unroll
                for (int i = 0; i < 7; ++i) { const int ki = (k + 21 * i < 1024) ? k + 21 * i : ks; w[i] = __builtin_nontemporal_load((const f32x4*)(wp + (size_t)ki * (6 * D))); }
#pragma unroll
                for (int i = 0; i < 7; ++i) { const int ki = k + 21 * i; if (ki < 1024) {
#pragma unroll
                    for (int b = 0; b < 4; ++b) { const float a = sc[b * D + kh * 1024 + ki]; acc[b][0] += a * w[i][0]; acc[b][1] += a * w[i][1]; acc[b][2] += a * w[i][2]; acc[b][3] += a * w[i][3]; } } }
            }
#pragma unroll
            for (int b = 0; b < 4; ++b)
#pragma unroll
                for (int j = 0; j < 4; ++j) red[(ks * 24 + cg) * 16 + b * 4 + j] = acc[b][j];
        }
        __syncthreads();
        if (F.tid < 384) {
            const int cg2 = F.tid / 16, bj = F.tid % 16, b = bj >> 2, j = bj & 3;
            const int col = cbk * 96 + cg2 * 4 + j;
            float s = kh == 0 ? b_ada[col] : 0.f;
#pragma unroll
            for (int k2 = 0; k2 < 21; ++k2) s += red[(k2 * 24 + cg2) * 16 + bj];
            mod[(size_t)kh * MOD_HALF + b * (6 * D) + col] = s;
        }
        __syncthreads();
    }
    const int* pos = (const int*)F.in[I_POS];
    f32x2* rd = (f32x2*)(F.ws + WS_ROPED); f32x2* rr = (f32x2*)(F.ws + WS_ROPER);
    {
        static_assert(M * 96 == 12 * 256 * NTHR, "rope-table work split");
        const int base = F.wg * NTHR + F.tid, stride = F.nwg * NTHR;
        if (F.nwg == 256) {
            int pv[12];
#pragma unroll
            for (int i = 0; i < 12; ++i) pv[i] = pos[(base + stride * i) / 96];
#pragma unroll
            for (int i = 0; i < 12; ++i) {
                const int idx = base + stride * i, tok = idx / 96, f = idx % 96;
                const float p = (float)pv[i];
                float ex; if (f < 32) ex = (float)(2 * f) * (1.f / 64.f); else ex = (float)(2 * (f - 32)) * (1.f / 128.f);
                const float inv = exp2f(-ex * 13.287712379549449f);
                double rev = (double)(p * inv) * 0.15915494309189535; rev -= rint(rev);
                const float rv = (float)rev, sn = __builtin_amdgcn_sinf(rv), cs = __builtin_amdgcn_cosf(rv);
                if (f < 32) rd[(size_t)tok * 32 + f] = (f32x2){cs, sn}; else rr[(size_t)tok * 64 + (f - 32)] = (f32x2){cs, sn};
            }
        } else {
        for (int idx = F.wg * NTHR + F.tid; idx < M * 96; idx += F.nwg * NTHR) {
        const int tok = idx / 96, f = idx % 96;
        const float p = (float)pos[tok];
        float ex; if (f < 32) ex = (float)(2 * f) * (1.f / 64.f); else ex = (float)(2 * (f - 32)) * (1.f / 128.f);
        const float inv = exp2f(-ex * 13.287712379549449f);
        double rev = (double)(p * inv) * 0.15915494309189535; rev -= rint(rev);
        const float rv = (float)rev, sn = __builtin_amdgcn_sinf(rv), cs = __builtin_amdgcn_cosf(rv);
        if (f < 32) rd[(size_t)tok * 32 + f] = (f32x2){cs, sn}; else rr[(size_t)tok * 64 + (f - 32)] = (f32x2){cs, sn};
    }
        }
    }
}


DI unsigned cvt_pk_bf16(float lo, float hi) { unsigned r; asm volatile("v_cvt_pk_bf16_f32 %0, %1, %2" : "=v"(r) : "v"(lo), "v"(hi)); return r; }
struct MapIn   { DI int src(int n) const { return src_col_in(n); } DI int dst(int n) const { return n; } };
struct MapId   { DI int src(int n) const { return n; } DI int dst(int n) const { return n; } };
struct MapGU   { int up; DI int src(int n) const { return n; } DI int dst(int n) const { return ((n >> 7) << 8) + (n & 127) + up * 128; } };
template <class MapF>
DI void transpose_item(const float* __restrict__ W, int ldw, bf16_t* __restrict__ WT, LAS float* scr, int k0, int n0, int lane, const MapF f) {
    const int sc = f.src(n0 + (lane & 31));
#pragma unroll 8
    for (int i = 0; i < 32; ++i) { const int kk = 2 * i + (lane >> 5); scr[kk * 33 + (lane & 31)] = W[(size_t)(k0 + kk) * ldw + sc]; }
    asm volatile("s_waitcnt lgkmcnt(0)" ::: "memory");
    const int c = lane & 7;
#pragma unroll
    for (int j = 0; j < 4; ++j) { const int n = (lane >> 3) + 8 * j; const LAS float* sp = scr + (8 * c) * 33 + n;
        u32x4 o; o.x = cvt_pk_bf16(sp[0 * 33], sp[1 * 33]); o.y = cvt_pk_bf16(sp[2 * 33], sp[3 * 33]); o.z = cvt_pk_bf16(sp[4 * 33], sp[5 * 33]); o.w = cvt_pk_bf16(sp[6 * 33], sp[7 * 33]);
        *(u32x4*)(WT + (size_t)f.dst(n0 + n) * 2048 + k0 + 8 * c) = o; }
    asm volatile("s_waitcnt lgkmcnt(0)" ::: "memory");
}
struct CvItem { const float* src; bf16_t* dst; int up; };
DI CvItem cv_decode2(const Frame& F, int q, int kb, int nb, int lane);
DI CvItem cv_decode(const Frame& F, int it, int lane) { const int ii = it & 1023; return cv_decode2(F, it >> 10, ii >> 5, ii & 31, lane); }
DI CvItem cv_decode2(const Frame& F, int q, int kb, int nb, int lane) {
    const int ty = q >> 4, e = q & 15, n4 = lane & 15, kr = lane >> 4;
    CvItem c;
    const float* W = (const float*)F.in[ty == 0 ? I_WGATE : (ty == 1 ? I_WUP : I_WDOWN)] + (size_t)e * D * FF;
    c.src = W + (size_t)(kb * 64 + 16 * kr) * 2048 + nb * 64 + 4 * n4;
    bf16_t* WT = ty < 2 ? (bf16_t*)(F.ws + WS_W1T) + (size_t)e * 4096 * 2048 : (bf16_t*)(F.ws + WS_W2T) + (size_t)e * 2048 * 2048;
    const int n0 = nb * 64, r0 = ty < 2 ? ((n0 >> 7) << 8) + (n0 & 127) + ty * 128 : n0;
    c.up = ty;
    if ((ty < 2 && F8_E1) || (ty == 2 && F8_E2)) {
        unsigned char* WT8 = ty < 2 ? (unsigned char*)(F.ws + WS_W1T) + (size_t)e * 4096 * 2048 : (unsigned char*)(F.ws + WS_W2T) + (size_t)e * 2048 * 2048;
        c.dst = (bf16_t*)(WT8 + (size_t)r0 * 2048 + kb * 64);
    } else c.dst = WT + (size_t)r0 * 2048 + kb * 64;
    return c;
}
#define CV_LOAD(v, c) do { _Pragma("unroll") for (int i_ = 0; i_ < 16; ++i_) v[i_] = __builtin_nontemporal_load((const f32x4*)((c).src + (size_t)i_ * 2048)); } while (0)
DI void cv_store(const f32x4 (&v)[16], const CvItem& c, char* tl, int lane) {
    const int n4 = lane & 15, kr = lane >> 4;
  if ((c.up < 2 && F8_E1) || (c.up == 2 && F8_E2)) {
#pragma unroll
    for (int j = 0; j < 4; ++j) { const int n = 4 * n4 + j;
        u32x4 a;
        a.x = pk4_f8(v[0][j] * F8_WSCALE, v[1][j] * F8_WSCALE, v[2][j] * F8_WSCALE, v[3][j] * F8_WSCALE); a.y = pk4_f8(v[4][j] * F8_WSCALE, v[5][j] * F8_WSCALE, v[6][j] * F8_WSCALE, v[7][j] * F8_WSCALE);
        a.z = pk4_f8(v[8][j] * F8_WSCALE, v[9][j] * F8_WSCALE, v[10][j] * F8_WSCALE, v[11][j] * F8_WSCALE); a.w = pk4_f8(v[12][j] * F8_WSCALE, v[13][j] * F8_WSCALE, v[14][j] * F8_WSCALE, v[15][j] * F8_WSCALE);
        *(u32x4*)(tl + n * 64 + ((kr ^ (n4 & 3)) << 4)) = a; }
    asm volatile("s_waitcnt lgkmcnt(0)" ::: "memory");
#pragma unroll
    for (int r = 0; r < 4; ++r) { const int n = (lane >> 2) + 16 * r, cc = lane & 3;
        const u32x4 o = *(const u32x4*)(tl + n * 64 + ((cc ^ ((n >> 2) & 3)) << 4));
        __builtin_nontemporal_store(o, (u32x4*)((unsigned char*)c.dst + (size_t)n * 2048 + 16 * cc)); }
    asm volatile("s_waitcnt lgkmcnt(0)" ::: "memory");
    return;
  }
#pragma unroll
    for (int j = 0; j < 4; ++j) { const int n = 4 * n4 + j; char* row = tl + n * 128; const int sw = (n >> 2) & 7;
        u32x4 a, b;
        a.x = cvt_pk_bf16(v[0][j], v[1][j]); a.y = cvt_pk_bf16(v[2][j], v[3][j]); a.z = cvt_pk_bf16(v[4][j], v[5][j]); a.w = cvt_pk_bf16(v[6][j], v[7][j]);
        b.x = cvt_pk_bf16(v[8][j], v[9][j]); b.y = cvt_pk_bf16(v[10][j], v[11][j]); b.z = cvt_pk_bf16(v[12][j], v[13][j]); b.w = cvt_pk_bf16(v[14][j], v[15][j]);
        *(u32x4*)(row + (((2 * kr) ^ sw) << 4)) = a; *(u32x4*)(row + (((2 * kr + 1) ^ sw) << 4)) = b; }
    asm volatile("s_waitcnt lgkmcnt(0)" ::: "memory");
#pragma unroll
    for (int r = 0; r < 8; ++r) { const int n = (lane >> 3) + 8 * r, cc = lane & 7;
        const u32x4 o = *(const u32x4*)(tl + n * 128 + ((cc ^ ((n >> 2) & 7)) << 4));
        __builtin_nontemporal_store(o, (u32x4*)(c.dst + (size_t)n * 2048 + 8 * cc)); }
    asm volatile("s_waitcnt lgkmcnt(0)" ::: "memory");
}
DI void convert_experts_slice(const Frame& F) {
    char* tl = (char*)F.lds + F.wave * 8192;
    constexpr int NIT = 3 * NE * 1024;
    const int per = (NIT + F.nwg - 1) / F.nwg, lo = F.wg * per, hi = (lo + per < NIT) ? lo + per : NIT;
    f32x4 va[16], vb[16]; CvItem ca, cb;
    const int cnt = (hi - lo) / NWAVES, it0 = lo + F.wave;
    if (F.nwg == 256) {
#define CV_DEC(i_) cv_decode2(F, (6 * F.wg + ((i_) >> 2)) >> 5, (6 * F.wg + ((i_) >> 2)) & 31, 4 * F.wave + ((i_) & 3), F.lane)
        ca = CV_DEC(0); CV_LOAD(va, ca);
        for (int i = 0; i < 24; i += 2) {
            cb = CV_DEC(i + 1); CV_LOAD(vb, cb);
            cv_store(va, ca, tl, F.lane);
            const int i2 = (i + 2 < 24) ? i + 2 : 23;
            ca = CV_DEC(i2); CV_LOAD(va, ca);
            cv_store(vb, cb, tl, F.lane);
        }
#undef CV_DEC
    } else if ((hi - lo) == cnt * NWAVES && (cnt & 1) == 0 && cnt > 0) {
        ca = cv_decode(F, it0, F.lane); CV_LOAD(va, ca);
        for (int i = 0; i < cnt; i += 2) {
            cb = cv_decode(F, it0 + NWAVES * (i + 1), F.lane); CV_LOAD(vb, cb);
            cv_store(va, ca, tl, F.lane);
            const int i2 = (i + 2 < cnt) ? i + 2 : cnt - 1;
            ca = cv_decode(F, it0 + NWAVES * i2, F.lane); CV_LOAD(va, ca);
            cv_store(vb, cb, tl, F.lane);
        }
    } else {
        for (int it = it0; it < hi; it += NWAVES) { ca = cv_decode(F, it, F.lane); CV_LOAD(va, ca); cv_store(va, ca, tl, F.lane); }
    }
}
template <class MapF>
DI void transpose_item_f8(const float* __restrict__ W, int ldw, unsigned char* __restrict__ WT8, LAS float* scr, int k0, int n0, int lane, const MapF f) {
    const int sc = f.src(n0 + (lane & 31));
    float wv[32];
#pragma unroll
    for (int i = 0; i < 32; ++i) { const int kk = 2 * i + (lane >> 5); wv[i] = W[(size_t)(k0 + kk) * ldw + sc]; }
#pragma unroll
    for (int i = 0; i < 32; ++i) { const int kk = 2 * i + (lane >> 5); scr[kk * 33 + (lane & 31)] = wv[i]; }
    asm volatile("s_waitcnt lgkmcnt(0)" ::: "memory");
    const int c = lane & 3;
#pragma unroll
    for (int j = 0; j < 2; ++j) { const int n = (lane >> 2) + 16 * j; const LAS float* sp = scr + (16 * c) * 33 + n;
        u32x4 o;
        o.x = pk4_f8(sp[0 * 33] * F8_WSCALE, sp[1 * 33] * F8_WSCALE, sp[2 * 33] * F8_WSCALE, sp[3 * 33] * F8_WSCALE); o.y = pk4_f8(sp[4 * 33] * F8_WSCALE, sp[5 * 33] * F8_WSCALE, sp[6 * 33] * F8_WSCALE, sp[7 * 33] * F8_WSCALE);
        o.z = pk4_f8(sp[8 * 33] * F8_WSCALE, sp[9 * 33] * F8_WSCALE, sp[10 * 33] * F8_WSCALE, sp[11 * 33] * F8_WSCALE); o.w = pk4_f8(sp[12 * 33] * F8_WSCALE, sp[13 * 33] * F8_WSCALE, sp[14 * 33] * F8_WSCALE, sp[15 * 33] * F8_WSCALE);
        *(u32x4*)(WT8 + (size_t)f.dst(n0 + n) * 2048 + k0 + 16 * c) = o; }
    asm volatile("s_waitcnt lgkmcnt(0)" ::: "memory");
}
template <bool F8>
DI void cvw_item(const float* __restrict__ W, int ldw, void* WT, char* tl, int k0, int s0, int mode, int lane) {
    const int n4 = lane & 15, kr = lane >> 4;
    const float* src = W + (size_t)(k0 + 16 * kr) * ldw + s0 + 4 * n4;
    f32x4 v[16];
#pragma unroll
    for (int i = 0; i < 16; ++i) v[i] = __builtin_nontemporal_load((const f32x4*)(src + (size_t)i * ldw));
    const int hb = (s0 >> 6) & 1, g128 = s0 & ~127;
#define CVW_ROW(n_) (mode == 0 ? s0 + (n_) : (mode == 1 ? s0 + ((n_) < 32 ? 2 * (n_) : 2 * ((n_) - 32) + 1) : g128 + 2 * (n_) + hb))
    if (F8) {
#pragma unroll
        for (int j = 0; j < 4; ++j) { const int n = 4 * n4 + j;
            u32x4 a;
            a.x = pk4_f8(v[0][j] * F8_WSCALE, v[1][j] * F8_WSCALE, v[2][j] * F8_WSCALE, v[3][j] * F8_WSCALE); a.y = pk4_f8(v[4][j] * F8_WSCALE, v[5][j] * F8_WSCALE, v[6][j] * F8_WSCALE, v[7][j] * F8_WSCALE);
            a.z = pk4_f8(v[8][j] * F8_WSCALE, v[9][j] * F8_WSCALE, v[10][j] * F8_WSCALE, v[11][j] * F8_WSCALE); a.w = pk4_f8(v[12][j] * F8_WSCALE, v[13][j] * F8_WSCALE, v[14][j] * F8_WSCALE, v[15][j] * F8_WSCALE);
            *(u32x4*)(tl + n * 64 + ((kr ^ (n4 & 3)) << 4)) = a; }
        asm volatile("s_waitcnt lgkmcnt(0)" ::: "memory");
#pragma unroll
        for (int r = 0; r < 4; ++r) { const int n = (lane >> 2) + 16 * r, cc = lane & 3;
            const u32x4 o = *(const u32x4*)(tl + n * 64 + ((cc ^ ((n >> 2) & 3)) << 4));
            *(u32x4*)((unsigned char*)WT + (size_t)CVW_ROW(n) * 2048 + k0 + 16 * cc) = o; }
    } else {
#pragma unroll
        for (int j = 0; j < 4; ++j) { const int n = 4 * n4 + j; char* row = tl + n * 128; const int sw = (n >> 2) & 7;
            u32x4 a, b;
            a.x = cvt_pk_bf16(v[0][j], v[1][j]); a.y = cvt_pk_bf16(v[2][j], v[3][j]); a.z = cvt_pk_bf16(v[4][j], v[5][j]); a.w = cvt_pk_bf16(v[6][j], v[7][j]);
            b.x = cvt_pk_bf16(v[8][j], v[9][j]); b.y = cvt_pk_bf16(v[10][j], v[11][j]); b.z = cvt_pk_bf16(v[12][j], v[13][j]); b.w = cvt_pk_bf16(v[14][j], v[15][j]);
            *(u32x4*)(row + (((2 * kr) ^ sw) << 4)) = a; *(u32x4*)(row + (((2 * kr + 1) ^ sw) << 4)) = b; }
        asm volatile("s_waitcnt lgkmcnt(0)" ::: "memory");
#pragma unroll
        for (int r = 0; r < 8; ++r) { const int n = (lane >> 3) + 8 * r, cc = lane & 7;
            const u32x4 o = *(const u32x4*)(tl + n * 128 + ((cc ^ ((n >> 2) & 7)) << 4));
            *(u32x4*)((bf16_t*)WT + (size_t)CVW_ROW(n) * 2048 + k0 + 8 * cc) = o; }
    }
    asm volatile("s_waitcnt lgkmcnt(0)" ::: "memory");
#undef CVW_ROW
}
DI void ph_convert(const Frame& F) {
    __syncthreads();
#if F8_IN && OPT_IN && OPT_OUT
    {
        char* tl = (char*)F.lds + F.wave * 8192;
        const int gw0 = F.wg * NWAVES + F.wave, ngw0 = F.nwg * NWAVES;
        constexpr int NI_IN = 32 * (NCOL / 64), NI_OUT = 32 * (D / 64);
        for (int it = gw0; it < NI_IN + NI_OUT; it += ngw0) {
            if (it < NI_IN) { const int kb = it / (NCOL / 64), cb = it % (NCOL / 64), s0 = cb * 64, sec = s0 >> 10;
                cvw_item<true>((const float*)F.in[I_WIN], NCOL, F.ws + WS_WINT, tl, kb * 64, s0, sec <= 1 ? 1 : ((sec == 3 || sec == 4) ? 2 : 0), F.lane); }
            else { const int r = it - NI_IN, kb = r >> 5, cb = r & 31;
                cvw_item<false>((const float*)F.in[I_WOUT], D, F.ws + WS_WOUTT, tl, kb * 64, cb * 64, 0, F.lane); }
        }
        return;
    }
#endif
    LAS float* scr = (LAS float*)(F.ldsl + F.wave * 16384);
    const int gw = F.wg * NWAVES + F.wave, ngw = F.nwg * NWAVES;
    constexpr int I_IN = OPT_IN ? 32 * (NCOL / 32) : 0, I_OUT = OPT_OUT ? 32 * 64 : 0, I_E1 = 0, I_E2 = 0;
    for (int it = gw; it < I_IN + I_OUT + I_E1 + I_E2; it += ngw) {
        int r = it;
        if (r < I_IN) { const int kb = r / (NCOL / 32), nb = r % (NCOL / 32);
#if F8_IN
            transpose_item_f8((const float*)F.in[I_WIN], NCOL, (unsigned char*)(F.ws + WS_WINT), scr, kb * 64, nb * 32, F.lane, MapIn{});
#else
            transpose_item((const float*)F.in[I_WIN], NCOL, (bf16_t*)(F.ws + WS_WINT), scr, kb * 64, nb * 32, F.lane, MapIn{});
#endif
            continue; } r -= I_IN;
        if (r < I_OUT) { const int kb = r >> 6, nb = r & 63; transpose_item((const float*)F.in[I_WOUT], D, (bf16_t*)(F.ws + WS_WOUTT), scr, kb * 64, nb * 32, F.lane, MapId{}); continue; } r -= I_OUT;
        if (r < I_E1) { const int q = r >> 11, up = q >> 4, e = q & 15, ii = r & 2047, kb = ii >> 6, nb = ii & 63;
            transpose_item((const float*)F.in[up ? I_WUP : I_WGATE] + (size_t)e * D * FF, FF, (bf16_t*)(F.ws + WS_W1T) + (size_t)e * 4096 * 2048, scr, kb * 64, nb * 32, F.lane, MapGU{up}); continue; } r -= I_E1;
        { const int e = r >> 11, ii = r & 2047, kb = ii >> 6, nb = ii & 63;
            transpose_item((const float*)F.in[I_WDOWN] + (size_t)e * FF * D, D, (bf16_t*)(F.ws + WS_W2T) + (size_t)e * 2048 * 2048, scr, kb * 64, nb * 32, F.lane, MapId{}); }
    }
}
struct SubOrder { pg8::StaticOrder S; int i0, n; DI bool next(int i, pg8::Unit& u) const { return i < n && S.next(i0 + i, u); } };
DI void ph_inproj(const Frame& F) {
    pg8::Gemm g{(const bf16_t*)(F.ws + WS_H), (const bf16_t*)(F.ws + WS_WINT), D}; GEpiIn E{F.ws};
    pg8::StaticOrder S; S.init(M, NCOL, F.nwg, F.wg);
#if F8_IN
    pg8::gemm_phase<GEpiIn, pg8::StaticOrder, false, true>(F.ldsl, g, S, E, nullptr, F.wave, F8_WSCL, F8_HSCL);
#else
    pg8::gemm_phase<GEpiIn, pg8::StaticOrder, false>(F.ldsl, g, S, E, nullptr, F.wave);
#endif
}
DI void ph_outproj(const Frame& F) {
    pg8::Gemm g{(const bf16_t*)(F.ws + WS_MIXIN), (const bf16_t*)(F.ws + WS_WOUTT), D}; pg8::StaticOrder S; S.init(M, D, F.nwg, F.wg); GEpiOut E{F.ws};
    pg8::gemm_phase<GEpiOut, pg8::StaticOrder, false>(F.ldsl, g, S, E, nullptr, F.wave);
}
DI void ph_e1(const Frame& F) {
    LAS int* rm = (LAS int*)(F.ldsl + RMAP_OFF);
    const int* rowmap = (const int*)(F.ws + WS_ROWMAP);
    pg8::ExpertOrder<16> S; S.init(F.nwg, F.wg);
    pg8::Unit u;
    {
        int rv[8]; bool ok[8];
#pragma unroll
        for (int i = 0; i < 8; ++i) { ok[i] = S.next(i, u); rv[i] = (ok[i] && F.tid < 256) ? rowmap[u.pm * 256 + F.tid] : 0; }
#pragma unroll
        for (int i = 0; i < 8; ++i) if (ok[i] && F.tid < 256) rm[i * 256 + F.tid] = rv[i];
    }
    __syncthreads();
    pg8::Gemm g{(const bf16_t*)(F.ws + WS_H), (const bf16_t*)(F.ws + WS_W1T), D}; GEpiE1 E{F.ws};
#if F8_E1
    pg8::gemm_phase<GEpiE1, pg8::ExpertOrder<16>, true, true>(F.ldsl, g, S, E, rm, F.wave, F8_WSCL, F8_HSCL);
#else
    pg8::gemm_phase<GEpiE1, pg8::ExpertOrder<16>, true>(F.ldsl, g, S, E, rm, F.wave);
#endif
}
DI void ph_e2(const Frame& F) {
    pg8::Gemm g{(const bf16_t*)(F.ws + WS_HID), (const bf16_t*)(F.ws + WS_W2T), FF}; pg8::ExpertOrder<8> S; S.init(F.nwg, F.wg); GEpiE2 E{F.ws};
#if F8_E2
    pg8::gemm_phase<GEpiE2, pg8::ExpertOrder<8>, false, true>(F.ldsl, g, S, E, nullptr, F.wave, F8_WSCL, F8_HIDSCL);
#else
    pg8::gemm_phase<GEpiE2, pg8::ExpertOrder<8>, false>(F.ldsl, g, S, E, nullptr, F.wave);
#endif
}


namespace att {
using bf16x8 = __attribute__((ext_vector_type(8))) short;
using s16x4  = __attribute__((ext_vector_type(4))) short;
using f32x16 = __attribute__((ext_vector_type(16))) float;
constexpr int SHM_V = 16384, SHM_K = 8192, OFF_V = 0, OFF_K = 49152, OFF_ST = 73728;
constexpr float THRL = 8.f;
#define AT_KSWZ(row, colB) ((row) * 128 + ((colB) ^ ((((row) >> 1) & 7) << 4)))
#define AT_SBAR() __builtin_amdgcn_sched_barrier(0)
DI int crow(int r, int hi) { return (r & 3) + 8 * (r >> 2) + 4 * hi; }
DI unsigned cvtpk(float lo, float hi) { unsigned r; asm volatile("v_cvt_pk_bf16_f32 %0, %1, %2" : "=v"(r) : "v"(lo), "v"(hi)); return r; }
DI int v_st(int k, int c) { const int kk = (k & ~0xC) | ((k & 4) << 1) | ((k & 8) >> 1); return ((kk >> 3) * 4 + (c >> 5)) * 512 + ((kk & 7) * 32 + (c & 31)) * 2; }
DI int v_rd_base(int lane) { return ((lane & 3) << 3) | (((lane >> 2) & 3) << 6) | (((lane >> 4) & 1) << 5) | (((lane >> 5) & 1) << 8); }
constexpr int v_rd_off(int d0, int ks, int half) { return d0 * 512 + ks * 4096 + half * 2048; }
template <int OFF> DI s16x4 tr_read(int vb) { s16x4 r; asm volatile("ds_read_b64_tr_b16 %0, %1 offset:%2" : "=&v"(r) : "v"(vb), "i"(OFF) : "memory"); return r; }
DI void partialSM(f32x16& p0, f32x16& p1, float& m_ref, f32x16& negm, float& alpha) {
    float pmax = p0[0];
#pragma unroll
    for (int r = 1; r < 16; ++r) pmax = fmaxf(pmax, p0[r]);
#pragma unroll
    for (int r = 0; r < 16; ++r) pmax = fmaxf(pmax, p1[r]);
    { auto rr = __builtin_amdgcn_permlane32_swap(__float_as_uint(pmax), __float_as_uint(pmax), false, false); pmax = fmaxf(__uint_as_float(rr[0]), __uint_as_float(rr[1])); }
    alpha = 1.f;
    if (__builtin_expect(!__all(pmax <= THRL), 0)) {
        const float dl = fmaxf(pmax, 0.f); m_ref += dl; alpha = __builtin_amdgcn_exp2f(-dl);
#pragma unroll
        for (int r = 0; r < 16; ++r) { p0[r] -= dl; p1[r] -= dl; }
#pragma unroll
        for (int r = 0; r < 16; ++r) negm[r] = -m_ref;
    }
#pragma unroll
    for (int r = 0; r < 16; ++r) p0[r] = __builtin_amdgcn_exp2f(p0[r]);
}
DI void finishSM(f32x16& p0, f32x16& p1, float alpha, float& l_reg, bf16x8& pa0, bf16x8& pa1, bf16x8& pa2, bf16x8& pa3) {
#pragma unroll
    for (int r = 0; r < 16; ++r) p1[r] = __builtin_amdgcn_exp2f(p1[r]);
    float ps = 0;
#pragma unroll
    for (int r = 0; r < 16; ++r) ps += p0[r];
#pragma unroll
    for (int r = 0; r < 16; ++r) ps += p1[r];
    { auto rr = __builtin_amdgcn_permlane32_swap(__float_as_uint(ps), __float_as_uint(ps), false, false); ps = __uint_as_float(rr[0]) + __uint_as_float(rr[1]); }
    l_reg = l_reg * alpha + ps;
#define AT_PK4(P, BASE, OUT) do { unsigned a0 = cvtpk(P[BASE + 0], P[BASE + 1]), a1 = cvtpk(P[BASE + 2], P[BASE + 3]);   \
    unsigned b0 = cvtpk(P[BASE + 4], P[BASE + 5]), b1 = cvtpk(P[BASE + 6], P[BASE + 7]);                              \
    auto r0 = __builtin_amdgcn_permlane32_swap(a0, b0, false, false); auto r1 = __builtin_amdgcn_permlane32_swap(a1, b1, false, false); \
    u32x4 w = {r0[0], r1[0], r0[1], r1[1]}; OUT = __builtin_bit_cast(bf16x8, w); } while (0)
    AT_PK4(p0, 0, pa0); AT_PK4(p0, 8, pa1); AT_PK4(p1, 0, pa2); AT_PK4(p1, 8, pa3);
#undef AT_PK4
}
DI void qkt(f32x16& p0, f32x16& p1, const char* Ks, const bf16x8* qr, const f32x16& negm, int r32, int hi) {
#pragma unroll
    for (int d0 = 0; d0 < 4; ++d0) { const int cb = (d0 * 16 + hi * 8) * 2;
        const bf16x8 b0 = *reinterpret_cast<const bf16x8*>(Ks + AT_KSWZ(r32, cb));
        const bf16x8 b1 = *reinterpret_cast<const bf16x8*>(Ks + AT_KSWZ(32 + r32, cb));
        p0 = __builtin_amdgcn_mfma_f32_32x32x16_bf16(b0, qr[d0], d0 == 0 ? negm : p0, 0, 0, 0);
        p1 = __builtin_amdgcn_mfma_f32_32x32x16_bf16(b1, qr[d0], d0 == 0 ? negm : p1, 0, 0, 0); }
}
template <int D0> DI void pv_one(f32x16& od, int vb, bf16x8 pa0, bf16x8 pa1, bf16x8 pa2, bf16x8 pa3) {
    const s16x4 l0 = tr_read<v_rd_off(D0, 0, 0)>(vb), h0 = tr_read<v_rd_off(D0, 0, 1)>(vb), l1 = tr_read<v_rd_off(D0, 1, 0)>(vb), h1 = tr_read<v_rd_off(D0, 1, 1)>(vb);
    const s16x4 l2 = tr_read<v_rd_off(D0, 2, 0)>(vb), h2 = tr_read<v_rd_off(D0, 2, 1)>(vb), l3 = tr_read<v_rd_off(D0, 3, 0)>(vb), h3 = tr_read<v_rd_off(D0, 3, 1)>(vb);
    asm volatile("s_waitcnt lgkmcnt(0)" ::: "memory"); AT_SBAR();
#define AT_PK(L, H) (bf16x8){L[0], L[1], L[2], L[3], H[0], H[1], H[2], H[3]}
    od = __builtin_amdgcn_mfma_f32_32x32x16_bf16(AT_PK(l0, h0), pa0, od, 0, 0, 0);
    od = __builtin_amdgcn_mfma_f32_32x32x16_bf16(AT_PK(l1, h1), pa1, od, 0, 0, 0);
    od = __builtin_amdgcn_mfma_f32_32x32x16_bf16(AT_PK(l2, h2), pa2, od, 0, 0, 0);
    od = __builtin_amdgcn_mfma_f32_32x32x16_bf16(AT_PK(l3, h3), pa3, od, 0, 0, 0);
#undef AT_PK
}
DI void pv_all_sm(f32x16* o, int vb, bf16x8 pa0, bf16x8 pa1, bf16x8 pa2, bf16x8 pa3, f32x16& p0, f32x16& p1, float& m_ref, f32x16& negm, float& alpha) {
    pv_one<0>(o[0], vb, pa0, pa1, pa2, pa3);
    float pmax = p0[0];
#pragma unroll
    for (int r = 1; r < 16; ++r) pmax = fmaxf(pmax, p0[r]);
    pv_one<1>(o[1], vb, pa0, pa1, pa2, pa3);
#pragma unroll
    for (int r = 0; r < 16; ++r) pmax = fmaxf(pmax, p1[r]);
    { auto rr = __builtin_amdgcn_permlane32_swap(__float_as_uint(pmax), __float_as_uint(pmax), false, false); pmax = fmaxf(__uint_as_float(rr[0]), __uint_as_float(rr[1])); }
    pv_one<2>(o[2], vb, pa0, pa1, pa2, pa3);
    alpha = 1.f;
    if (__builtin_expect(!__all(pmax <= THRL), 0)) {
        const float dl = fmaxf(pmax, 0.f); m_ref += dl; alpha = __builtin_amdgcn_exp2f(-dl);
#pragma unroll
        for (int r = 0; r < 16; ++r) { p0[r] -= dl; p1[r] -= dl; }
#pragma unroll
        for (int r = 0; r < 16; ++r) negm[r] = -m_ref;
    }
    pv_one<3>(o[3], vb, pa0, pa1, pa2, pa3);
#pragma unroll
    for (int r = 0; r < 16; ++r) p0[r] = __builtin_amdgcn_exp2f(p0[r]);
}
DI void pv_all(f32x16* o, int vb, bf16x8 pa0, bf16x8 pa1, bf16x8 pa2, bf16x8 pa3) {
    pv_one<0>(o[0], vb, pa0, pa1, pa2, pa3); pv_one<1>(o[1], vb, pa0, pa1, pa2, pa3); pv_one<2>(o[2], vb, pa0, pa1, pa2, pa3); pv_one<3>(o[3], vb, pa0, pa1, pa2, pa3);
}
constexpr int OFF_CV = OFF_ST + 65536, CV_TILE = 64 * 68, CV_NITEM = 192;
struct CvRide { int ci, pend; };
DI void cv_ptrs(const Frame& F, int i, const float*& src, unsigned char*& dst) {
    const int p = 6 * F.wg + (i >> 5), nb = i & 31, q = p >> 5, kb = p & 31, ty = q >> 4, e = q & 15;
    const float* W = (const float*)F.in[ty == 0 ? I_WGATE : (ty == 1 ? I_WUP : I_WDOWN)] + (size_t)e * D * FF;
    src = W + (size_t)(kb * 64) * 2048 + nb * 64;
    const int n0 = nb * 64, r0 = ty < 2 ? ((n0 >> 7) << 8) + (n0 & 127) + ty * 128 : n0;
    unsigned char* WT8 = ty < 2 ? (unsigned char*)(F.ws + WS_W1T) + (size_t)e * 4096 * 2048 : (unsigned char*)(F.ws + WS_W2T) + (size_t)e * 2048 * 2048;
    dst = WT8 + (size_t)r0 * 2048 + kb * 64;
}
DI void attn_pass(const Frame& F, CvRide& cv, const bf16_t* __restrict__ Qb, const bf16_t* __restrict__ Kh, const bf16_t* __restrict__ Vh, char* lds, f32x16 (&o)[4], float& l_out, const int wave_s) {
    const int tid = tid_fresh(wave_s), wid = tid >> 6, lane = tid & 63, r32 = lane & 31, hi = lane >> 5;
    char* V_lds = lds + OFF_V; char* K_lds = lds + OFF_K;
    float m_ref = 0.f, l_reg = 0.f; bf16x8 qr[4]; f32x16 negm = f32x16{};
#pragma unroll
    for (int d = 0; d < 4; ++d) o[d] = f32x16{};
    const bf16_t* Qw = Qb + (size_t)(wid * 32 + r32) * 64 + hi * 8;
#pragma unroll
    for (int d0 = 0; d0 < 4; ++d0) qr[d0] = *reinterpret_cast<const bf16x8*>(Qw + d0 * 16);
    const int sr = tid >> 4, sc = (tid & 15) * 8, vst0 = v_st(sr, sc), vst1 = v_st(32 + sr, sc);
    const int kr = tid >> 3, kcb = (tid & 7) * 16, kst = AT_KSWZ(kr, kcb);
    const int vb0 = (int)(uintptr_t)V_lds + v_rd_base(lane);
    struct { bf16x8 vs0, vs1, ks0; } sr_[1];
#define AT_SLOAD(i, k0) do { sr_[i].vs0 = *reinterpret_cast<const bf16x8*>(&Vh[(size_t)((k0) + sr) * 128 + sc]); sr_[i].vs1 = *reinterpret_cast<const bf16x8*>(&Vh[(size_t)((k0) + 32 + sr) * 128 + sc]); \
    sr_[i].ks0 = *reinterpret_cast<const bf16x8*>(&Kh[(size_t)((k0) + kr) * 64 + (tid & 7) * 8]); } while (0)
#define AT_SWRITE(b, i) do { *(bf16x8*)(V_lds + (b) * SHM_V + vst0) = sr_[i].vs0; *(bf16x8*)(V_lds + (b) * SHM_V + vst1) = sr_[i].vs1; *(bf16x8*)(K_lds + (b) * SHM_K + kst) = sr_[i].ks0; } while (0)
#define AT_SWAIT() asm volatile("s_waitcnt vmcnt(0)" ::: "memory")
#define AT_RESC(a) do { if (__any((a) < 1.f)) { _Pragma("unroll") for (int d = 0; d < 4; ++d) _Pragma("unroll") for (int r = 0; r < 16; ++r) o[d][r] *= (a); } } while (0)
    const unsigned cv_ldo = (unsigned)(((tid >> 4) * 2 * 2048 + (tid & 15) * 4) * 4), cv_sto = (unsigned)((tid >> 3) * 2048 + 8 * (tid & 7));
    const int cv_lw = OFF_CV + (4 * (tid & 15)) * 68 + 2 * (tid >> 4), cv_lr = OFF_CV + (tid >> 3) * 68 + 8 * (tid & 7);
    f32x4 cvA = f32x4{}, cvB = f32x4{}; unsigned cvr0 = 0, cvr1 = 0;
#define AT_CVT2(x, y) __builtin_amdgcn_cvt_pk_fp8_f32(__builtin_amdgcn_fmed3f((x) * F8_WSCALE, -448.f, 448.f), __builtin_amdgcn_fmed3f((y) * F8_WSCALE, -448.f, 448.f), 0, false)
#define AT_CV_READ() do { if (cv.pend) { const char* t_ = lds + cv_lr + ((cv.ci - 1) & 1) * CV_TILE; cvr0 = *(const unsigned*)t_; cvr1 = *(const unsigned*)(t_ + 4); } } while (0)
#define AT_CV_LOAD() do { if (cv.ci < CV_NITEM) { const float* s_; unsigned char* d_; cv_ptrs(F, cv.ci, s_, d_); \
        cvA = __builtin_nontemporal_load((const f32x4*)((const char*)s_ + (size_t)cv_ldo)); cvB = __builtin_nontemporal_load((const f32x4*)((const char*)s_ + 8192 + (size_t)cv_ldo)); } } while (0)
#define AT_CV_STORE() do { if (cv.pend) { const float* s_; unsigned char* d_; cv_ptrs(F, cv.ci - 1, s_, d_); __builtin_nontemporal_store((u32x2){cvr0, cvr1}, (u32x2*)(d_ + (size_t)cv_sto)); cv.pend = 0; } } while (0)
#define AT_CV_TAIL() do { if (cv.ci < CV_NITEM) { char* t_ = lds + cv_lw + (cv.ci & 1) * CV_TILE; \
        _Pragma("unroll") for (int j_ = 0; j_ < 4; ++j_) *(unsigned short*)(t_ + j_ * 68) = (unsigned short)AT_CVT2(cvA[j_], cvB[j_]); cv.pend = 1; ++cv.ci; } } while (0)
    f32x16 pA0, pA1, pB0, pB1; float alA, alB; bf16x8 pa0, pa1, pa2, pa3; constexpr int NT = S / 64;
    constexpr int SE = 0;
    {
        bf16x8 v10 = *reinterpret_cast<const bf16x8*>(&Vh[(size_t)(64 + sr) * 128 + sc]), v11 = *reinterpret_cast<const bf16x8*>(&Vh[(size_t)(96 + sr) * 128 + sc]);
        bf16x8 k10 = *reinterpret_cast<const bf16x8*>(&Kh[(size_t)(64 + kr) * 64 + (tid & 7) * 8]);
        AT_SLOAD(SE, 0); asm volatile("s_waitcnt vmcnt(0)" ::: "memory");
        __syncthreads();
        AT_SWRITE(0, SE);
        *(bf16x8*)(V_lds + SHM_V + vst0) = v10; *(bf16x8*)(V_lds + SHM_V + vst1) = v11; *(bf16x8*)(K_lds + SHM_K + kst) = k10;
        __syncthreads();
    }
    qkt(pA0, pA1, K_lds, qr, negm, r32, hi); partialSM(pA0, pA1, m_ref, negm, alA);
    int s_prev = 0, s_cur = 1, s_next = 2;
#define AT_ROT() do { const int t_ = s_prev; s_prev = s_cur; s_cur = s_next; s_next = t_; } while (0)
#define AT_STEP(X0, X1, Y0, Y1, alX, alY, j_, LOADN) do { \
        AT_CV_READ(); AT_CV_LOAD(); AT_SBAR(); qkt(X0, X1, K_lds + s_cur * SHM_K, qr, negm, r32, hi); \
        finishSM(Y0, Y1, alY, l_reg, pa0, pa1, pa2, pa3); AT_SBAR(); \
        if (LOADN) { AT_SLOAD(SE, ((j_) + 1) * 64); } AT_CV_STORE(); AT_SBAR(); \
        pv_all_sm(o, vb0 + s_prev * SHM_V, pa0, pa1, pa2, pa3, X0, X1, m_ref, negm, alX); \
        AT_SWAIT(); if (LOADN) { AT_SWRITE(s_next, SE); } AT_CV_TAIL(); \
        AT_RESC(alX); __syncthreads(); AT_ROT(); } while (0)
    for (int j = 1; j + 2 < NT; j += 2) {
        AT_STEP(pB0, pB1, pA0, pA1, alB, alA, j, true);
        AT_STEP(pA0, pA1, pB0, pB1, alA, alB, j + 1, true);
    }
    AT_STEP(pB0, pB1, pA0, pA1, alB, alA, NT - 1, false);
    AT_CV_READ(); AT_CV_STORE();
    finishSM(pB0, pB1, alB, l_reg, pa0, pa1, pa2, pa3); AT_SBAR();
    pv_all(o, vb0 + s_prev * SHM_V, pa0, pa1, pa2, pa3);
#undef AT_STEP
#undef AT_ROT
    l_out = l_reg;
#undef AT_CVT2
#undef AT_CV_READ
#undef AT_CV_LOAD
#undef AT_CV_STORE
#undef AT_CV_TAIL
#undef AT_SLOAD
#undef AT_SWRITE
#undef AT_SWAIT
#undef AT_RESC
}
}

DI void attn_unit(const Frame& F, att::CvRide& cv, int bh, int qb, float lam) {
    using namespace att;
    const int tid = tid_fresh(F.wave), lane = tid & 63, wid = tid >> 6, r32 = lane & 31, hi = lane >> 5;
    const bf16_t* QD = (const bf16_t*)(F.ws + WS_QD); const bf16_t* KD = (const bf16_t*)(F.ws + WS_KD); const bf16_t* VD = (const bf16_t*)(F.ws + WS_VD);
    unsigned* stash = (unsigned*)(F.lds + OFF_ST) + wid * 2048;
    const bf16_t* Vh = VD + (size_t)bh * S * 128;
    f32x16 o[4]; float l;
    attn_pass(F, cv, QD + ((size_t)(bh * 2 + 0) * S + qb * 256) * 64, KD + (size_t)(bh * 2 + 0) * S * 64, Vh, (char*)F.lds, o, l, F.wave);
    { const float rl = 1.f / l;
#pragma unroll
      for (int d = 0; d < 4; ++d)
#pragma unroll
          for (int r = 0; r < 16; r += 2) stash[(d * 8 + (r >> 1)) * 64 + lane] = pk2(o[d][r] * rl, o[d][r + 1] * rl); }
    attn_pass(F, cv, QD + ((size_t)(bh * 2 + 1) * S + qb * 256) * 64, KD + (size_t)(bh * 2 + 1) * S * 64, Vh, (char*)F.lds, o, l, F.wave);
    { const float rl = lam / l; float ss = 0.f;
#pragma unroll
      for (int d = 0; d < 4; ++d)
#pragma unroll
          for (int r = 0; r < 16; r += 2) { const unsigned w = stash[(d * 8 + (r >> 1)) * 64 + lane]; o[d][r] = bflo(w) - o[d][r] * rl; o[d][r + 1] = bfhi(w) - o[d][r + 1] * rl; ss += o[d][r] * o[d][r] + o[d][r + 1] * o[d][r + 1]; }
      { auto rr = __builtin_amdgcn_permlane32_swap(__float_as_uint(ss), __float_as_uint(ss), false, false); ss = __uint_as_float(rr[0]) + __uint_as_float(rr[1]); }
      const float rs = rsqrtf(ss * (1.f / 128.f) + NORM_EPS) * (1.f - LAM_INIT);
      const float* gain = (const float*)F.in[I_SUBLN];
      const int b = bh >> 3, h = bh & 7;
      f32x4 gq[4][4];
#pragma unroll
      for (int d = 0; d < 4; ++d)
#pragma unroll
          for (int g = 0; g < 4; ++g) gq[d][g] = *(const f32x4*)(gain + 32 * d + 8 * g + 4 * hi);
      bf16_t* obase = (bf16_t*)(F.ws + WS_MIXIN) + (size_t)(b * S + qb * 256 + wid * 32) * D + h * 128;
      char* tb = (char*)stash;
#pragma unroll
      for (int hf = 0; hf < 2; ++hf) {
#pragma unroll
          for (int dd = 0; dd < 2; ++dd)
#pragma unroll
              for (int gp = 0; gp < 2; ++gp) { const int d = 2 * hf + dd, g0 = 2 * gp, g1 = g0 + 1; const f32x4 ga = gq[d][g0], gb = gq[d][g1];
                  const unsigned a0 = pk2(o[d][4 * g0] * rs * ga[0], o[d][4 * g0 + 1] * rs * ga[1]), a1 = pk2(o[d][4 * g0 + 2] * rs * ga[2], o[d][4 * g0 + 3] * rs * ga[3]);
                  const unsigned b0 = pk2(o[d][4 * g1] * rs * gb[0], o[d][4 * g1 + 1] * rs * gb[1]), b1 = pk2(o[d][4 * g1 + 2] * rs * gb[2], o[d][4 * g1 + 3] * rs * gb[3]);
                  auto r0 = __builtin_amdgcn_permlane32_swap(a0, b0, false, false); auto r1 = __builtin_amdgcn_permlane32_swap(a1, b1, false, false);
                  char* wp = tb + r32 * 136 + (32 * dd + 16 * gp + 8 * hi) * 2;
                  *(u32x2*)wp = (u32x2){r0[0], r1[0]}; *(u32x2*)(wp + 8) = (u32x2){r0[1], r1[1]}; }
          asm volatile("s_waitcnt lgkmcnt(0)" ::: "memory");
#pragma unroll
          for (int q = 0; q < 4; ++q) { const int row = (lane >> 3) + 8 * q, ch = lane & 7; const char* rp = tb + row * 136 + ch * 16;
              const u32x2 lo = *(const u32x2*)rp, hi2 = *(const u32x2*)(rp + 8);
              *(u32x4*)(obase + (size_t)row * D + hf * 64 + ch * 8) = (u32x4){lo.x, lo.y, hi2.x, hi2.y}; }
          asm volatile("s_waitcnt lgkmcnt(0)" ::: "memory");
      } }
}
DI void convert_experts_slice(const Frame& F);
DI void ph_attn(const Frame& F) {
    const float lam = diff_lambda((const float*)F.in[I_LQ1], (const float*)F.in[I_LK1], (const float*)F.in[I_LQ2], (const float*)F.in[I_LK2], F.lane);
    const int x = F.wg & 7, j = F.wg >> 3;
    if (F.nwg == 256) { att::CvRide cv{0, 0};
        attn_unit(F, cv, 0 * 16 + x * 2 + (j >> 4), j & 15, lam);
        attn_unit(F, cv, 1 * 16 + x * 2 + (j >> 4), j & 15, lam); }
    else { att::CvRide cv{att::CV_NITEM, 0}; for (int u = F.wg; u < NB * NH * 16; u += F.nwg) attn_unit(F, cv, u >> 4, u & 15, lam); __syncthreads(); convert_experts_slice(F); __syncthreads(); }
}


namespace ret {
using att::bf16x8; using att::s16x4; using att::f32x16; using att::crow; using att::cvtpk; using att::v_st; using att::v_rd_base; using att::v_rd_off; using att::tr_read;
#define RT_KSWZ(row, colB) ((row) * 256 + ((colB) ^ (((row) & 7) << 4)))
DI bf16x8 scale8(bf16x8 v, float s) { const u32x4 w = __builtin_bit_cast(u32x4, v); u32x4 o; o.x = cvtpk(bflo(w.x) * s, bfhi(w.x) * s); o.y = cvtpk(bflo(w.y) * s, bfhi(w.y) * s); o.z = cvtpk(bflo(w.z) * s, bfhi(w.z) * s); o.w = cvtpk(bflo(w.w) * s, bfhi(w.w) * s); return __builtin_bit_cast(bf16x8, o); }
#define RT_PK(L, H) (bf16x8){L[0], L[1], L[2], L[3], H[0], H[1], H[2], H[3]}
template <int TOFF> DI void kv_step4(f32x16& acc, int vbK, int vbV) {
    const s16x4 ka0 = tr_read<TOFF + v_rd_off(0, 0, 0)>(vbK), kb0 = tr_read<TOFF + v_rd_off(0, 0, 1)>(vbK), va0 = tr_read<TOFF + v_rd_off(0, 0, 0)>(vbV), vb0 = tr_read<TOFF + v_rd_off(0, 0, 1)>(vbV);
    const s16x4 ka1 = tr_read<TOFF + v_rd_off(0, 1, 0)>(vbK), kb1 = tr_read<TOFF + v_rd_off(0, 1, 1)>(vbK), va1 = tr_read<TOFF + v_rd_off(0, 1, 0)>(vbV), vb1 = tr_read<TOFF + v_rd_off(0, 1, 1)>(vbV);
    const s16x4 ka2 = tr_read<TOFF + v_rd_off(0, 2, 0)>(vbK), kb2 = tr_read<TOFF + v_rd_off(0, 2, 1)>(vbK), va2 = tr_read<TOFF + v_rd_off(0, 2, 0)>(vbV), vb2 = tr_read<TOFF + v_rd_off(0, 2, 1)>(vbV);
    const s16x4 ka3 = tr_read<TOFF + v_rd_off(0, 3, 0)>(vbK), kb3 = tr_read<TOFF + v_rd_off(0, 3, 1)>(vbK), va3 = tr_read<TOFF + v_rd_off(0, 3, 0)>(vbV), vb3 = tr_read<TOFF + v_rd_off(0, 3, 1)>(vbV);
    asm volatile("s_waitcnt lgkmcnt(0)" ::: "memory"); __builtin_amdgcn_sched_barrier(0);
    acc = __builtin_amdgcn_mfma_f32_32x32x16_bf16(RT_PK(ka0, kb0), RT_PK(va0, vb0), acc, 0, 0, 0);
    acc = __builtin_amdgcn_mfma_f32_32x32x16_bf16(RT_PK(ka1, kb1), RT_PK(va1, vb1), acc, 0, 0, 0);
    acc = __builtin_amdgcn_mfma_f32_32x32x16_bf16(RT_PK(ka2, kb2), RT_PK(va2, vb2), acc, 0, 0, 0);
    acc = __builtin_amdgcn_mfma_f32_32x32x16_bf16(RT_PK(ka3, kb3), RT_PK(va3, vb3), acc, 0, 0, 0);
}
}

DI void state_unit(const Frame& F, int u) {
    using namespace ret;
    const int tid = tid_fresh(F.wave), lane = tid & 63, hi = lane >> 5;
    const int eh = u & 1, dkh = (u >> 1) & 1, dir = (u >> 2) & 1, bh = u >> 3, h = bh & 7;
    const float* logit = (const float*)F.in[I_DECAY];
    const float lg = log2f(1.f / (1.f + __expf(-logit[dir * 8 + h])));
    const float cd = exp2f(128.f * lg);
    char* lds = (char*)F.lds;
    const bf16_t* RK = (const bf16_t*)(F.ws + WS_RK) + (size_t)bh * S * 128 + dkh * 64; const bf16_t* RV = (const bf16_t*)(F.ws + WS_RV) + (size_t)bh * S * 128 + eh * 64;
    bf16_t* ST = (bf16_t*)(F.ws + WS_ST) + (size_t)((bh * 2 + dir) * 32) * 16384;
    const int srow = tid >> 3, sch = tid & 7;
    float kdec[2];
#pragma unroll
    for (int i = 0; i < 2; ++i) { const int j = srow + 64 * i; kdec[i] = exp2f(lg * (float)(dir ? j : 127 - j)); }
    int kst[2], vst[2];
#pragma unroll
    for (int i = 0; i < 2; ++i) { const int j = srow + 64 * i; kst[i] = (j >> 6) * 16384 + v_st(j & 63, 8 * sch); vst[i] = 32768 + (j >> 6) * 16384 + v_st(j & 63, 8 * sch); }
    const int grp = F.wave >> 2;
    const int rb = (F.wave >> 1) & 1, cb = F.wave & 1;
    const int vbK = (int)(uintptr_t)lds + v_rd_base(lane) + rb * 512, vbV = (int)(uintptr_t)(lds + 32768) + v_rd_base(lane) + cb * 512;
    f32x16 acc = f32x16{};
    bf16x8 kA[2], vA[2], kB[2], vB[2], kC[2], vC[2];
    const unsigned goff = (unsigned)((srow * 128 + 8 * sch) * 2);
#define ST_LOAD(KR, VR, it_) do { const int itc_ = (it_) < 32 ? (it_) : 31; const int n_ = dir ? 31 - itc_ : itc_; unsigned o_ = goff; asm volatile("" : "+v"(o_)); \
    const GAS char* kp_ = (const GAS char*)(RK + (size_t)n_ * 16384); const GAS char* vp_ = (const GAS char*)(RV + (size_t)n_ * 16384); \
    KR[0] = *(const GAS bf16x8*)(kp_ + (size_t)o_); KR[1] = *(const GAS bf16x8*)(kp_ + 16384 + (size_t)o_); VR[0] = *(const GAS bf16x8*)(vp_ + (size_t)o_); VR[1] = *(const GAS bf16x8*)(vp_ + 16384 + (size_t)o_); } while (0)
#define ST_STEP(KR, VR, it_) do { const int n = dir ? 31 - (it_) : (it_); \
        _Pragma("unroll") for (int i = 0; i < 2; ++i) { *(bf16x8*)(lds + kst[i]) = scale8(KR[i], kdec[i]); *(bf16x8*)(lds + vst[i]) = VR[i]; } \
        {   \
              \
            char* sw_ = lds + 65536 + grp * 8704 + (cb * 32 + (lane & 31)) * 136 + (rb * 32 + 4 * hi) * 2; \
            _Pragma("unroll") for (int g = 0; g < 4; ++g) *(u32x2*)(sw_ + 16 * g) = (u32x2){cvtpk(acc[4 * g], acc[4 * g + 1]), cvtpk(acc[4 * g + 2], acc[4 * g + 3])}; } \
        __syncthreads(); \
        ST_LOAD(KR, VR, (it_) + 3); \
        { const char* sr_ = lds + 65536 + srow * 136 + sch * 16; const u32x2 l0_ = *(const u32x2*)sr_, h0_ = *(const u32x2*)(sr_ + 8), l1_ = *(const u32x2*)(sr_ + 8704), h1_ = *(const u32x2*)(sr_ + 8712); \
          *(u32x4*)(ST + (size_t)n * 16384 + (size_t)(eh * 64 + srow) * 128 + dkh * 64 + sch * 8) = \
              (u32x4){cvtpk(bflo(l0_.x) + bflo(l1_.x), bfhi(l0_.x) + bfhi(l1_.x)), cvtpk(bflo(l0_.y) + bflo(l1_.y), bfhi(l0_.y) + bfhi(l1_.y)), \
                      cvtpk(bflo(h0_.x) + bflo(h1_.x), bfhi(h0_.x) + bfhi(h1_.x)), cvtpk(bflo(h0_.y) + bflo(h1_.y), bfhi(h0_.y) + bfhi(h1_.y))}; } \
        { _Pragma("unroll") for (int r = 0; r < 16; ++r) acc[r] *= cd; \
          if (grp == 0) kv_step4<0>(acc, vbK, vbV); else kv_step4<16384>(acc, vbK, vbV); } \
        __syncthreads(); } while (0)
    ST_LOAD(kA, vA, 0); ST_LOAD(kB, vB, 1); ST_LOAD(kC, vC, 2);
    for (int it = 0; it < 30; it += 3) { ST_STEP(kA, vA, it); ST_STEP(kB, vB, it + 1); ST_STEP(kC, vC, it + 2); }
    ST_STEP(kA, vA, 30); ST_STEP(kB, vB, 31);
#undef ST_STEP
#undef ST_LOAD
}

DI void retout_unit(const Frame& F, int u) {
    using namespace ret;
    const int tid = tid_fresh(F.wave), lane = tid & 63, wid = tid >> 6, r32 = lane & 31, hi = lane >> 5;
    const int bh = u >> 4, h = bh & 7, b = bh >> 3, cs = F.wave >> 2, w4 = F.wave & 3, n = 2 * (u & 15) + cs;
    (void)wid;
    const float* logit = (const float*)F.in[I_DECAY];
    const float lgf = log2f(1.f / (1.f + __expf(-logit[h]))), lgb = log2f(1.f / (1.f + __expf(-logit[8 + h])));
    char* lds = (char*)F.lds; char* Kc = lds + cs * 65536; char* Vc = Kc + 32768;
    const bf16_t* RQ = (const bf16_t*)(F.ws + WS_RQ) + ((size_t)bh * S + n * 128) * 128; const bf16_t* RK = (const bf16_t*)(F.ws + WS_RK) + ((size_t)bh * S + n * 128) * 128;
    const bf16_t* RV = (const bf16_t*)(F.ws + WS_RV) + ((size_t)bh * S + n * 128) * 128;
    const int js = w4 * 32 + r32;
    const size_t tok = (size_t)b * S + n * 128 + js;
    {
        const int t2 = tid & 255;
#pragma unroll
        for (int i = 0; i < 8; ++i) { const int p = t2 + 256 * i, row = p >> 4, ch = p & 15;
            *(bf16x8*)(Kc + RT_KSWZ(row, ch * 16)) = *reinterpret_cast<const bf16x8*>(RK + (size_t)row * 128 + 8 * ch);
            *(bf16x8*)(Vc + (row >> 6) * 16384 + v_st(row & 63, 8 * ch)) = *reinterpret_cast<const bf16x8*>(RV + (size_t)row * 128 + 8 * ch); }
    }
    bf16x8 qr[8];
    { const bf16_t* Qw = RQ + (size_t)(w4 * 32 + r32) * 128 + hi * 8;
#pragma unroll
      for (int ks = 0; ks < 8; ++ks) qr[ks] = *reinterpret_cast<const bf16x8*>(Qw + ks * 16); }
    f32x16 acc[4];
#pragma unroll
    for (int d = 0; d < 4; ++d) acc[d] = f32x16{};
    int kad[4];
#pragma unroll
    for (int kl = 0; kl < 4; ++kl) kad[kl] = RT_KSWZ(r32, (kl * 16 + hi * 8) * 2);
    __syncthreads();
#pragma unroll
    for (int t = 0; t < 2; ++t) {
        f32x16 p0 = f32x16{}, p1 = f32x16{};
#pragma unroll
        for (int ks = 0; ks < 8; ++ks) {
            const bf16x8 k0 = *reinterpret_cast<const bf16x8*>(Kc + kad[ks & 3] + (ks >> 2) * 128 + t * 16384);
            const bf16x8 k1 = *reinterpret_cast<const bf16x8*>(Kc + kad[ks & 3] + (ks >> 2) * 128 + t * 16384 + 8192);
            p0 = __builtin_amdgcn_mfma_f32_32x32x16_bf16(k0, qr[ks], p0, 0, 0, 0);
            p1 = __builtin_amdgcn_mfma_f32_32x32x16_bf16(k1, qr[ks], p1, 0, 0, 0);
            if (ks & 1) asm volatile("" ::: "memory"); }
#pragma unroll
        for (int r = 0; r < 16; ++r) { const int jm = t * 64 + crow(r, hi); const int d0 = js - jm, d1 = d0 - 32;
            p0[r] *= __builtin_amdgcn_exp2f((d0 >= 0 ? lgf : -lgb) * (float)d0);
            p1[r] *= __builtin_amdgcn_exp2f((d1 >= 0 ? lgf : -lgb) * (float)d1); }
        bf16x8 pa0, pa1, pa2, pa3;
#define RT_PK4(P, BASE, OUT) do { unsigned a0 = cvtpk(P[BASE + 0], P[BASE + 1]), a1 = cvtpk(P[BASE + 2], P[BASE + 3]);   \
    unsigned b0 = cvtpk(P[BASE + 4], P[BASE + 5]), b1 = cvtpk(P[BASE + 6], P[BASE + 7]);                              \
    auto r0 = __builtin_amdgcn_permlane32_swap(a0, b0, false, false); auto r1 = __builtin_amdgcn_permlane32_swap(a1, b1, false, false); \
    u32x4 w = {r0[0], r1[0], r0[1], r1[1]}; OUT = __builtin_bit_cast(bf16x8, w); } while (0)
        RT_PK4(p0, 0, pa0); RT_PK4(p0, 8, pa1); RT_PK4(p1, 0, pa2); RT_PK4(p1, 8, pa3);
#undef RT_PK4
        att::pv_all(acc, (int)(uintptr_t)(Vc + t * 16384) + v_rd_base(lane), pa0, pa1, pa2, pa3);
    }
    __syncthreads();
    {
        const bf16_t* Sf = (const bf16_t*)(F.ws + WS_ST) + (size_t)((bh * 2 + 0) * 32 + n) * 16384;
        const bf16_t* Sb = (const bf16_t*)(F.ws + WS_ST) + (size_t)((bh * 2 + 1) * 32 + n) * 16384;
        const char* sfb = pg8::uni((const char*)Sf); const char* sbb = pg8::uni((const char*)Sb);
        const unsigned ldk = (unsigned)__builtin_amdgcn_readfirstlane((unsigned)(uintptr_t)Kc + (unsigned)w4 * 8192u), ldv = (unsigned)__builtin_amdgcn_readfirstlane((unsigned)(uintptr_t)Vc + (unsigned)w4 * 8192u);
        unsigned vo[2];
#pragma unroll
        for (int par = 0; par < 2; ++par) { const int rowl = par * 4 + (lane >> 4); vo[par] = (unsigned)((lane >> 4) * 256 + (((lane & 15) ^ (rowl & 7)) << 4)); }
#pragma unroll
        for (int i = 0; i < 8; ++i) {
            asm volatile("s_mov_b32 m0, %2\n\ts_nop 0\n\tglobal_load_lds_dwordx4 %0, %1" :: "v"(vo[i & 1]), "s"(sfb + (size_t)(w4 * 8 + i) * 1024), "s"(ldk + (unsigned)i * 1024u) : "memory", "m0");
            asm volatile("s_mov_b32 m0, %2\n\ts_nop 0\n\tglobal_load_lds_dwordx4 %0, %1" :: "v"(vo[i & 1]), "s"(sbb + (size_t)(w4 * 8 + i) * 1024), "s"(ldv + (unsigned)i * 1024u) : "memory", "m0");
        }
    }
    const float* gain = (const float*)F.in[I_RETG] + h * 128;
    const bf16_t* grow = (const bf16_t*)(F.ws + WS_RG) + tok * 1024 + h * 128;
    asm volatile("s_waitcnt vmcnt(0)" ::: "memory");
    __syncthreads();
    const float rsf = exp2f(lgf * (float)(js + 1)), rsb = exp2f(lgb * (float)(128 - js));
#pragma unroll
    for (int dir = 0; dir < 2; ++dir) {
        const char* img = dir ? Vc : Kc; const float rs = dir ? rsb : rsf;
#pragma unroll
        for (int t = 0; t < 2; ++t) {
            f32x16 c0 = f32x16{}, c1 = f32x16{};
#pragma unroll
            for (int ks = 0; ks < 8; ++ks) {
                const bf16x8 s0 = *reinterpret_cast<const bf16x8*>(img + kad[ks & 3] + (ks >> 2) * 128 + t * 16384);
                const bf16x8 s1 = *reinterpret_cast<const bf16x8*>(img + kad[ks & 3] + (ks >> 2) * 128 + t * 16384 + 8192);
                c0 = __builtin_amdgcn_mfma_f32_32x32x16_bf16(s0, qr[ks], c0, 0, 0, 0);
                c1 = __builtin_amdgcn_mfma_f32_32x32x16_bf16(s1, qr[ks], c1, 0, 0, 0);
                if (ks & 1) asm volatile("" ::: "memory"); }
#pragma unroll
            for (int r = 0; r < 16; ++r) { acc[2 * t][r] += rs * c0[r]; acc[2 * t + 1][r] += rs * c1[r]; }
        }
    }
    f32x4 gq[4][4];
#pragma unroll
    for (int d = 0; d < 4; ++d)
#pragma unroll
        for (int g = 0; g < 4; ++g) gq[d][g] = *(const f32x4*)(gain + 32 * d + 8 * g + 4 * hi);
    u32x2 gtq[4][4];
#pragma unroll
    for (int d = 0; d < 4; ++d)
#pragma unroll
        for (int g = 0; g < 4; ++g) gtq[d][g] = *(const u32x2*)(grow + 32 * d + 8 * g + 4 * hi);
    float sm = 0.f;
#pragma unroll
    for (int d = 0; d < 4; ++d)
#pragma unroll
        for (int r = 0; r < 16; ++r) sm += acc[d][r];
    { auto rr = __builtin_amdgcn_permlane32_swap(__float_as_uint(sm), __float_as_uint(sm), false, false); sm = __uint_as_float(rr[0]) + __uint_as_float(rr[1]); }
    const float mu = sm * (1.f / 128.f); float sq = 0.f;
#pragma unroll
    for (int d = 0; d < 4; ++d)
#pragma unroll
        for (int r = 0; r < 16; ++r) { acc[d][r] -= mu; sq += acc[d][r] * acc[d][r]; }
    { auto rr = __builtin_amdgcn_permlane32_swap(__float_as_uint(sq), __float_as_uint(sq), false, false); sq = __uint_as_float(rr[0]) + __uint_as_float(rr[1]); }
    const float rs = rsqrtf(sq * (1.f / 128.f) + NORM_EPS);
    bf16_t* orow = (bf16_t*)(F.ws + WS_MIXIN) + tok * D + 1024 + h * 128;
#pragma unroll
    for (int d = 0; d < 4; ++d)
#pragma unroll
        for (int gp = 0; gp < 2; ++gp) { const int g0 = 2 * gp, g1 = g0 + 1; const f32x4 ga = gq[d][g0], gb = gq[d][g1]; const u32x2 ta = gtq[d][g0], tb = gtq[d][g1];
            const unsigned a0 = pk2(acc[d][4 * g0] * rs * ga[0] * bflo(ta.x), acc[d][4 * g0 + 1] * rs * ga[1] * bfhi(ta.x)), a1 = pk2(acc[d][4 * g0 + 2] * rs * ga[2] * bflo(ta.y), acc[d][4 * g0 + 3] * rs * ga[3] * bfhi(ta.y));
            const unsigned b0 = pk2(acc[d][4 * g1] * rs * gb[0] * bflo(tb.x), acc[d][4 * g1 + 1] * rs * gb[1] * bfhi(tb.x)), b1 = pk2(acc[d][4 * g1 + 2] * rs * gb[2] * bflo(tb.y), acc[d][4 * g1 + 3] * rs * gb[3] * bfhi(tb.y));
            auto r0 = __builtin_amdgcn_permlane32_swap(a0, b0, false, false); auto r1 = __builtin_amdgcn_permlane32_swap(a1, b1, false, false);
            *(u32x4*)(orow + 32 * d + 16 * gp + 8 * hi) = (u32x4){r0[0], r1[0], r0[1], r1[1]}; }
    __syncthreads();
}
DI void ph_state(const Frame& F) {
    for (int v = F.wg; v < NB * NH * 8; v += F.nwg) { const int x = v & 7, idx = v >> 3; state_unit(F, (x + 8 * (idx >> 3)) * 8 + (idx & 7)); } }
DI void ph_retout(const Frame& F) { for (int u = F.wg; u < NB * NH * 16; u += F.nwg) retout_unit(F, u); }

DI void ph_prenorm(const Frame& F) {
    const float* x = (const float*)F.in[I_X]; const float* g = (const float*)F.in[I_GPREMIX];
    const float* mod = (const float*)(F.ws + WS_MOD);
    bf16_t* H = (bf16_t*)(F.ws + WS_H);
    const int gw = F.wg * NWAVES + F.wave, ngw = F.nwg * NWAVES;
    for (int r0 = gw * 8; r0 < M; r0 += ngw * 8) {
        const int b = r0 >> 12;
        const float* shift = mod + (size_t)b * 6 * D, * scale = shift + D;
        f32x4 pg[8], ps[8];
#pragma unroll
        for (int j = 0; j < 8; ++j) { const int d0 = 4 * F.lane + 256 * j; const f32x4 gg = *(const f32x4*)(g + d0), sc = *(const f32x4*)(scale + d0) + *(const f32x4*)(scale + MOD_HALF + d0); ps[j] = *(const f32x4*)(shift + d0) + *(const f32x4*)(shift + MOD_HALF + d0);
#pragma unroll
            for (int i = 0; i < 4; ++i) pg[j][i] = gg[i] * (1.f + sc[i]); }
        for (int m = r0; m < r0 + 8; m += 2) {
            const f32x4* xr = (const f32x4*)(x + (size_t)m * D) + F.lane;
            f32x4 v[8], w[8]; float ss = 0.f, ss2 = 0.f;
#pragma unroll
            for (int j = 0; j < 8; ++j) { v[j] = __builtin_nontemporal_load(xr + 64 * j); w[j] = __builtin_nontemporal_load(xr + 512 + 64 * j); }
#pragma unroll
            for (int j = 0; j < 8; ++j) { ss += (v[j][0] * v[j][0] + v[j][1] * v[j][1]) + (v[j][2] * v[j][2] + v[j][3] * v[j][3]); ss2 += (w[j][0] * w[j][0] + w[j][1] * w[j][1]) + (w[j][2] * w[j][2] + w[j][3] * w[j][3]); }
            const float rstd = rsqrtf(wave_sum(ss) * (1.f / D) + NORM_EPS), rstd2 = rsqrtf(wave_sum(ss2) * (1.f / D) + NORM_EPS);
#pragma unroll
            for (int j = 0; j < 8; ++j) {
                float o[4], o2[4];
#pragma unroll
                for (int i = 0; i < 4; ++i) { o[i] = v[j][i] * rstd * pg[j][i] + ps[j][i]; o2[i] = w[j][i] * rstd2 * pg[j][i] + ps[j][i]; }
#if F8_IN
                ((unsigned*)((unsigned char*)H + (size_t)m * D))[F.lane + 64 * j] = pk4_f8(o[0] * F8_HSCALE, o[1] * F8_HSCALE, o[2] * F8_HSCALE, o[3] * F8_HSCALE);
                ((unsigned*)((unsigned char*)H + (size_t)(m + 1) * D))[F.lane + 64 * j] = pk4_f8(o2[0] * F8_HSCALE, o2[1] * F8_HSCALE, o2[2] * F8_HSCALE, o2[3] * F8_HSCALE);
#else
                ((u32x2*)(H + (size_t)m * D) + F.lane)[64 * j] = (u32x2){pk2(o[0], o[1]), pk2(o[2], o[3])};
                ((u32x2*)(H + (size_t)(m + 1) * D) + F.lane)[64 * j] = (u32x2){pk2(o2[0], o2[1]), pk2(o2[2], o2[3])};
#endif
            }
        }
    }
}

DI void ph_rowpass(const Frame& F) {
    const float* x = (const float*)F.in[I_X]; const float* gpm = (const float*)F.in[I_GPOSTMIX]; const float* gpf = (const float*)F.in[I_GPREFFN];
    const float* wr = (const float*)F.in[I_WROUTER];
    const float* mod = (const float*)(F.ws + WS_MOD);
    const bf16_t* MIX = (const bf16_t*)(F.ws + WS_MIX);
    bf16_t* X1 = (bf16_t*)(F.ws + WS_X1); bf16_t* H2 = (bf16_t*)(F.ws + WS_H); float* AFF = (float*)(F.ws + WS_AFF);
    f32x4* wl = (f32x4*)F.lds;
    {
        f32x4 wt[16];
#pragma unroll
        for (int i = 0; i < 16; ++i) wt[i] = ((const f32x4*)wr)[F.tid + NTHR * i];
#pragma unroll
        for (int i = 0; i < 16; ++i) { const int si = F.tid + NTHR * i, d = si >> 2, q = si & 3; wl[((((d >> 8) * 4 + (d & 3)) * 4 + q) << 6) + ((d & 255) >> 2)] = wt[i]; }
    }
    f32x4* pgm = (f32x4*)(F.lds + 131072); f32x4* pgf = pgm + 512; f32x4* psh = pgf + 512;
    for (int blk = F.wg; blk < M / 64; blk += F.nwg) {
        const int bb = (blk * 64) >> 12; const float* mb = mod + (size_t)bb * 6 * D;
        __syncthreads();
        { const int d4 = F.tid; const f32x4 a = ((const f32x4*)gpm)[d4], g1 = ((const f32x4*)(mb + 2 * D))[d4] + ((const f32x4*)(mb + MOD_HALF + 2 * D))[d4], c = ((const f32x4*)gpf)[d4], sc = ((const f32x4*)(mb + 4 * D))[d4] + ((const f32x4*)(mb + MOD_HALF + 4 * D))[d4];
          pgm[d4] = a * g1; pgf[d4] = c * (1.f + sc); psh[d4] = ((const f32x4*)(mb + 3 * D))[d4] + ((const f32x4*)(mb + MOD_HALF + 3 * D))[d4]; }
        if ((blk & 63) == 0) { const int d4 = F.tid; ((f32x4*)((float*)(F.ws + WS_MOD) + 2 * MOD_HALF + (size_t)bb * D))[d4] = ((const f32x4*)(mb + 5 * D))[d4] + ((const f32x4*)(mb + MOD_HALF + 5 * D))[d4]; }
        __syncthreads();
      for (int m = blk * 64 + F.wave * 8; m < blk * 64 + F.wave * 8 + 8; ++m) {
        const int b = m >> 12, s = m & 4095;
        const u32x2* mr = (const u32x2*)(MIX + (size_t)m * D) + F.lane;
        f32x4 v[8]; float ss = 0.f;
#pragma unroll
        for (int j = 0; j < 8; ++j) { const u32x2 w = __builtin_nontemporal_load(mr + 64 * j); v[j] = (f32x4){bflo(w.x), bfhi(w.x), bflo(w.y), bfhi(w.y)}; ss += (v[j][0] * v[j][0] + v[j][1] * v[j][1]) + (v[j][2] * v[j][2] + v[j][3] * v[j][3]); }
        const f32x4* xr = (const f32x4*)(x + (size_t)m * D) + F.lane;
        f32x4 xc[8];
#pragma unroll
        for (int j = 0; j < 8; ++j) xc[j] = __builtin_nontemporal_load(xr + 64 * j);
        const float rstd = rsqrtf(wave_sum(ss) * (1.f / D) + NORM_EPS);
        u32x2* x1r = (u32x2*)(X1 + (size_t)m * D) + F.lane;
        float ss2 = 0.f;
#pragma unroll
        for (int j = 0; j < 8; ++j) {
            const f32x4 gg = pgm[F.lane + 64 * j], xv = xc[j];
#pragma unroll
            for (int i = 0; i < 4; ++i) v[j][i] = xv[i] + (v[j][i] * rstd) * gg[i];
            x1r[64 * j] = (u32x2){pk2(v[j][0], v[j][1]), pk2(v[j][2], v[j][3])};
            ss2 += (v[j][0] * v[j][0] + v[j][1] * v[j][1]) + (v[j][2] * v[j][2] + v[j][3] * v[j][3]);
        }
        const float rstd2 = rsqrtf(wave_sum(ss2) * (1.f / D) + NORM_EPS);
        u32x2* h2r = (u32x2*)(H2 + (size_t)m * D) + F.lane;
        f32x2 lgp[8];
#pragma unroll
        for (int e = 0; e < 8; ++e) lgp[e] = (f32x2){0.f, 0.f};
#pragma unroll
        for (int j = 0; j < 8; ++j) {
            const f32x4 gg = pgf[F.lane + 64 * j], sh = psh[F.lane + 64 * j];
            float h[4];
#pragma unroll
            for (int i = 0; i < 4; ++i) h[i] = v[j][i] * rstd2 * gg[i] + sh[i];
#if F8_E1
            ((unsigned*)((unsigned char*)H2 + (size_t)m * D))[F.lane + 64 * j] = pk4_f8(h[0] * F8_HSCALE, h[1] * F8_HSCALE, h[2] * F8_HSCALE, h[3] * F8_HSCALE);
#else
            h2r[64 * j] = (u32x2){pk2(h[0], h[1]), pk2(h[2], h[3])};
#endif
#pragma unroll
            for (int i = 0; i < 4; ++i) v[j][i] = h[i];
        }
        {
            f32x4 wq0[4], wq1[4], wq2[4];
#define RT_LD(W, t_) do { _Pragma("unroll") for (int q = 0; q < 4; ++q) W[q] = wl[((((t_)) * 4 + q) << 6) + F.lane]; } while (0)
#define RT_FMA(W, t_) do { const float hv_ = v[(t_) >> 2][(t_) & 3]; const f32x2 hh = {hv_, hv_}; _Pragma("unroll") for (int q = 0; q < 4; ++q) { \
                lgp[2 * q] = __builtin_elementwise_fma(hh, (f32x2){W[q][0], W[q][1]}, lgp[2 * q]); lgp[2 * q + 1] = __builtin_elementwise_fma(hh, (f32x2){W[q][2], W[q][3]}, lgp[2 * q + 1]); } \
                asm volatile("" ::: "memory"); } while (0)
            RT_LD(wq0, 0); RT_LD(wq1, 1);
#pragma unroll
            for (int t = 0; t < 30; t += 3) { RT_LD(wq2, t + 2); RT_FMA(wq0, t); RT_LD(wq0, t + 3); RT_FMA(wq1, t + 1); RT_LD(wq1, t + 4); RT_FMA(wq2, t + 2); }
            RT_FMA(wq0, 30); RT_FMA(wq1, 31);
#undef RT_LD
#undef RT_FMA
        }
        {
            const float tot = expert_totals16(lgp, F.lane);
            const float pe = __expf(tot - experts_max(tot));
            const float prob = pe * (1.f / experts_sum(pe));
            if ((F.lane & 3) == 0) AFF[((size_t)b * NE + (F.lane >> 2)) * S + s] = prob;
        }
      }
    }
}

DI int block_scan_incl(int v, volatile LAS int* sw, int tid) {
    const int lane = tid & 63, wid = tid >> 6;
#pragma unroll
    for (int o = 1; o < 64; o <<= 1) { const int t = __shfl_up(v, o); if (lane >= o) v += t; }
    if (lane == 63) sw[wid] = v;
    __syncthreads();
    int off = 0;
    for (int i = 0; i < wid; ++i) off += sw[i];
    __syncthreads();
    return v + off;
}
DI void ph_topk(const Frame& F) {
    const float* AFF = (const float*)(F.ws + WS_AFF);
    int* rowmap = (int*)(F.ws + WS_ROWMAP); float* gatev = (float*)(F.ws + WS_GATEV); int* sel = (int*)(F.ws + WS_SEL);
    volatile LAS int* hist = (volatile LAS int*)F.ldsl;
    volatile LAS int* sw = (volatile LAS int*)(F.ldsl + 1024);
    volatile LAS int* bc = (volatile LAS int*)(F.ldsl + 1024 + 64);
    for (int u = F.wg; u < NB * NE; u += F.nwg) {
        const int b = u >> 4, e = u & 15;
        const float* a = AFF + (size_t)u * S;
        unsigned key[8];
        { const u32x4 k0 = *(const u32x4*)(a + F.tid * 8), k1 = *(const u32x4*)(a + F.tid * 8 + 4); key[0] = k0.x; key[1] = k0.y; key[2] = k0.z; key[3] = k0.w; key[4] = k1.x; key[5] = k1.y; key[6] = k1.z; key[7] = k1.w; }
        unsigned prefix = 0u; int krem = CAP;
#pragma unroll
        for (int pass = 0; pass < 4; ++pass) {
            const int shift = 24 - 8 * pass;
            if (F.tid < 256) hist[F.tid] = 0;
            __syncthreads();
#pragma unroll
            for (int j = 0; j < 8; ++j) { const bool match = (pass == 0) || ((key[j] >> (shift + 8)) == prefix); if (match) __hip_atomic_fetch_add((LAS int*)&hist[(key[j] >> shift) & 255u], 1, __ATOMIC_RELAXED, __HIP_MEMORY_SCOPE_WORKGROUP); }
            __syncthreads();
            const int mybin = 255 - F.tid;
            const int my = F.tid < 256 ? hist[mybin] : 0;
            const int suf = block_scan_incl(my, sw, F.tid);
            if (F.tid < 256 && suf >= krem && suf - my < krem) { bc[0] = mybin; bc[1] = krem - (suf - my); }
            __syncthreads();
            prefix = (prefix << 8) | (unsigned)bc[0]; krem = bc[1];
            __syncthreads();
        }
        int neq = 0;
#pragma unroll
        for (int j = 0; j < 8; ++j) neq += (key[j] == prefix) ? 1 : 0;
        int eqbase = block_scan_incl(neq, sw, F.tid) - neq;
        int nsel = 0; bool flag[8];
#pragma unroll
        for (int j = 0; j < 8; ++j) { const bool eq = key[j] == prefix; flag[j] = key[j] > prefix || (eq && eqbase < krem); eqbase += eq ? 1 : 0; nsel += flag[j] ? 1 : 0; }
        int slot = block_scan_incl(nsel, sw, F.tid) - nsel;
        int slv[8];
#pragma unroll
        for (int j = 0; j < 8; ++j) {
            const int s = F.tid * 8 + j;
            int sl = -1;
            if (flag[j]) { sl = slot++; if (sl < CAP) { rowmap[e * 2048 + b * CAP + sl] = b * S + s; gatev[e * 2048 + b * CAP + sl] = __uint_as_float(key[j]); } else sl = -1; }
            slv[j] = sl;
        }
        { u32x4* sp = (u32x4*)(sel + (size_t)u * S + F.tid * 8);
          sp[0] = (u32x4){(unsigned)slv[0], (unsigned)slv[1], (unsigned)slv[2], (unsigned)slv[3]}; sp[1] = (u32x4){(unsigned)slv[4], (unsigned)slv[5], (unsigned)slv[6], (unsigned)slv[7]}; }
        __syncthreads();
    }
}

DI void ph_final(const Frame& F) {
    const bf16_t* X1 = (const bf16_t*)(F.ws + WS_X1); const bf16_t* Y = (const bf16_t*)(F.ws + WS_Y); const int* sel = (const int*)(F.ws + WS_SEL);
    const float* mod = (const float*)(F.ws + WS_MOD); const float* g = (const float*)F.in[I_GPOSTFFN];
    const int gw = F.wg * NWAVES + F.wave, ngw = F.nwg * NWAVES;
    for (int r0 = 8 * gw; r0 < M; r0 += 8 * ngw) {
      const int b = r0 >> 12;
      const float* g2 = mod + 2 * MOD_HALF + (size_t)b * D;
      f32x4 ggt[8];
#pragma unroll
      for (int j = 0; j < 8; ++j) { const int d0 = 4 * F.lane + 256 * j; ggt[j] = *(const f32x4*)(g + d0) * *(const f32x4*)(g2 + d0); }
      int slots[8];
      { const u32x4* sp = (const u32x4*)(sel + ((size_t)b * NE + (F.lane & 15)) * S + (r0 & 4095)); const u32x4 s0 = sp[0], s1 = sp[1];
        slots[0] = (int)s0.x; slots[1] = (int)s0.y; slots[2] = (int)s0.z; slots[3] = (int)s0.w; slots[4] = (int)s1.x; slots[5] = (int)s1.y; slots[6] = (int)s1.z; slots[7] = (int)s1.w; }
#pragma unroll
      for (int pr = 0; pr < 4; ++pr) {
        const int m = r0 + 2 * pr;
        f32x4 acc[2][8];
#pragma unroll
        for (int rw = 0; rw < 2; ++rw)
#pragma unroll
            for (int j = 0; j < 8; ++j) acc[rw][j] = (f32x4){0.f, 0.f, 0.f, 0.f};
        const int myslot0 = slots[2 * pr], myslot1 = slots[2 * pr + 1];
        u32x2 xw[2][8];
#pragma unroll
        for (int rw = 0; rw < 2; ++rw)
#pragma unroll
            for (int j = 0; j < 8; ++j) xw[rw][j] = __builtin_nontemporal_load((const u32x2*)(X1 + (size_t)(m + rw) * D) + F.lane + 64 * j);
        unsigned m0 = (unsigned)(__ballot(myslot0 >= 0) & 0xFFFFull), m1 = (unsigned)(__ballot(myslot1 >= 0) & 0xFFFFull);
        while (m0 | m1) {
            int e_[4] = {0, 0, 0, 0}, s_[4] = {-1, -1, -1, -1};
            if (m0) { e_[0] = __builtin_ctz(m0); m0 &= m0 - 1; s_[0] = __builtin_amdgcn_readlane(myslot0, e_[0]); }
            if (m0) { e_[1] = __builtin_ctz(m0); m0 &= m0 - 1; s_[1] = __builtin_amdgcn_readlane(myslot0, e_[1]); }
            if (m1) { e_[2] = __builtin_ctz(m1); m1 &= m1 - 1; s_[2] = __builtin_amdgcn_readlane(myslot1, e_[2]); }
            if (m1) { e_[3] = __builtin_ctz(m1); m1 &= m1 - 1; s_[3] = __builtin_amdgcn_readlane(myslot1, e_[3]); }
#if F8_Y
            unsigned yv[4][8];
#pragma unroll
            for (int t = 0; t < 4; ++t) { const unsigned* yr = (const unsigned*)((const unsigned char*)Y + ((size_t)e_[t] * 2048 + b * CAP + (s_[t] < 0 ? 0 : s_[t])) * D) + F.lane;
#pragma unroll
                for (int j = 0; j < 8; ++j) yv[t][j] = __builtin_nontemporal_load(yr + 64 * j); }
#pragma unroll
            for (int t = 0; t < 4; ++t) { const float wt = s_[t] < 0 ? 0.f : 1.f;
#pragma unroll
                for (int j = 0; j < 8; ++j) { const int w = (int)yv[t][j]; const f32x2 lo = __builtin_amdgcn_cvt_pk_f32_fp8(w, false), hi = __builtin_amdgcn_cvt_pk_f32_fp8(w, true);
                    acc[t >> 1][j][0] += wt * lo.x; acc[t >> 1][j][1] += wt * lo.y; acc[t >> 1][j][2] += wt * hi.x; acc[t >> 1][j][3] += wt * hi.y; } }
#else
            u32x2 yv[4][8];
#pragma unroll
            for (int t = 0; t < 4; ++t) { const u32x2* yr = (const u32x2*)(Y + ((size_t)e_[t] * 2048 + b * CAP + (s_[t] < 0 ? 0 : s_[t])) * D) + F.lane;
#pragma unroll
                for (int j = 0; j < 8; ++j) yv[t][j] = yr[64 * j]; }
#pragma unroll
            for (int t = 0; t < 4; ++t) { const float wt = s_[t] < 0 ? 0.f : 1.f;
#pragma unroll
                for (int j = 0; j < 8; ++j) { const u32x2 w = yv[t][j]; acc[t >> 1][j][0] += wt * bflo(w.x); acc[t >> 1][j][1] += wt * bfhi(w.x); acc[t >> 1][j][2] += wt * bflo(w.y); acc[t >> 1][j][3] += wt * bfhi(w.y); } }
#endif
        }
#pragma unroll
        for (int rw = 0; rw < 2; ++rw) {
            float ss = 0.f;
#if F8_Y
#pragma unroll
            for (int j = 0; j < 8; ++j) acc[rw][j] = acc[rw][j] * (1.f / F8_YSCALE);
#endif
#pragma unroll
            for (int j = 0; j < 8; ++j) ss += (acc[rw][j][0] * acc[rw][j][0] + acc[rw][j][1] * acc[rw][j][1]) + (acc[rw][j][2] * acc[rw][j][2] + acc[rw][j][3] * acc[rw][j][3]);
            const float rstd = rsqrtf(wave_sum(ss) * (1.f / D) + NORM_EPS);
            f32x4* orow = (f32x4*)(F.out + (size_t)(m + rw) * D) + F.lane;
#pragma unroll
            for (int j = 0; j < 8; ++j) {
                const f32x4 xv = (f32x4){bflo(xw[rw][j].x), bfhi(xw[rw][j].x), bflo(xw[rw][j].y), bfhi(xw[rw][j].y)};
                f32x4 o;
#pragma unroll
                for (int i = 0; i < 4; ++i) { o[i] = xv[i] + (acc[rw][j][i] * rstd) * ggt[j][i]; }
                __builtin_nontemporal_store(o, orow + 64 * j);
            }
        }
      }
    }
}

__global__ void __launch_bounds__(NTHR, 2) mega(Args a) {
    extern __shared__ __attribute__((aligned(16))) unsigned char lds[];
    Frame F;
    F.lds = lds; F.ldsl = (LAS unsigned char*)lds; F.ws = a.ws; F.in = a.in; F.out = a.out;
    F.wg = blockIdx.x; F.nwg = gridDim.x;
    F.wave = __builtin_amdgcn_readfirstlane(threadIdx.x >> 6);
#define REFRESH() do { F.tid = tid_fresh(F.wave); F.lane = F.tid & 63; } while (0)
    REFRESH();
    for (int u = F.tid; u < (LDS_BYTES - LDSCTL_OFF) / 4; u += NTHR) ((unsigned*)(lds + LDSCTL_OFF))[u] = 0u;
    __syncthreads();
    const int lo = a.ph_lo, hi = a.ph_hi;
    XcdBarrier bar; bar.bar = (unsigned*)(a.ws + WS_CTL) + CW_BAR; bar.x = 0; bar.st = nullptr; bar.wave = F.wave;
    if (hi - lo > 1) bar = xcd_barrier_post((unsigned*)(a.ws + WS_CTL) + CW_BAR, (volatile LAS unsigned*)(lds + MISC_OFF + 32), F.wave);
#define IN(k) (lo <= (k) && (k) < hi)
#define SEAM(k) do { if (IN(k) && IN((k) + 1)) xcd_barrier(bar); } while (0)
    if (IN(PH_PREP)) { for (int rep_ = 0; rep_ < REP_PREP; ++rep_) { REFRESH(); ph_prep(F); } for (int rep_ = 0; rep_ < REP_CONV; ++rep_) { REFRESH(); ph_convert(F); } SEAM(PH_PREP); }
    if (IN(PH_PRENORM)) { for (int rep_ = 0; rep_ < REP_PRENORM; ++rep_) { REFRESH(); ph_prenorm(F); } SEAM(PH_PRENORM); }
#if OPT_IN
    if (IN(PH_INPROJ)) { for (int rep_ = 0; rep_ < REP_IN; ++rep_) { REFRESH(); ph_inproj(F); } SEAM(PH_INPROJ); }
#endif
    if (IN(PH_ATTN)) {
#if OPT_RET
        for (int rep_ = 0; rep_ < REP_STATE; ++rep_) { REFRESH(); ph_state(F); }
#endif
#if OPT_ATTN
        for (int rep_ = 0; rep_ < REP_ATTN; ++rep_) { REFRESH(); ph_attn(F); }
#endif
        SEAM(PH_ATTN); }
#if OPT_RET
    if (IN(PH_RETOUT)) { for (int rep_ = 0; rep_ < REP_RETOUT; ++rep_) { REFRESH(); ph_retout(F); } SEAM(PH_RETOUT); }
#endif
#if OPT_OUT
    if (IN(PH_OUTPROJ)) { REFRESH(); ph_outproj(F); SEAM(PH_OUTPROJ); }
#endif
    if (IN(PH_ROWPASS)) { for (int rep_ = 0; rep_ < REP_ROWPASS; ++rep_) { REFRESH(); ph_rowpass(F); } SEAM(PH_ROWPASS); }
    if (IN(PH_TOPK)) { for (int rep_ = 0; rep_ < REP_TOPK; ++rep_) { REFRESH(); ph_topk(F); } SEAM(PH_TOPK); }
#if OPT_E1
    if (IN(PH_E1)) { for (int rep_ = 0; rep_ < REP_E1; ++rep_) { REFRESH(); ph_e1(F); } SEAM(PH_E1); }
#endif
#if OPT_E2
    if (IN(PH_E2)) { REFRESH(); ph_e2(F); SEAM(PH_E2); }
#endif
    if (IN(PH_FINAL)) { for (int rep_ = 0; rep_ < REP_FINAL; ++rep_) { REFRESH(); ph_final(F); } }
#undef IN
#undef SEAM
}

static void launch_mega(const Args& base, int lo, int hi, int grid, hipStream_t stream) {
    Args a = base; a.ph_lo = lo; a.ph_hi = hi;
    hipLaunchKernelGGL(mega, dim3(grid), dim3(NTHR), LDS_BYTES, stream, a);
}
extern "C" void kernel_launch(void* const* d_in, const int* in_sizes, int n_in, void* d_out, int out_size, void* d_ws, size_t ws_size, hipStream_t stream) {
    static int grid = 0;
    if (grid == 0) {
        if (n_in != 22 || out_size != M * D || ws_size < WS_END) { fprintf(stderr, "kernel_launch: unexpected shapes (n_in %d out %d ws %zu)\n", n_in, out_size, ws_size); grid = -1; return; }
        int dev = 0, cus = 0;
        if (hipGetDevice(&dev) != hipSuccess || hipDeviceGetAttribute(&cus, hipDeviceAttributeMultiprocessorCount, dev) != hipSuccess) { grid = -1; return; }
        if (hipFuncSetAttribute((const void*)mega, hipFuncAttributeMaxDynamicSharedMemorySize, LDS_BYTES) != hipSuccess) { fprintf(stderr, "kernel_launch: hipFuncSetAttribute failed\n"); grid = -1; return; }
        (void)hipGetLastError();
        grid = cus;
    }
    if (grid < 0) return;
    unsigned char* ws = (unsigned char*)d_ws;
    (void)hipMemsetAsync(ws + WS_CTL, 0, CTL_ZERO_BYTES, stream);
    Args a{};
    for (int i = 0; i < 22; ++i) a.in[i] = d_in[i];
    a.out = (float*)d_out; a.ws = ws; a.ph_lo = 0; a.ph_hi = 0;

#if OPT_IN && OPT_OUT && OPT_E1 && OPT_E2 && OPT_ATTN && OPT_RET && !defined(MK_PER_PHASE)
    launch_mega(a, 0, PH_COUNT, grid, stream);
    { const hipError_t le1 = hipPeekAtLastError(); if (le1 != hipSuccess) fprintf(stderr, "kernel_launch: launch failed: %s\n", hipGetErrorName(le1)); }
    return;
#endif
    launch_mega(a, PH_PREP, PH_PREP + 1, grid, stream);
    launch_mega(a, PH_PRENORM, PH_PRENORM + 1, grid, stream);
#if OPT_IN
    launch_mega(a, PH_INPROJ, PH_INPROJ + 1, grid, stream);
#else
    hipLaunchKernelGGL((k_gemm_naive<EpiIn, false, true>), dim3(NCOL / 128, M / 64, 1), dim3(256), 0, stream,
                       (const bf16_t*)(ws + WS_H), D, (const int*)nullptr, (const float*)d_in[I_WIN], (const float*)nullptr, NCOL, D, M, 0L, EpiIn{ws});
#endif
#if OPT_ATTN || OPT_RET
    launch_mega(a, PH_ATTN, PH_ATTN + 1, grid, stream);
#endif
#if !OPT_ATTN
    hipLaunchKernelGGL(k_attn_naive, dim3(NB * NH * 2 * 16), dim3(256), 0, stream, (const bf16_t*)(ws + WS_QD), (const bf16_t*)(ws + WS_KD), (const bf16_t*)(ws + WS_VD), (float*)(ws + WS_ON));
    hipLaunchKernelGGL(k_attn_combine, dim3(NB * NH * S / 4), dim3(256), 0, stream, (const float*)(ws + WS_ON), (const float*)d_in[I_LQ1], (const float*)d_in[I_LK1], (const float*)d_in[I_LQ2], (const float*)d_in[I_LK2],
                       (const float*)d_in[I_SUBLN], (bf16_t*)(ws + WS_MIXIN));
#endif
#if OPT_RET
    launch_mega(a, PH_RETOUT, PH_RETOUT + 1, grid, stream);
#else
    hipLaunchKernelGGL(k_ret_naive, dim3(NB * NH * 2 * 16), dim3(256), 0, stream, (const bf16_t*)(ws + WS_RQ), (const bf16_t*)(ws + WS_RK), (const bf16_t*)(ws + WS_RV), (const float*)d_in[I_DECAY], (float*)(ws + WS_RAW));
    hipLaunchKernelGGL(k_ret_norm, dim3(NB * NH * S / 4), dim3(256), 0, stream, (const float*)(ws + WS_RAW), (const float*)d_in[I_RETG], (const bf16_t*)(ws + WS_RG), (bf16_t*)(ws + WS_MIXIN));
#endif
#if OPT_OUT
    launch_mega(a, PH_OUTPROJ, PH_OUTPROJ + 1, grid, stream);
#else
    hipLaunchKernelGGL((k_gemm_naive<EpiOut, false, false>), dim3(D / 128, M / 64, 1), dim3(256), 0, stream,
                       (const bf16_t*)(ws + WS_MIXIN), D, (const int*)nullptr, (const float*)d_in[I_WOUT], (const float*)nullptr, D, D, M, 0L, EpiOut{ws});
#endif
    launch_mega(a, PH_ROWPASS, PH_ROWPASS + 1, grid, stream);
    launch_mega(a, PH_TOPK, PH_TOPK + 1, grid, stream);
#if OPT_E1
    launch_mega(a, PH_E1, PH_E1 + 1, grid, stream);
#else
    hipLaunchKernelGGL((k_gemm_naive<EpiE1, true, false>), dim3(FF / 128, 2048 / 64, NE), dim3(256), 0, stream,
                       (const bf16_t*)(ws + WS_H), D, (const int*)(ws + WS_ROWMAP), (const float*)d_in[I_WGATE], (const float*)d_in[I_WUP], FF, D, 2048, (long)D * FF, EpiE1{ws});
#endif
#if OPT_E2
    launch_mega(a, PH_E2, PH_E2 + 1, grid, stream);
#else
    hipLaunchKernelGGL((k_gemm_naive<EpiE2, false, false>), dim3(D / 128, 2048 / 64, NE), dim3(256), 0, stream,
                       (const bf16_t*)(ws + WS_HID), FF, (const int*)nullptr, (const float*)d_in[I_WDOWN], (const float*)nullptr, D, FF, 2048, (long)FF * D, EpiE2{ws});
#endif
    launch_mega(a, PH_FINAL, PH_FINAL + 1, grid, stream);
    const hipError_t le = hipPeekAtLastError();
    if (le != hipSuccess) fprintf(stderr, "kernel_launch: launch failed: %s\n", hipGetErrorName(le));
}
```

```cpp
#include <hip/hip_runtime.h>
#include <cstdio>
#include <cstdint>

#ifndef OPT_IN
#define OPT_IN 1
#endif
#ifndef OPT_OUT
#define OPT_OUT 1
#endif
#ifndef OPT_E1
#define OPT_E1 1
#endif
#ifndef OPT_E2
#define OPT_E2 1
#endif
#ifndef OPT_ATTN
#define OPT_ATTN 1
#endif
#ifndef OPT_RET
#define OPT_RET 1
#endif
#ifndef F8_E1
#define F8_E1 1
#endif
#ifndef F8_E2
#define F8_E2 1
#endif
#ifndef F8_Y
#define F8_Y 1
#endif
#ifndef F8_IN
#define F8_IN 1
#endif
#ifndef EXP_F8
#define EXP_F8 (F8_E1 || F8_E2)
#endif
#ifndef REP_CONV
#define REP_CONV 1
#endif
#ifndef REP_IN
#define REP_IN 1
#endif
#ifndef REP_ATTN
#define REP_ATTN 1
#endif
#ifndef REP_E1
#define REP_E1 1
#endif
#ifndef REP_MISC
#define REP_MISC 1
#endif
#ifndef REP_SLICE
#define REP_SLICE 1
#endif
#ifndef REP_PRENORM
#define REP_PRENORM 1
#endif
#ifndef REP_ROWPASS
#define REP_ROWPASS 1
#endif
#ifndef REP_FINAL
#define REP_FINAL 1
#endif
#ifndef REP_RETOUT
#define REP_RETOUT 1
#endif
#ifndef REP_STATE
#define REP_STATE 1
#endif
#ifndef REP_TOPK
#define REP_TOPK 1
#endif
#ifndef REP_PREP
#define REP_PREP 1
#endif


constexpr int D = 2048, NB = 4, S = 4096, M = NB * S;
constexpr int NCOL = 7168;
constexpr int NE = 16, CAP = 512, FF = 2048;
constexpr int NH = 8;
constexpr float NORM_EPS = 1e-6f;
constexpr float LAM_INIT = 0.2f;
constexpr float QSCALE = 0.125f * 1.4426950408889634f;
constexpr float RKSCALE = 0.08838834764831845f;

constexpr size_t MiB = 1u << 20;
constexpr size_t WS_CTL = 0, CTL_ZERO_BYTES = 32768;
constexpr size_t WS_MOD = 1 * MiB;
constexpr int MOD_HALF = 4 * 6 * 2048;
constexpr size_t WS_AFF = 2 * MiB;
constexpr size_t WS_ROWMAP = 3 * MiB;
constexpr size_t WS_GATEV = 3 * MiB + 256 * 1024;
constexpr size_t WS_SEL = 4 * MiB;
constexpr size_t WS_ROPED = 6 * MiB;
constexpr size_t WS_ROPER = 10 * MiB;
constexpr size_t WS_WINT = 20 * MiB;
constexpr size_t WS_WOUTT = 48 * MiB;
constexpr size_t WS_W1T = 56 * MiB;
constexpr size_t WS_W2T = 312 * MiB;
constexpr size_t WS_H = 440 * MiB;
constexpr size_t WS_QD = 504 * MiB;
constexpr size_t WS_KD = 536 * MiB;
constexpr size_t WS_VD = 568 * MiB;
constexpr size_t WS_RQ = 600 * MiB;
constexpr size_t WS_RK = 632 * MiB;
constexpr size_t WS_RV = 664 * MiB;
constexpr size_t WS_RG = 696 * MiB;
constexpr size_t WS_HID = 504 * MiB;
constexpr size_t WS_ST = 728 * MiB;
constexpr size_t WS_MIXIN = 792 * MiB;
constexpr size_t WS_Y = 728 * MiB;
constexpr size_t WS_MIX = 856 * MiB;
constexpr size_t WS_X1 = 920 * MiB;
constexpr size_t WS_END = 1048 * MiB;
constexpr size_t WS_ON = WS_X1;
constexpr size_t WS_RAW = WS_MIX;

typedef unsigned short bf16_t;
typedef float f32x4 __attribute__((ext_vector_type(4)));
typedef float f32x2 __attribute__((ext_vector_type(2)));
typedef unsigned u32x4 __attribute__((ext_vector_type(4)));
typedef unsigned u32x2 __attribute__((ext_vector_type(2)));
#define DI __device__ __forceinline__

DI int lane_fresh() { int l; asm volatile("v_mbcnt_lo_u32_b32 %0, -1, 0\n\tv_mbcnt_hi_u32_b32 %0, -1, %0" : "=v"(l)); return l; }
DI int tid_fresh(int wave) { return wave * 64 + lane_fresh(); }
DI float bf2f(bf16_t v) { return __uint_as_float((unsigned)v << 16); }
DI float bflo(unsigned w) { return __uint_as_float(w << 16); }
DI float bfhi(unsigned w) { return __uint_as_float(w & 0xffff0000u); }
DI unsigned f2bf(float f) { unsigned u = __float_as_uint(f); return (u + 0x7fffu + ((u >> 16) & 1u)) >> 16; }
DI unsigned pk2(float lo, float hi) { unsigned r; asm("v_cvt_pk_bf16_f32 %0, %1, %2" : "=v"(r) : "v"(lo), "v"(hi)); return r; }
DI unsigned pk4_f8(float a, float b, float c, float d) {
    a = __builtin_amdgcn_fmed3f(a, -448.f, 448.f); b = __builtin_amdgcn_fmed3f(b, -448.f, 448.f); c = __builtin_amdgcn_fmed3f(c, -448.f, 448.f); d = __builtin_amdgcn_fmed3f(d, -448.f, 448.f);
    int w = __builtin_amdgcn_cvt_pk_fp8_f32(a, b, 0, false); w = __builtin_amdgcn_cvt_pk_fp8_f32(c, d, w, true); return (unsigned)w; }
constexpr float F8_WSCALE = 512.f, F8_HSCALE = 8.f, F8_HIDSCALE = 4.f, F8_YSCALE = 64.f;
constexpr int F8_WSCL = 0x76767676, F8_HSCL = 0x7C7C7C7C, F8_HIDSCL = 0x7D7D7D7D;
DI float silu_f(float v) { return v * __builtin_amdgcn_rcpf(1.f + __builtin_amdgcn_exp2f(-1.4426950408889634f * v)); }
DI float wave_sum(float v) {
    v += __builtin_bit_cast(float, __builtin_amdgcn_mov_dpp(__builtin_bit_cast(int, v), 0xB1, 0xF, 0xF, true));
    v += __builtin_bit_cast(float, __builtin_amdgcn_mov_dpp(__builtin_bit_cast(int, v), 0x4E, 0xF, 0xF, true));
    v += __builtin_bit_cast(float, __builtin_amdgcn_mov_dpp(__builtin_bit_cast(int, v), 0x141, 0xF, 0xF, true));
    v += __builtin_bit_cast(float, __builtin_amdgcn_mov_dpp(__builtin_bit_cast(int, v), 0x140, 0xF, 0xF, true));
    v += __builtin_bit_cast(float, __builtin_amdgcn_ds_swizzle(__builtin_bit_cast(int, v), 0x401F));
    { auto rr = __builtin_amdgcn_permlane32_swap(__float_as_uint(v), __float_as_uint(v), false, false); v = __uint_as_float(rr[0]) + __uint_as_float(rr[1]); }
    return v;
}

DI float dpp_f(float v, int ctrl) { switch (ctrl) {
    case 0x128: return __builtin_bit_cast(float, __builtin_amdgcn_mov_dpp(__builtin_bit_cast(int, v), 0x128, 0xF, 0xF, true));
    case 0x141: return __builtin_bit_cast(float, __builtin_amdgcn_mov_dpp(__builtin_bit_cast(int, v), 0x141, 0xF, 0xF, true));
    case 0x140: return __builtin_bit_cast(float, __builtin_amdgcn_mov_dpp(__builtin_bit_cast(int, v), 0x140, 0xF, 0xF, true));
    case 0xB1:  return __builtin_bit_cast(float, __builtin_amdgcn_mov_dpp(__builtin_bit_cast(int, v), 0xB1, 0xF, 0xF, true));
    default:    return __builtin_bit_cast(float, __builtin_amdgcn_mov_dpp(__builtin_bit_cast(int, v), 0x4E, 0xF, 0xF, true)); } }
DI float swz16_f(float v) { return __builtin_bit_cast(float, __builtin_amdgcn_ds_swizzle(__builtin_bit_cast(int, v), 0x401F)); }
DI float expert_totals16(const f32x2 (&p)[8], int lane) {
    float y[8];
#pragma unroll
    for (int i = 0; i < 8; ++i) { const float a = p[i >> 1][i & 1], b = p[(i + 8) >> 1][i & 1];
        auto r = __builtin_amdgcn_permlane32_swap(__float_as_uint(a), __float_as_uint(b), false, false); y[i] = __uint_as_float(r[0]) + __uint_as_float(r[1]); }
    const bool b4 = (lane & 16) != 0, b3 = (lane & 8) != 0, b2 = (lane & 4) != 0;
    float z[4];
#pragma unroll
    for (int i = 0; i < 4; ++i) { const float send = b4 ? y[i] : y[i + 4], keep = b4 ? y[i + 4] : y[i]; z[i] = keep + swz16_f(send); }
    float w[2];
#pragma unroll
    for (int i = 0; i < 2; ++i) { const float send = b3 ? z[i] : z[i + 2], keep = b3 ? z[i + 2] : z[i]; w[i] = keep + dpp_f(send, 0x128); }
    float v; { const float send = b2 ? w[0] : w[1], keep = b2 ? w[1] : w[0]; v = keep + dpp_f(send, 0x141); }
    v += dpp_f(v, 0xB1); v += dpp_f(v, 0x4E);
    return v;
}
DI float experts_max(float v) { v = fmaxf(v, dpp_f(v, 0x141)); v = fmaxf(v, dpp_f(v, 0x140)); v = fmaxf(v, swz16_f(v));
    auto r = __builtin_amdgcn_permlane32_swap(__float_as_uint(v), __float_as_uint(v), false, false); return fmaxf(__uint_as_float(r[0]), __uint_as_float(r[1])); }
DI float experts_sum(float v) { v += dpp_f(v, 0x141); v += dpp_f(v, 0x140); v += swz16_f(v);
    auto r = __builtin_amdgcn_permlane32_swap(__float_as_uint(v), __float_as_uint(v), false, false); return __uint_as_float(r[0]) + __uint_as_float(r[1]); }

struct Args {
    const void* in[22];
    float* out;
    unsigned char* ws;
    int ph_lo, ph_hi;
};
enum { I_X = 0, I_C, I_POS, I_WADA, I_BADA, I_GPREMIX, I_GPOSTMIX, I_WIN, I_LQ1, I_LK1, I_LQ2, I_LK2, I_SUBLN, I_DECAY, I_RETG, I_WOUT, I_GPREFFN, I_GPOSTFFN, I_WROUTER, I_WGATE, I_WUP, I_WDOWN };

__host__ __device__ __forceinline__ int src_col_in(int n) {
    const int sec = n >> 10, r = n & 1023;
    if (sec <= 1) { const int g = r >> 6, j = r & 63; return (sec << 10) + (g << 6) + (j >> 1) + ((j & 1) << 5); }
    if (sec == 3 || sec == 4) { const int g = r >> 7, j = r & 127; return (sec << 10) + (g << 7) + (j >> 1) + ((j & 1) << 6); }
    return n;
}

DI void epi_in8(unsigned char* ws, int row, int col0, const float (&v)[8]) {
    const int sec = col0 >> 10, r = col0 & 1023, b = row >> 12, s = row & 4095;
    float o[8];
    bf16_t* dst;
    if (sec <= 1) {
        const int hm = r >> 6, j0 = r & 63;
        const f32x4* rt = (const f32x4*)(ws + WS_ROPED + ((size_t)row * 32 + (j0 >> 1)) * 8);
        const f32x4 t0 = rt[0], t1 = rt[1];
        const float cs[4] = {t0[0], t0[2], t1[0], t1[2]}, sn[4] = {t0[1], t0[3], t1[1], t1[3]};
        const float sc = sec == 0 ? QSCALE : 1.f;
#pragma unroll
        for (int t = 0; t < 4; ++t) { const float x1 = v[2 * t], x2 = v[2 * t + 1]; o[2 * t] = (x1 * cs[t] - x2 * sn[t]) * sc; o[2 * t + 1] = (x2 * cs[t] + x1 * sn[t]) * sc; }
        dst = (bf16_t*)(ws + (sec == 0 ? WS_QD : WS_KD)) + (((size_t)(b * 16 + hm) * S + s) * 64 + j0);
    } else if (sec == 3 || sec == 4) {
        const int h = r >> 7, j0 = r & 127;
        const f32x4* rt = (const f32x4*)(ws + WS_ROPER + ((size_t)row * 64 + (j0 >> 1)) * 8);
        const f32x4 t0 = rt[0], t1 = rt[1];
        const float cs[4] = {t0[0], t0[2], t1[0], t1[2]}, sn[4] = {t0[1], t0[3], t1[1], t1[3]};
        const float sc = sec == 4 ? RKSCALE : 1.f;
#pragma unroll
        for (int t = 0; t < 4; ++t) { const float x1 = v[2 * t], x2 = v[2 * t + 1]; o[2 * t] = (x1 * cs[t] - x2 * sn[t]) * sc; o[2 * t + 1] = (x2 * cs[t] + x1 * sn[t]) * sc; }
        dst = (bf16_t*)(ws + (sec == 3 ? WS_RQ : WS_RK)) + (((size_t)(b * 8 + h) * S + s) * 128 + j0);
    } else if (sec == 6) {
#pragma unroll
        for (int t = 0; t < 8; ++t) o[t] = silu_f(v[t]);
        dst = (bf16_t*)(ws + WS_RG) + ((size_t)row * 1024 + r);
    } else {
        const int h = r >> 7, j0 = r & 127;
#pragma unroll
        for (int t = 0; t < 8; ++t) o[t] = v[t];
        dst = (bf16_t*)(ws + (sec == 2 ? WS_VD : WS_RV)) + (((size_t)(b * 8 + h) * S + s) * 128 + j0);
    }
    u32x4 w; w.x = pk2(o[0], o[1]); w.y = pk2(o[2], o[3]); w.z = pk2(o[4], o[5]); w.w = pk2(o[6], o[7]);
    *(u32x4*)dst = w;
}
DI bool epi_in_is_rope(int col0) { const int sec = col0 >> 10; return sec <= 1 || sec == 3 || sec == 4; }
DI void epi_in_table(const unsigned char* ws, int row, int col0, f32x4& t0, f32x4& t1) {
    const int sec = col0 >> 10, r = col0 & 1023;
    const f32x4* rt = sec <= 1 ? (const f32x4*)(ws + WS_ROPED + ((size_t)row * 32 + ((r & 63) >> 1)) * 8) : (const f32x4*)(ws + WS_ROPER + ((size_t)row * 64 + ((r & 127) >> 1)) * 8);
    t0 = rt[0]; t1 = rt[1];
}
DI void epi_in8_rope(unsigned char* ws, int row, int col0, const float (&v)[8], const f32x4 t0, const f32x4 t1) {
    const int sec = col0 >> 10, r = col0 & 1023, b = row >> 12, s = row & 4095;
    float o[8];
    const float cs[4] = {t0[0], t0[2], t1[0], t1[2]}, sn[4] = {t0[1], t0[3], t1[1], t1[3]};
    const float sc = sec == 0 ? QSCALE : (sec == 4 ? RKSCALE : 1.f);
#pragma unroll
    for (int t = 0; t < 4; ++t) { const float x1 = v[2 * t], x2 = v[2 * t + 1]; o[2 * t] = (x1 * cs[t] - x2 * sn[t]) * sc; o[2 * t + 1] = (x2 * cs[t] + x1 * sn[t]) * sc; }
    bf16_t* dst;
    if (sec <= 1) { const int hm = r >> 6, j0 = r & 63; dst = (bf16_t*)(ws + (sec == 0 ? WS_QD : WS_KD)) + (((size_t)(b * 16 + hm) * S + s) * 64 + j0); }
    else { const int h = r >> 7, j0 = r & 127; dst = (bf16_t*)(ws + (sec == 3 ? WS_RQ : WS_RK)) + (((size_t)(b * 8 + h) * S + s) * 128 + j0); }
    u32x4 w; w.x = pk2(o[0], o[1]); w.y = pk2(o[2], o[3]); w.z = pk2(o[4], o[5]); w.w = pk2(o[6], o[7]);
    *(u32x4*)dst = w;
}
DI void store8_bf16(bf16_t* dst, const float (&o)[8]) {
    u32x4 w; w.x = pk2(o[0], o[1]); w.y = pk2(o[2], o[3]); w.z = pk2(o[4], o[5]); w.w = pk2(o[6], o[7]);
    *(u32x4*)dst = w;
}

struct EpiIn  { unsigned char* ws; DI void operator()(int row, int col0, const float (&v)[8], const float (&)[8]) const { epi_in8(ws, row, col0, v); } };
struct EpiOut { unsigned char* ws; DI void operator()(int row, int col0, const float (&v)[8], const float (&)[8]) const { store8_bf16((bf16_t*)(ws + WS_MIX) + (size_t)row * D + col0, v); } };
struct EpiE1  { unsigned char* ws; DI void operator()(int row, int col0, const float (&g)[8], const float (&u)[8]) const {
    float o[8];
#pragma unroll
    for (int t = 0; t < 8; ++t) o[t] = silu_f(g[t]) * u[t];
    store8_bf16((bf16_t*)(ws + WS_HID) + (size_t)row * FF + col0, o); } };
struct EpiE2  { unsigned char* ws; DI void operator()(int row, int col0, const float (&v)[8], const float (&)[8]) const {
    const float gt = ((const float*)(ws + WS_GATEV))[row]; float o[8];
#pragma unroll
    for (int t = 0; t < 8; ++t) o[t] = v[t] * gt;
    store8_bf16((bf16_t*)(ws + WS_Y) + (size_t)row * D + col0, o); } };

template <class Epi, bool DUAL, bool PERMIN>
__global__ void __launch_bounds__(256) k_gemm_naive(const bf16_t* __restrict__ A, int lda, const int* __restrict__ rowmap, const float* __restrict__ Bm, const float* __restrict__ B2m,
                                                     int ldb, int K, int Mz, long zB, Epi epi) {
    __shared__ __attribute__((aligned(16))) float As[16][68];
    __shared__ __attribute__((aligned(16))) float Bs[16][128];
    __shared__ __attribute__((aligned(16))) float B2s[DUAL ? 16 : 1][128];
    const int t = threadIdx.x, tx = t & 15, ty = t >> 4, z = blockIdx.z;
    const int n0 = blockIdx.x * 128, r0 = blockIdx.y * 64;
    const float* B = Bm + (size_t)z * zB; const float* B2 = DUAL ? B2m + (size_t)z * zB : nullptr;
    const int ar = t >> 2, akq = t & 3;
    const int grow = z * Mz + r0 + ar;
    const size_t arow = rowmap ? (size_t)rowmap[grow] : (size_t)grow;
    const bf16_t* ap = A + arow * lda + akq * 4;
    const int bk = t >> 4, bcg = t & 15;
    int scol[8];
#pragma unroll
    for (int j = 0; j < 8; ++j) scol[j] = PERMIN ? src_col_in(n0 + bcg * 8 + j) : (n0 + bcg * 8 + j);
    float acc[4][8], acc2[4][8];
#pragma unroll
    for (int i = 0; i < 4; ++i)
#pragma unroll
        for (int j = 0; j < 8; ++j) { acc[i][j] = 0.f; acc2[i][j] = 0.f; }
    for (int k0 = 0; k0 < K; k0 += 16) {
        const u32x2 av = *(const u32x2*)(ap + k0);
        float bv[8], bv2[8];
#pragma unroll
        for (int j = 0; j < 8; ++j) { bv[j] = B[(size_t)(k0 + bk) * ldb + scol[j]]; if (DUAL) bv2[j] = B2[(size_t)(k0 + bk) * ldb + scol[j]]; }
        __syncthreads();
        As[akq * 4 + 0][ar] = bflo(av.x); As[akq * 4 + 1][ar] = bfhi(av.x); As[akq * 4 + 2][ar] = bflo(av.y); As[akq * 4 + 3][ar] = bfhi(av.y);
#pragma unroll
        for (int j = 0; j < 8; ++j) { Bs[bk][bcg * 8 + j] = bv[j]; if (DUAL) B2s[bk][bcg * 8 + j] = bv2[j]; }
        __syncthreads();
#pragma unroll
        for (int kk = 0; kk < 16; ++kk) {
            const f32x4 a4 = *(const f32x4*)&As[kk][ty * 4];
            const f32x4 b0 = *(const f32x4*)&Bs[kk][tx * 8], b1 = *(const f32x4*)&Bs[kk][tx * 8 + 4];
            const float bb[8] = {b0[0], b0[1], b0[2], b0[3], b1[0], b1[1], b1[2], b1[3]};
#pragma unroll
            for (int i = 0; i < 4; ++i)
#pragma unroll
                for (int j = 0; j < 8; ++j) acc[i][j] += a4[i] * bb[j];
            if (DUAL) {
                const f32x4 c0 = *(const f32x4*)&B2s[kk][tx * 8], c1 = *(const f32x4*)&B2s[kk][tx * 8 + 4];
                const float cc[8] = {c0[0], c0[1], c0[2], c0[3], c1[0], c1[1], c1[2], c1[3]};
#pragma unroll
                for (int i = 0; i < 4; ++i)
#pragma unroll
                    for (int j = 0; j < 8; ++j) acc2[i][j] += a4[i] * cc[j];
            }
        }
    }
#pragma unroll
    for (int i = 0; i < 4; ++i) epi(z * Mz + r0 + ty * 4 + i, n0 + tx * 8, acc[i], acc2[i]);
}

__global__ void __launch_bounds__(256) k_attn_naive(const bf16_t* __restrict__ QD, const bf16_t* __restrict__ KD, const bf16_t* __restrict__ VD, float* __restrict__ On) {
    __shared__ __attribute__((aligned(16))) bf16_t Ks[32][64];
    __shared__ __attribute__((aligned(16))) bf16_t Vs[32][128];
    const int t = threadIdx.x, bid = blockIdx.x, qb = bid & 15, bhm = bid >> 4, bh = bhm >> 1;
    const int s = qb * 256 + t;
    float q[64], o[128];
    {
        const u32x4* qp = (const u32x4*)(QD + ((size_t)bhm * S + s) * 64);
#pragma unroll
        for (int c = 0; c < 8; ++c) { const u32x4 w = qp[c]; q[8 * c] = bflo(w.x); q[8 * c + 1] = bfhi(w.x); q[8 * c + 2] = bflo(w.y); q[8 * c + 3] = bfhi(w.y); q[8 * c + 4] = bflo(w.z); q[8 * c + 5] = bfhi(w.z); q[8 * c + 6] = bflo(w.w); q[8 * c + 7] = bfhi(w.w); }
    }
#pragma unroll
    for (int e = 0; e < 128; ++e) o[e] = 0.f;
    float mx = -1e30f, l = 0.f;
    for (int m0 = 0; m0 < S; m0 += 32) {
        __syncthreads();
        *(u32x4*)&Ks[t >> 3][(t & 7) * 8] = *(const u32x4*)(KD + ((size_t)bhm * S + m0 + (t >> 3)) * 64 + (t & 7) * 8);
#pragma unroll
        for (int i = 0; i < 2; ++i) { const int idx = t + 256 * i, row = idx >> 4, ch = idx & 15; *(u32x4*)&Vs[row][ch * 8] = *(const u32x4*)(VD + ((size_t)bh * S + m0 + row) * 128 + ch * 8); }
        __syncthreads();
        for (int mm = 0; mm < 32; ++mm) {
            float sc = 0.f;
#pragma unroll
            for (int c = 0; c < 8; ++c) { const u32x4 w = *(const u32x4*)&Ks[mm][c * 8];
                sc += q[8 * c] * bflo(w.x) + q[8 * c + 1] * bfhi(w.x) + q[8 * c + 2] * bflo(w.y) + q[8 * c + 3] * bfhi(w.y) + q[8 * c + 4] * bflo(w.z) + q[8 * c + 5] * bfhi(w.z) + q[8 * c + 6] * bflo(w.w) + q[8 * c + 7] * bfhi(w.w); }
            if (sc > mx) { const float f = exp2f(mx - sc); l *= f;
#pragma unroll
                for (int e = 0; e < 128; ++e) o[e] *= f;
                mx = sc; }
            const float p = exp2f(sc - mx); l += p;
#pragma unroll
            for (int c = 0; c < 16; ++c) { const u32x4 w = *(const u32x4*)&Vs[mm][c * 8];
                o[8 * c] += p * bflo(w.x); o[8 * c + 1] += p * bfhi(w.x); o[8 * c + 2] += p * bflo(w.y); o[8 * c + 3] += p * bfhi(w.y); o[8 * c + 4] += p * bflo(w.z); o[8 * c + 5] += p * bfhi(w.z); o[8 * c + 6] += p * bflo(w.w); o[8 * c + 7] += p * bfhi(w.w); }
        }
    }
    const float rl = 1.f / l;
    f32x4* op = (f32x4*)(On + ((size_t)bhm * S + s) * 128);
#pragma unroll
    for (int c = 0; c < 32; ++c) op[c] = (f32x4){o[4 * c] * rl, o[4 * c + 1] * rl, o[4 * c + 2] * rl, o[4 * c + 3] * rl};
}
DI float diff_lambda(const float* lq1, const float* lk1, const float* lq2, const float* lk2, int lane) {
    const float a = wave_sum(lq1[lane] * lk1[lane]), b = wave_sum(lq2[lane] * lk2[lane]);
    return __expf(a) - __expf(b) + LAM_INIT;
}
__global__ void __launch_bounds__(256) k_attn_combine(const float* __restrict__ On, const float* lq1, const float* lk1, const float* lq2, const float* lk2, const float* __restrict__ gain, bf16_t* __restrict__ MIXIN) {
    const int lane = threadIdx.x & 63, w = blockIdx.x * 4 + (threadIdx.x >> 6);
    const int bh = w >> 12, s = w & 4095, b = bh >> 3, h = bh & 7;
    const float lam = diff_lambda(lq1, lk1, lq2, lk2, lane);
    const f32x2 o1 = *(const f32x2*)(On + ((size_t)(bh * 2 + 0) * S + s) * 128 + 2 * lane), o2 = *(const f32x2*)(On + ((size_t)(bh * 2 + 1) * S + s) * 128 + 2 * lane);
    const float v0 = o1.x - lam * o2.x, v1 = o1.y - lam * o2.y;
    const float ss = wave_sum(v0 * v0 + v1 * v1);
    const float rs = rsqrtf(ss * (1.f / 128.f) + NORM_EPS) * (1.f - LAM_INIT);
    *(unsigned*)(MIXIN + ((size_t)(b * S + s)) * D + h * 128 + 2 * lane) = pk2(v0 * rs * gain[2 * lane], v1 * rs * gain[2 * lane + 1]);
}
__global__ void __launch_bounds__(256) k_ret_naive(const bf16_t* __restrict__ RQ, const bf16_t* __restrict__ RK, const bf16_t* __restrict__ RV, const float* __restrict__ logit, float* __restrict__ Oraw) {
    __shared__ __attribute__((aligned(16))) bf16_t Ks[32][128];
    __shared__ __attribute__((aligned(16))) bf16_t Vs[32][64];
    const int t = threadIdx.x, bid = blockIdx.x, sb = bid & 15, hf = (bid >> 4) & 1, bh = bid >> 5, h = bh & 7;
    const int s = sb * 256 + t;
    const float gf = 1.f / (1.f + __expf(-logit[h])), gb = 1.f / (1.f + __expf(-logit[8 + h]));
    const float lgf = log2f(gf), lgb = log2f(gb);
    float q[128], o[64];
    {
        const u32x4* qp = (const u32x4*)(RQ + ((size_t)bh * S + s) * 128);
#pragma unroll
        for (int c = 0; c < 16; ++c) { const u32x4 w = qp[c]; q[8 * c] = bflo(w.x); q[8 * c + 1] = bfhi(w.x); q[8 * c + 2] = bflo(w.y); q[8 * c + 3] = bfhi(w.y); q[8 * c + 4] = bflo(w.z); q[8 * c + 5] = bfhi(w.z); q[8 * c + 6] = bflo(w.w); q[8 * c + 7] = bfhi(w.w); }
    }
#pragma unroll
    for (int e = 0; e < 64; ++e) o[e] = 0.f;
    for (int m0 = 0; m0 < S; m0 += 32) {
        __syncthreads();
#pragma unroll
        for (int i = 0; i < 2; ++i) { const int idx = t + 256 * i, row = idx >> 4, ch = idx & 15; *(u32x4*)&Ks[row][ch * 8] = *(const u32x4*)(RK + ((size_t)bh * S + m0 + row) * 128 + ch * 8); }
        *(u32x4*)&Vs[t >> 3][(t & 7) * 8] = *(const u32x4*)(RV + ((size_t)bh * S + m0 + (t >> 3)) * 128 + hf * 64 + (t & 7) * 8);
        __syncthreads();
        for (int mm = 0; mm < 32; ++mm) {
            float sc = 0.f;
#pragma unroll
            for (int c = 0; c < 16; ++c) { const u32x4 w = *(const u32x4*)&Ks[mm][c * 8];
                sc += q[8 * c] * bflo(w.x) + q[8 * c + 1] * bfhi(w.x) + q[8 * c + 2] * bflo(w.y) + q[8 * c + 3] * bfhi(w.y) + q[8 * c + 4] * bflo(w.z) + q[8 * c + 5] * bfhi(w.z) + q[8 * c + 6] * bflo(w.w) + q[8 * c + 7] * bfhi(w.w); }
            const int dist = s - (m0 + mm);
            const float dec = dist >= 0 ? exp2f((float)dist * lgf) : exp2f((float)(-dist) * lgb);
            const float p = sc * dec;
#pragma unroll
            for (int c = 0; c < 8; ++c) { const u32x4 w = *(const u32x4*)&Vs[mm][c * 8];
                o[8 * c] += p * bflo(w.x); o[8 * c + 1] += p * bfhi(w.x); o[8 * c + 2] += p * bflo(w.y); o[8 * c + 3] += p * bfhi(w.y); o[8 * c + 4] += p * bflo(w.z); o[8 * c + 5] += p * bfhi(w.z); o[8 * c + 6] += p * bflo(w.w); o[8 * c + 7] += p * bfhi(w.w); }
        }
    }
    f32x4* op = (f32x4*)(Oraw + ((size_t)bh * S + s) * 128 + hf * 64);
#pragma unroll
    for (int c = 0; c < 16; ++c) op[c] = (f32x4){o[4 * c], o[4 * c + 1], o[4 * c + 2], o[4 * c + 3]};
}
__global__ void __launch_bounds__(256) k_ret_norm(const float* __restrict__ Oraw, const float* __restrict__ gain, const bf16_t* __restrict__ RG, bf16_t* __restrict__ MIXIN) {
    const int lane = threadIdx.x & 63, w = blockIdx.x * 4 + (threadIdx.x >> 6);
    const int bh = w >> 12, s = w & 4095, b = bh >> 3, h = bh & 7;
    const f32x2 v = *(const f32x2*)(Oraw + ((size_t)bh * S + s) * 128 + 2 * lane);
    const float mu = wave_sum(v.x + v.y) * (1.f / 128.f);
    const float d0 = v.x - mu, d1 = v.y - mu;
    const float var = wave_sum(d0 * d0 + d1 * d1) * (1.f / 128.f);
    const float rs = rsqrtf(var + NORM_EPS);
    const size_t tok = (size_t)b * S + s;
    const unsigned g = *(const unsigned*)(RG + tok * 1024 + h * 128 + 2 * lane);
    *(unsigned*)(MIXIN + tok * D + 1024 + h * 128 + 2 * lane) = pk2(d0 * rs * gain[h * 128 + 2 * lane] * bflo(g), d1 * rs * gain[h * 128 + 2 * lane + 1] * bfhi(g));
}

#define XB_TMO      128
#define XB_XCNT(j)  (256  + 64 * (j))
#define XB_XSUB(j)  (1280 + 64 * (j))
#define XB_XGEN(j)  (2304 + 64 * (j))
#define XB_TOP      3328
#define XB_TOPGEN   3392
#define XCD_BAR_WORDS 3456
#define XB_SPIN_CAP (1u << 18)
#define LAS __attribute__((address_space(3)))
#define GAS __attribute__((address_space(1)))

__device__ __forceinline__ unsigned xb_ld(unsigned* p)              { return __hip_atomic_load(p, __ATOMIC_RELAXED, __HIP_MEMORY_SCOPE_AGENT); }
__device__ __forceinline__ unsigned xb_add(unsigned* p, unsigned v) { return __hip_atomic_fetch_add(p, v, __ATOMIC_RELAXED, __HIP_MEMORY_SCOPE_AGENT); }
__device__ __forceinline__ unsigned xb_xcc_id() { return (unsigned)__builtin_amdgcn_s_getreg((3 << 11) | 20) & 0xFu; }
#define XB_SPIN(cond, bar) do { unsigned _sp = 0; while (cond) { __builtin_amdgcn_s_sleep(1); \
    if ((++_sp & 255u) == 0u) { if (xb_ld(&(bar)[XB_TMO])) break; if (_sp > XB_SPIN_CAP) { atomicAdd(&(bar)[XB_TMO], 1u); break; } } } } while (0)

struct XcdBarrier {
    unsigned* bar; unsigned x;
    volatile LAS unsigned* st;
    int wave;
};
__device__ __forceinline__ bool xb_leader(int wave) { return wave == 0 && lane_fresh() == 0; }
__device__ __forceinline__ XcdBarrier xcd_barrier_post(unsigned* bar, volatile LAS unsigned* st, int wave) {
    XcdBarrier b; b.bar = bar; b.x = xb_xcc_id(); b.st = st; b.wave = wave;
    if (xb_leader(wave)) (void)xb_add(&bar[XB_XCNT(b.x)], 1u);
    return b;
}
__device__ __forceinline__ void xcd_barrier_complete(unsigned* bar, unsigned x, unsigned& nloc, unsigned& nx) {
    const unsigned G = gridDim.x * gridDim.y * gridDim.z;
    unsigned sum, cnt, mine, sp = 0u;
    for (;;) {
        sum = 0u; cnt = 0u; mine = 0u;
#pragma unroll
        for (unsigned j = 0; j < 16; ++j) { const unsigned c = xb_ld(&bar[XB_XCNT(j)]); sum += c; cnt += (c > 0u) ? 1u : 0u; mine = (j == x) ? c : mine; }
        if (sum == G) break;
        __builtin_amdgcn_s_sleep(1);
        if ((++sp & 255u) == 0u) { if (xb_ld(&bar[XB_TMO])) break; if (sp > XB_SPIN_CAP) { atomicAdd(&bar[XB_TMO], 1u); break; } }
    }
    nloc = mine > 0u ? mine : 1u; nx = cnt > 0u ? cnt : 1u;
}
__device__ __forceinline__ void xcd_barrier(const XcdBarrier& b) {
    asm volatile("s_waitcnt vmcnt(0)" ::: "memory");
    __syncthreads();
    if (xb_leader(b.wave)) {
        unsigned* bar = b.bar;
        __builtin_amdgcn_s_waitcnt(0);
        unsigned nloc = b.st[0], nx = b.st[1];
        if (nloc == 0u) { xcd_barrier_complete(bar, b.x, nloc, nx); b.st[0] = nloc; b.st[1] = nx; }
        const unsigned old = xb_add(&bar[XB_XSUB(b.x)], 1u);
        const unsigned gen = old / nloc;
        if (old + 1u == (gen + 1u) * nloc) {
            __builtin_amdgcn_fence(__ATOMIC_RELEASE, "agent");
            asm volatile("s_waitcnt vmcnt(0)" ::: "memory");
            const unsigned og = xb_add(&bar[XB_TOP], 1u);
            const unsigned tg = og / nx;
            if (og + 1u == (tg + 1u) * nx) xb_add(&bar[XB_TOPGEN], 1u);
            else XB_SPIN(xb_ld(&bar[XB_TOPGEN]) == tg, bar);
            __builtin_amdgcn_fence(__ATOMIC_ACQUIRE, "agent");
            xb_add(&bar[XB_XGEN(b.x)], 1u);
            asm volatile("s_waitcnt vmcnt(0)" ::: "memory");
        } else {
            XB_SPIN(xb_ld(&bar[XB_XGEN(b.x)]) == gen, bar);
            __builtin_amdgcn_fence(__ATOMIC_ACQUIRE, "agent");
            asm volatile("s_waitcnt vmcnt(0)" ::: "memory");
        }
    }
    __syncthreads();
}


namespace pg8 {
#define PG8_LAS __attribute__((address_space(3)))
typedef short bf16x8 __attribute__((ext_vector_type(8)));
typedef int v4i_t __attribute__((ext_vector_type(4)));
typedef int v8i_t __attribute__((ext_vector_type(8)));
constexpr int BM = 256, BK = 64, HALF = 128, HTB = HALF * BK * 2, STAGE_BYTES = 8 * HTB, NXCD = 8, WGM = 8;
__host__ __device__ __forceinline__ int lds_byte(int r, int c) { const int st = (r >> 4) * 2 + (c >> 5), rr = r & 15, cc = c & 31, ob = rr * 64 + cc * 2; return st * 1024 + (ob ^ (((ob >> 9) & 1) << 5)); }
__host__ __device__ __forceinline__ void stage_rc(int b, int& R, int& C) { const int st = b / 1024, sb = b % 1024, swz = sb ^ (((sb >> 9) & 1) << 5); R = (st >> 1) * 16 + swz / 64; C = (st & 1) * 32 + (swz % 64) / 2; }
__host__ __device__ __forceinline__ int perm32(int rho) { const int n = rho >> 4, i = rho & 15; return 8 * (i >> 2) + 4 * n + (i & 3); }
__device__ __forceinline__ const char* uni(const char* p) { const unsigned long long v = (unsigned long long)p; const unsigned lo = __builtin_amdgcn_readfirstlane((unsigned)v), hi = __builtin_amdgcn_readfirstlane((unsigned)(v >> 32));
    return (const char*)(((unsigned long long)hi << 32) | lo); }
struct Unit { int pm, pn; };
struct Gemm { const bf16_t* A; const bf16_t* Bt; int K; };
struct StaticOrder {
    int nM, nN, nwg, G, c;
    __device__ void init(int M_, int N_, int G_, int c_) { nM = M_ / BM; nN = N_ / BM; nwg = nM * nN; G = G_; c = c_; }
    __device__ bool next(int i, Unit& u) const {
        const long L = (long)i * G + c; if (L >= nwg) return false;
        int wgid = (int)L; { const int q = nwg / NXCD, r = nwg % NXCD, xcd = wgid % NXCD, off = wgid / NXCD; wgid = (xcd < r ? xcd * (q + 1) : r * (q + 1) + (xcd - r) * q) + off; }
        const int nig = WGM * nN, gid = wgid / nig, fm = gid * WGM, gsz = (nM - fm) < WGM ? (nM - fm) : WGM;
        u.pm = fm + ((wgid % nig) % gsz); u.pn = (wgid % nig) / gsz; return true;
    }
};
template <int NPN, bool REV = false> struct ExpertOrder {
    int G, c;
    __device__ void init(int G_, int c_) { G = G_; c = c_; }
    __device__ bool next(int i, Unit& u) const {
        constexpr int UPE = 8 * NPN, TOT = NE * UPE;
        if (G == 256) {
            constexpr int EPR = 256 / UPE, XPE = 8 / EPR;
            const int e0 = i * EPR + (c & 7) / XPE; if (e0 >= NE) return false;
            const int e = REV ? NE - 1 - e0 : e0;
            const int xx = (c & 7) % XPE, j = c >> 3;
            u.pm = e * 8 + (j & 7); u.pn = e * NPN + xx * 4 + (j >> 3); return true;
        }
        const long L = (long)i * G + c; if (L >= TOT) return false;
        const int e0 = (int)L / UPE, r = (int)L % UPE, e = REV ? NE - 1 - e0 : e0; u.pm = e * 8 + (r & 7); u.pn = e * NPN + (r >> 3); return true;
    }
};

template <class Epi, class Sched, bool GATHER, bool F8 = false, bool ALIGN_EPI = true, bool SP2 = true>
__device__ __forceinline__ void gemm_phase(PG8_LAS unsigned char* lds, const Gemm g, const Sched& S, const Epi& E, const PG8_LAS int* rmap, const int wave_s, const int sclB = 0x7F7F7F7F, const int sclA = 0x7F7F7F7F) {
    const int tid = tid_fresh(wave_s), wid = __builtin_amdgcn_readfirstlane(tid >> 6), lane = tid & 63, wr = wid >> 2, wc = wid & 3, fr = lane & 15, fq = lane >> 4;
    constexpr int ES = F8 ? 1 : 2;
    const int K = g.K, nt = K / (F8 ? 2 * BK : BK);
    unsigned voffA[2], voffB[2]; int stR[2], stC[2];
#pragma unroll
    for (int i = 0; i < 2; ++i) { int R, C; stage_rc(tid * 16 + i * 8192, R, C); const int Rb = Epi::PERM ? ((R & ~31) + perm32(R & 31)) : R;
        voffA[i] = (unsigned)(R * K * ES + C * 2); voffB[i] = (unsigned)(Rb * K * ES + C * 2); stR[i] = R; stC[i] = C; }
    const size_t kstep = (size_t)(BK * 2);
    const size_t hstep = (size_t)HALF * K * ES;
    const size_t tstep = 2 * hstep;
    const unsigned ldsw = (unsigned)wid * 1024u;
    const unsigned ldsb = (unsigned)__builtin_amdgcn_readfirstlane((unsigned)(size_t)lds + ldsw);
    const char* gA = F8 ? uni((const char*)g.A) : (const char*)g.A;
    const int fcol = F8 ? 32 * (fq >> 1) + 16 * (fq & 1) : fq * 8;
    const int aoff = lds_byte(wr * 64 + fr, fcol), boff = lds_byte(wc * 32 + fr, fcol);
#define PG8_SA(b, h) (((b) * 2 + (h)) * HTB)
#define PG8_SB(b, h) ((4 + (b) * 2 + (h)) * HTB)
#define PG8_GLDS(sbase, voff_, bufoff, i_) do { if constexpr (!F8) { __builtin_amdgcn_global_load_lds((const unsigned*)((sbase) + (voff_)), (PG8_LAS unsigned*)(lds + (bufoff) + ldsw + (i_) * 8192), 16, 0, 0); } else { asm volatile("s_mov_b32 m0, %2\n\ts_nop 0\n\tglobal_load_lds_dwordx4 %0, %1" \
        :: "v"(voff_), "s"(sbase), "s"(ldsb + (unsigned)((bufoff) + (i_) * 8192)) : "memory", "m0"); } } while (0)
#define PG8_STAGE(bufoff, gbase, voff) do { const char* sb_ = (gbase); _Pragma("unroll") for (int _i = 0; _i < 2; ++_i) PG8_GLDS(sb_, (voff)[_i], bufoff, _i); } while (0)
#define PG8_STAGE_A(bufoff, h, kb, NXT) do { if constexpr (GATHER) { const char* b_ = gA + (kb); const int sl_ = ((((NXT) ? uin : ui) & 1) * 4 + (h) * 2) * 512; \
            const unsigned o0_ = gofft[sl_], o1_ = gofft[sl_ + 512];     \
            PG8_GLDS(b_, o0_, bufoff, 0); PG8_GLDS(b_, o1_, bufoff, 1); } \
        else { const char* b_ = ((NXT) ? nA : cA) + (size_t)(h) * hstep + (kb); _Pragma("unroll") for (int _i = 0; _i < 2; ++_i) PG8_GLDS(b_, voffA[_i], bufoff, _i); } } while (0)
#define PG8_RD8(p_) __builtin_shufflevector(*(const PG8_LAS v4i_t*)(p_), *(const PG8_LAS v4i_t*)((p_) + 16), 0, 1, 2, 3, 4, 5, 6, 7)
#define PG8_LDA(dst, b, h) do { if constexpr (F8) { _Pragma("unroll") for (int m = 0; m < 4; ++m) dst##8[m] = PG8_RD8(lds + PG8_SA(b, h) + aoff + m * 2048); } else { \
        _Pragma("unroll") for (int m = 0; m < 4; ++m) _Pragma("unroll") for (int k = 0; k < 2; ++k) dst[m][k] = *(const PG8_LAS bf16x8*)(lds + PG8_SA(b, h) + aoff + m * 2048 + k * 1024); } } while (0)
#define PG8_LDB(dst, b, h) do { if constexpr (F8) { _Pragma("unroll") for (int n = 0; n < 2; ++n) dst##8[n] = PG8_RD8(lds + PG8_SB(b, h) + boff + n * 2048); } else { \
        _Pragma("unroll") for (int n = 0; n < 2; ++n) _Pragma("unroll") for (int k = 0; k < 2; ++k) dst[n][k] = *(const PG8_LAS bf16x8*)(lds + PG8_SB(b, h) + boff + n * 2048 + k * 1024); } } while (0)
#define PG8_MMA(ai, bj, At, Bt) do { __builtin_amdgcn_s_setprio(1); if constexpr (F8) { _Pragma("unroll") for (int m = 0; m < 4; ++m) _Pragma("unroll") for (int n = 0; n < 2; ++n) \
        acc[ai][bj][m][n] = __builtin_amdgcn_mfma_scale_f32_16x16x128_f8f6f4(Bt##8[n], At##8[m], acc[ai][bj][m][n], 0, 0, 0, sclB, 0, sclA); } else { \
        _Pragma("unroll") for (int m = 0; m < 4; ++m) _Pragma("unroll") for (int n = 0; n < 2; ++n) _Pragma("unroll") for (int k = 0; k < 2; ++k) \
        acc[ai][bj][m][n] = __builtin_amdgcn_mfma_f32_16x16x32_bf16(Bt[n][k], At[m][k], acc[ai][bj][m][n], 0, 0, 0); } __builtin_amdgcn_s_setprio(0); } while (0)
#define PG8_WAIT_V(n) asm volatile("s_waitcnt vmcnt(" #n ")" ::: "memory")
#define PG8_WAIT_L(n) asm volatile("s_waitcnt lgkmcnt(" #n ")" ::: "memory")
#define PG8_BAR __builtin_amdgcn_s_barrier()
#define PG8_SCHED __builtin_amdgcn_sched_barrier(0)
#define PG8_GOFF(dst, ui_) do { _Pragma("unroll") for (int h_ = 0; h_ < 2; ++h_) _Pragma("unroll") for (int i_ = 0; i_ < 2; ++i_) dst[h_][i_] = (unsigned)rmap[(ui_) * 256 + h_ * 128 + stR[i_]] * (unsigned)(K * ES) + (unsigned)stC[i_] * 2u; } while (0)
    Unit cur, nxt; int ui = 0;
    if (!S.next(0, cur)) return;
    f32x4 acc[2][2][4][2];
#pragma unroll
    for (int a = 0; a < 2; ++a)
#pragma unroll
        for (int b = 0; b < 2; ++b)
#pragma unroll
            for (int m = 0; m < 4; ++m)
#pragma unroll
                for (int n = 0; n < 2; ++n) acc[a][b][m][n] = (f32x4){0.f, 0.f, 0.f, 0.f};
    bf16x8 At[4][2], B0[2][2], B1[2][2];
    v8i_t At8[4], B08[2], B18[2];
    int uin = 0;
    PG8_LAS unsigned* gofft = (PG8_LAS unsigned*)((PG8_LAS unsigned char*)rmap + 8192) + tid;
#define PG8_GFILL(u_) do { const int tg_ = tid_fresh(wave_s); PG8_LAS unsigned* gt_ = (PG8_LAS unsigned*)((PG8_LAS unsigned char*)rmap + 8192) + tg_; \
        _Pragma("unroll") for (int i_ = 0; i_ < 2; ++i_) { int R_, C_; stage_rc(tg_ * 16 + i_ * 8192, R_, C_);     \
        _Pragma("unroll") for (int h_ = 0; h_ < 2; ++h_) gt_[((((u_) & 1) * 4 + h_ * 2 + i_)) * 512] = (unsigned)rmap[(u_) * 256 + h_ * 128 + R_] * (unsigned)(K * ES) + (unsigned)C_ * 2u; } } while (0)
    if constexpr (GATHER) { PG8_GFILL(0); }
#define PG8_UNI(x) (F8 ? uni(x) : (x))
    const char* cA = PG8_UNI((const char*)g.A + (size_t)cur.pm * tstep); const char* cB = PG8_UNI((const char*)g.Bt + (size_t)cur.pn * tstep);
    const char* nA = cA;
    if constexpr (SP2) {
        PG8_STAGE(PG8_SB(0, 0), cB, voffB); PG8_STAGE(PG8_SB(0, 1), cB + hstep, voffB); PG8_STAGE_A(PG8_SA(0, 0), 0, 0, false); PG8_STAGE_A(PG8_SA(0, 1), 1, 0, false);
        if (wr == 1) PG8_BAR;
        PG8_WAIT_V(2); PG8_BAR;
        PG8_STAGE(PG8_SB(1, 0), cB + kstep, voffB); PG8_STAGE_A(PG8_SA(1, 0), 0, kstep, false); PG8_STAGE(PG8_SB(1, 1), cB + hstep + kstep, voffB);
        PG8_WAIT_V(6); PG8_BAR;
    }
    for (;;) {
        const bool has_next = S.next(ui + 1, nxt);
        nA = PG8_UNI(has_next ? (const char*)g.A + (size_t)nxt.pm * tstep : cA); const char* nB = PG8_UNI(has_next ? (const char*)g.Bt + (size_t)nxt.pn * tstep : cB);
        uin = has_next ? ui + 1 : ui;
        if constexpr (GATHER) { if (has_next) { PG8_GFILL(ui + 1); } }
        for (int t = 0; t < nt; t += 2) {
            const bool last = (t == nt - 2);
            const size_t k1 = (size_t)(t + 1) * kstep;
            const size_t k2 = last ? 0 : (size_t)(t + 2) * kstep, k3 = k2 + kstep;
            const char* b2 = last ? nB : cB + (size_t)(t + 2) * kstep; const char* b3 = b2 + kstep;
            PG8_LDB(B0, 0, 0); PG8_LDB(B1, 0, 1); PG8_SCHED; PG8_LDA(At, 0, 0); PG8_STAGE_A(PG8_SA(1, 1), 1, k1, false);
            PG8_WAIT_V(8); PG8_WAIT_L(0); PG8_BAR; PG8_MMA(0, 0, At, B0); PG8_MMA(0, 1, At, B1); PG8_BAR; PG8_SCHED;
            PG8_LDA(At, 0, 1); PG8_STAGE(PG8_SB(0, 0), b2, voffB); PG8_STAGE(PG8_SB(0, 1), b2 + hstep, voffB); PG8_STAGE_A(PG8_SA(0, 0), 0, k2, last);
            PG8_WAIT_V(8); PG8_WAIT_L(0); PG8_BAR; PG8_MMA(1, 0, At, B0); PG8_MMA(1, 1, At, B1); PG8_BAR; PG8_SCHED;
            PG8_LDB(B0, 1, 0); PG8_LDB(B1, 1, 1); PG8_SCHED; PG8_LDA(At, 1, 0); PG8_STAGE_A(PG8_SA(0, 1), 1, k2, last);
            PG8_WAIT_V(8); PG8_WAIT_L(0); PG8_BAR; PG8_MMA(0, 0, At, B0); PG8_MMA(0, 1, At, B1); PG8_BAR; PG8_SCHED;
            PG8_LDA(At, 1, 1); PG8_STAGE(PG8_SB(1, 0), b3, voffB); PG8_STAGE(PG8_SB(1, 1), b3 + hstep, voffB); PG8_STAGE_A(PG8_SA(1, 0), 0, k3, last);
            PG8_WAIT_V(8); PG8_WAIT_L(0); PG8_BAR; PG8_MMA(1, 0, At, B0); PG8_MMA(1, 1, At, B1); PG8_BAR; PG8_SCHED;
        }
        if constexpr (ALIGN_EPI) { if (wr == 0) PG8_BAR; }
        { const int le_ = lane_fresh(); E(acc, cur, wr, wc, le_ & 15, le_ >> 4); }
        if (!has_next) break;
#pragma unroll
        for (int a = 0; a < 2; ++a)
#pragma unroll
            for (int b = 0; b < 2; ++b)
#pragma unroll
                for (int m = 0; m < 4; ++m)
#pragma unroll
                    for (int n = 0; n < 2; ++n) acc[a][b][m][n] = (f32x4){0.f, 0.f, 0.f, 0.f};
        cur = nxt; cA = nA; cB = nB; ++ui;
        if constexpr (ALIGN_EPI) { if (wr == 1) PG8_BAR; }
    }
    PG8_WAIT_V(0);
    if constexpr (!ALIGN_EPI) { if (wr == 0) PG8_BAR; }
    PG8_BAR;
#undef PG8_SA
#undef PG8_SB
#undef PG8_GLDS
#undef PG8_STAGE
#undef PG8_STAGE_A
#undef PG8_LDA
#undef PG8_LDB
#undef PG8_RD8
#undef PG8_MMA
#undef PG8_WAIT_V
#undef PG8_WAIT_L
#undef PG8_BAR
#undef PG8_SCHED
#undef PG8_GOFF
#undef PG8_GFILL
}
}

struct GEpiIn { static constexpr bool PERM = true; unsigned char* ws;
    DI void operator()(const f32x4 (&acc)[2][2][4][2], const pg8::Unit& u, int wr, int wc, int fr, int fq) const {
        const int row0 = u.pm * 256 + wr * 64 + fr, col0 = u.pn * 256 + wc * 32 + 8 * fq;
        if (epi_in_is_rope(col0)) {
            f32x4 t0[2][4], t1[2][4];
#pragma unroll
            for (int ai = 0; ai < 2; ++ai)
#pragma unroll
                for (int m = 0; m < 4; ++m) epi_in_table(ws, row0 + ai * 128 + m * 16, col0, t0[ai][m], t1[ai][m]);
#pragma unroll
            for (int ai = 0; ai < 2; ++ai)
#pragma unroll
                for (int m = 0; m < 4; ++m)
#pragma unroll
                    for (int bj = 0; bj < 2; ++bj) { const f32x4 a = acc[ai][bj][m][0], b = acc[ai][bj][m][1]; const float v[8] = {a[0], a[1], a[2], a[3], b[0], b[1], b[2], b[3]};
                        epi_in8_rope(ws, row0 + ai * 128 + m * 16, col0 + bj * 128, v, t0[ai][m], t1[ai][m]); }
            return;
        }
#pragma unroll
        for (int ai = 0; ai < 2; ++ai)
#pragma unroll
            for (int m = 0; m < 4; ++m)
#pragma unroll
                for (int bj = 0; bj < 2; ++bj) { const f32x4 a = acc[ai][bj][m][0], b = acc[ai][bj][m][1]; const float v[8] = {a[0], a[1], a[2], a[3], b[0], b[1], b[2], b[3]};
                    epi_in8(ws, row0 + ai * 128 + m * 16, col0 + bj * 128, v); }
    } };
struct GEpiOut { static constexpr bool PERM = true; unsigned char* ws;
    DI void operator()(const f32x4 (&acc)[2][2][4][2], const pg8::Unit& u, int wr, int wc, int fr, int fq) const {
        const int row0 = u.pm * 256 + wr * 64 + fr, col0 = u.pn * 256 + wc * 32 + 8 * fq;
#pragma unroll
        for (int ai = 0; ai < 2; ++ai)
#pragma unroll
            for (int m = 0; m < 4; ++m)
#pragma unroll
                for (int bj = 0; bj < 2; ++bj) { const f32x4 a = acc[ai][bj][m][0], b = acc[ai][bj][m][1]; const float v[8] = {a[0], a[1], a[2], a[3], b[0], b[1], b[2], b[3]};
                    store8_bf16((bf16_t*)(ws + WS_MIX) + (size_t)(row0 + ai * 128 + m * 16) * D + col0 + bj * 128, v); }
    } };
struct GEpiE1 { static constexpr bool PERM = true; unsigned char* ws;
    DI void operator()(const f32x4 (&acc)[2][2][4][2], const pg8::Unit& u, int wr, int wc, int fr, int fq) const {
        const int row0 = u.pm * 256 + wr * 64 + fr, col0 = (u.pn & 15) * 128 + wc * 32 + 8 * fq;
#pragma unroll
        for (int ai = 0; ai < 2; ++ai)
#pragma unroll
            for (int m = 0; m < 4; ++m) { const f32x4 g0 = acc[ai][0][m][0], g1 = acc[ai][0][m][1], u0 = acc[ai][1][m][0], u1 = acc[ai][1][m][1];
                const float v[8] = {silu_f(g0[0]) * u0[0], silu_f(g0[1]) * u0[1], silu_f(g0[2]) * u0[2], silu_f(g0[3]) * u0[3], silu_f(g1[0]) * u1[0], silu_f(g1[1]) * u1[1], silu_f(g1[2]) * u1[2], silu_f(g1[3]) * u1[3]};
#if F8_E2
                *(u32x2*)((unsigned char*)(ws + WS_HID) + (size_t)(row0 + ai * 128 + m * 16) * FF + col0) =
                    (u32x2){pk4_f8(v[0] * F8_HIDSCALE, v[1] * F8_HIDSCALE, v[2] * F8_HIDSCALE, v[3] * F8_HIDSCALE), pk4_f8(v[4] * F8_HIDSCALE, v[5] * F8_HIDSCALE, v[6] * F8_HIDSCALE, v[7] * F8_HIDSCALE)};
#else
                store8_bf16((bf16_t*)(ws + WS_HID) + (size_t)(row0 + ai * 128 + m * 16) * FF + col0, v);
#endif
            }
    } };
struct GEpiE2 { static constexpr bool PERM = true; unsigned char* ws;
    DI void operator()(const f32x4 (&acc)[2][2][4][2], const pg8::Unit& u, int wr, int wc, int fr, int fq) const {
        const int row0 = u.pm * 256 + wr * 64 + fr, col0 = (u.pn & 7) * 256 + wc * 32 + 8 * fq;
        const float* gatev = (const float*)(ws + WS_GATEV);
        float gtv[2][4];
#pragma unroll
        for (int ai = 0; ai < 2; ++ai)
#pragma unroll
            for (int m = 0; m < 4; ++m) gtv[ai][m] = gatev[row0 + ai * 128 + m * 16];
#pragma unroll
        for (int ai = 0; ai < 2; ++ai)
#pragma unroll
            for (int m = 0; m < 4; ++m) { const int row = row0 + ai * 128 + m * 16; const float gt = gtv[ai][m];
#pragma unroll
                for (int bj = 0; bj < 2; ++bj) { const f32x4 a = acc[ai][bj][m][0], b = acc[ai][bj][m][1]; const float v[8] = {a[0] * gt, a[1] * gt, a[2] * gt, a[3] * gt, b[0] * gt, b[1] * gt, b[2] * gt, b[3] * gt};
#if F8_Y
                    *(u32x2*)((unsigned char*)(ws + WS_Y) + (size_t)row * D + col0 + bj * 128) = (u32x2){pk4_f8(v[0] * F8_YSCALE, v[1] * F8_YSCALE, v[2] * F8_YSCALE, v[3] * F8_YSCALE), pk4_f8(v[4] * F8_YSCALE, v[5] * F8_YSCALE, v[6] * F8_YSCALE, v[7] * F8_YSCALE)};
#else
                    store8_bf16((bf16_t*)(ws + WS_Y) + (size_t)row * D + col0 + bj * 128, v);
#endif
                } }
    } };


constexpr int NWAVES = 8, NTHR = 512;
constexpr int RING_BYTES = 131072;
constexpr int LDSCTL_OFF = 162816, MISC_OFF = LDSCTL_OFF + 320;
constexpr int RMAP_OFF = RING_BYTES;
constexpr int GOFF_OFF = RMAP_OFF + 8192;
constexpr int LDS_BYTES = 163840;
constexpr int CW_BAR = 4096;
static_assert((size_t)(CW_BAR + XCD_BAR_WORDS) * 4 <= CTL_ZERO_BYTES, "the per-call memset must cover the barrier words");

enum { PH_PREP = 0, PH_PRENORM, PH_INPROJ, PH_ATTN, PH_RETOUT, PH_OUTPROJ, PH_ROWPASS, PH_TOPK, PH_E1, PH_E2, PH_FINAL, PH_COUNT };

struct Frame {
    unsigned char* lds;
    LAS unsigned char* ldsl;
    unsigned char* ws;
    const void* const* in;
    float* out;
    int tid, lane, wave, wg, nwg;
};

DI void ph_prep(const Frame& F) {
    const float* c = (const float*)F.in[I_C]; const float* w_ada = (const float*)F.in[I_WADA]; const float* b_ada = (const float*)F.in[I_BADA];
    float* mod = (float*)(F.ws + WS_MOD);
    float* sc = (float*)F.lds;
    float* red = (float*)(F.lds + 32768);
    {
        float cv_[16];
#pragma unroll
        for (int i = 0; i < 16; ++i) cv_[i] = c[F.tid + NTHR * i];
#pragma unroll
        for (int i = 0; i < 16; ++i) sc[F.tid + NTHR * i] = silu_f(cv_[i]);
    }
    __syncthreads();
    for (int u = F.wg; u < 256; u += F.nwg) {
        const int cbk = u >> 1, kh = u & 1, cg = F.tid % 24, ks = F.tid / 24;
        float acc[4][4];
#pragma unroll
        for (int b = 0; b < 4; ++b)
#pragma unroll
            for (int j = 0; j < 4; ++j) acc[b][j] = 0.f;
        if (ks < 21) {
            const float* wp = w_ada + (size_t)(kh * 1024) * (6 * D) + cbk * 96 + cg * 4;
            for (int k = ks; k < 1024; k += 21 * 7) {
                f32x4 w[7];
#pragma unroll
                for (int i = 0; i < 7; ++i) { const int ki = (k + 21 * i < 1024) ? k + 21 * i : ks; w[i] = __builtin_nontemporal_load((const f32x4*)(wp + (size_t)ki * (6 * D))); }
#pragma unroll
                for (int i = 0; i < 7; ++i) { const int ki = k + 21 * i; if (ki < 1024) {
#pragma unroll
                    for (int b = 0; b < 4; ++b) { const float a = sc[b * D + kh * 1024 + ki]; acc[b][0] += a * w[i][0]; acc[b][1] += a * w[i][1]; acc[b][2] += a * w[i][2]; acc[b][3] += a * w[i][3]; } } }
            }
#pragma unroll
            for (int b = 0; b < 4; ++b)
#pragma unroll
                for (int j = 0; j < 4; ++j) red[(ks * 24 + cg) * 16 + b * 4 + j] = acc[b][j];
        }
        __syncthreads();
        if (F.tid < 384) {
            const int cg2 = F.tid / 16, bj = F.tid % 16, b = bj >> 2, j = bj & 3;
            const int col = cbk * 96 + cg2 * 4 + j;
            float s = kh == 0 ? b_ada[col] : 0.f;
#pragma unroll
            for (int k2 = 0; k2 < 21; ++k2) s += red[(k2 * 24 + cg2) * 16 + bj];
            mod[(size_t)kh * MOD_HALF + b * (6 * D) + col] = s;
        }
        __syncthreads();
    }
    const int* pos = (const int*)F.in[I_POS];
    f32x2* rd = (f32x2*)(F.ws + WS_ROPED); f32x2* rr = (f32x2*)(F.ws + WS_ROPER);
    {
        static_assert(M * 96 == 12 * 256 * NTHR, "rope-table work split");
        const int base = F.wg * NTHR + F.tid, stride = F.nwg * NTHR;
        if (F.nwg == 256) {
            int pv[12];
#pragma unroll
            for (int i = 0; i < 12; ++i) pv[i] = pos[(base + stride * i) / 96];
#pragma unroll
            for (int i = 0; i < 12; ++i) {
                const int idx = base + stride * i, tok = idx / 96, f = idx % 96;
                const float p = (float)pv[i];
                float ex; if (f < 32) ex = (float)(2 * f) * (1.f / 64.f); else ex = (float)(2 * (f - 32)) * (1.f / 128.f);
                const float inv = exp2f(-ex * 13.287712379549449f);
                double rev = (double)(p * inv) * 0.15915494309189535; rev -= rint(rev);
                const float rv = (float)rev, sn = __builtin_amdgcn_sinf(rv), cs = __builtin_amdgcn_cosf(rv);
                if (f < 32) rd[(size_t)tok * 32 + f] = (f32x2){cs, sn}; else rr[(size_t)tok * 64 + (f - 32)] = (f32x2){cs, sn};
            }
        } else {
        for (int idx = F.wg * NTHR + F.tid; idx < M * 96; idx += F.nwg * NTHR) {
        const int tok = idx / 96, f = idx % 96;
        const float p = (float)pos[tok];
        float ex; if (f < 32) ex = (float)(2 * f) * (1.f / 64.f); else ex = (float)(2 * (f - 32)) * (1.f / 128.f);
        const float inv = exp2f(-ex * 13.287712379549449f);
        double rev = (double)(p * inv) * 0.15915494309189535; rev -= rint(rev);
        const float rv = (float)rev, sn = __builtin_amdgcn_sinf(rv), cs = __builtin_amdgcn_cosf(rv);
        if (f < 32) rd[(size_t)tok * 32 + f] = (f32x2){cs, sn}; else rr[(size_t)tok * 64 + (f - 32)] = (f32x2){cs, sn};
    }
        }
    }
}


DI unsigned cvt_pk_bf16(float lo, float hi) { unsigned r; asm volatile("v_cvt_pk_bf16_f32 %0, %1, %2" : "=v"(r) : "v"(lo), "v"(hi)); return r; }
struct MapIn   { DI int src(int n) const { return src_col_in(n); } DI int dst(int n) const { return n; } };
struct MapId   { DI int src(int n) const { return n; } DI int dst(int n) const { return n; } };
struct MapGU   { int up; DI int src(int n) const { return n; } DI int dst(int n) const { return ((n >> 7) << 8) + (n & 127) + up * 128; } };
template <class MapF>
DI void transpose_item(const float* __restrict__ W, int ldw, bf16_t* __restrict__ WT, LAS float* scr, int k0, int n0, int lane, const MapF f) {
    const int sc = f.src(n0 + (lane & 31));
#pragma unroll 8
    for (int i = 0; i < 32; ++i) { const int kk = 2 * i + (lane >> 5); scr[kk * 33 + (lane & 31)] = W[(size_t)(k0 + kk) * ldw + sc]; }
    asm volatile("s_waitcnt lgkmcnt(0)" ::: "memory");
    const int c = lane & 7;
#pragma unroll
    for (int j = 0; j < 4; ++j) { const int n = (lane >> 3) + 8 * j; const LAS float* sp = scr + (8 * c) * 33 + n;
        u32x4 o; o.x = cvt_pk_bf16(sp[0 * 33], sp[1 * 33]); o.y = cvt_pk_bf16(sp[2 * 33], sp[3 * 33]); o.z = cvt_pk_bf16(sp[4 * 33], sp[5 * 33]); o.w = cvt_pk_bf16(sp[6 * 33], sp[7 * 33]);
        *(u32x4*)(WT + (size_t)f.dst(n0 + n) * 2048 + k0 + 8 * c) = o; }
    asm volatile("s_waitcnt lgkmcnt(0)" ::: "memory");
}
struct CvItem { const float* src; bf16_t* dst; int up; };
DI CvItem cv_decode2(const Frame& F, int q, int kb, int nb, int lane);
DI CvItem cv_decode(const Frame& F, int it, int lane) { const int ii = it & 1023; return cv_decode2(F, it >> 10, ii >> 5, ii & 31, lane); }
DI CvItem cv_decode2(const Frame& F, int q, int kb, int nb, int lane) {
    const int ty = q >> 4, e = q & 15, n4 = lane & 15, kr = lane >> 4;
    CvItem c;
    const float* W = (const float*)F.in[ty == 0 ? I_WGATE : (ty == 1 ? I_WUP : I_WDOWN)] + (size_t)e * D * FF;
    c.src = W + (size_t)(kb * 64 + 16 * kr) * 2048 + nb * 64 + 4 * n4;
    bf16_t* WT = ty < 2 ? (bf16_t*)(F.ws + WS_W1T) + (size_t)e * 4096 * 2048 : (bf16_t*)(F.ws + WS_W2T) + (size_t)e * 2048 * 2048;
    const int n0 = nb * 64, r0 = ty < 2 ? ((n0 >> 7) << 8) + (n0 & 127) + ty * 128 : n0;
    c.up = ty;
    if ((ty < 2 && F8_E1) || (ty == 2 && F8_E2)) {
        unsigned char* WT8 = ty < 2 ? (unsigned char*)(F.ws + WS_W1T) + (size_t)e * 4096 * 2048 : (unsigned char*)(F.ws + WS_W2T) + (size_t)e * 2048 * 2048;
        c.dst = (bf16_t*)(WT8 + (size_t)r0 * 2048 + kb * 64);
    } else c.dst = WT + (size_t)r0 * 2048 + kb * 64;
    return c;
}
#define CV_LOAD(v, c) do { _Pragma("unroll") for (int i_ = 0; i_ < 16; ++i_) v[i_] = __builtin_nontemporal_load((const f32x4*)((c).src + (size_t)i_ * 2048)); } while (0)
DI void cv_store(const f32x4 (&v)[16], const CvItem& c, char* tl, int lane) {
    const int n4 = lane & 15, kr = lane >> 4;
  if ((c.up < 2 && F8_E1) || (c.up == 2 && F8_E2)) {
#pragma unroll
    for (int j = 0; j < 4; ++j) { const int n = 4 * n4 + j;
        u32x4 a;
        a.x = pk4_f8(v[0][j] * F8_WSCALE, v[1][j] * F8_WSCALE, v[2][j] * F8_WSCALE, v[3][j] * F8_WSCALE); a.y = pk4_f8(v[4][j] * F8_WSCALE, v[5][j] * F8_WSCALE, v[6][j] * F8_WSCALE, v[7][j] * F8_WSCALE);
        a.z = pk4_f8(v[8][j] * F8_WSCALE, v[9][j] * F8_WSCALE, v[10][j] * F8_WSCALE, v[11][j] * F8_WSCALE); a.w = pk4_f8(v[12][j] * F8_WSCALE, v[13][j] * F8_WSCALE, v[14][j] * F8_WSCALE, v[15][j] * F8_WSCALE);
        *(u32x4*)(tl + n * 64 + ((kr ^ (n4 & 3)) << 4)) = a; }
    asm volatile("s_waitcnt lgkmcnt(0)" ::: "memory");
#pragma unroll
    for (int r = 0; r < 4; ++r) { const int n = (lane >> 2) + 16 * r, cc = lane & 3;
        const u32x4 o = *(const u32x4*)(tl + n * 64 + ((cc ^ ((n >> 2) & 3)) << 4));
        __builtin_nontemporal_store(o, (u32x4*)((unsigned char*)c.dst + (size_t)n * 2048 + 16 * cc)); }
    asm volatile("s_waitcnt lgkmcnt(0)" ::: "memory");
    return;
  }
#pragma unroll
    for (int j = 0; j < 4; ++j) { const int n = 4 * n4 + j; char* row = tl + n * 128; const int sw = (n >> 2) & 7;
        u32x4 a, b;
        a.x = cvt_pk_bf16(v[0][j], v[1][j]); a.y = cvt_pk_bf16(v[2][j], v[3][j]); a.z = cvt_pk_bf16(v[4][j], v[5][j]); a.w = cvt_pk_bf16(v[6][j], v[7][j]);
        b.x = cvt_pk_bf16(v[8][j], v[9][j]); b.y = cvt_pk_bf16(v[10][j], v[11][j]); b.z = cvt_pk_bf16(v[12][j], v[13][j]); b.w = cvt_pk_bf16(v[14][j], v[15][j]);
        *(u32x4*)(row + (((2 * kr) ^ sw) << 4)) = a; *(u32x4*)(row + (((2 * kr + 1) ^ sw) << 4)) = b; }
    asm volatile("s_waitcnt lgkmcnt(0)" ::: "memory");
#pragma unroll
    for (int r = 0; r < 8; ++r) { const int n = (lane >> 3) + 8 * r, cc = lane & 7;
        const u32x4 o = *(const u32x4*)(tl + n * 128 + ((cc ^ ((n >> 2) & 7)) << 4));
        __builtin_nontemporal_store(o, (u32x4*)(c.dst + (size_t)n * 2048 + 8 * cc)); }
    asm volatile("s_waitcnt lgkmcnt(0)" ::: "memory");
}
DI void convert_experts_slice(const Frame& F) {
    char* tl = (char*)F.lds + F.wave * 8192;
    constexpr int NIT = 3 * NE * 1024;
    const int per = (NIT + F.nwg - 1) / F.nwg, lo = F.wg * per, hi = (lo + per < NIT) ? lo + per : NIT;
    f32x4 va[16], vb[16]; CvItem ca, cb;
    const int cnt = (hi - lo) / NWAVES, it0 = lo + F.wave;
    if (F.nwg == 256) {
#define CV_DEC(i_) cv_decode2(F, (6 * F.wg + ((i_) >> 2)) >> 5, (6 * F.wg + ((i_) >> 2)) & 31, 4 * F.wave + ((i_) & 3), F.lane)
        ca = CV_DEC(0); CV_LOAD(va, ca);
        for (int i = 0; i < 24; i += 2) {
            cb = CV_DEC(i + 1); CV_LOAD(vb, cb);
            cv_store(va, ca, tl, F.lane);
            const int i2 = (i + 2 < 24) ? i + 2 : 23;
            ca = CV_DEC(i2); CV_LOAD(va, ca);
            cv_store(vb, cb, tl, F.lane);
        }
#undef CV_DEC
    } else if ((hi - lo) == cnt * NWAVES && (cnt & 1) == 0 && cnt > 0) {
        ca = cv_decode(F, it0, F.lane); CV_LOAD(va, ca);
        for (int i = 0; i < cnt; i += 2) {
            cb = cv_decode(F, it0 + NWAVES * (i + 1), F.lane); CV_LOAD(vb, cb);
            cv_store(va, ca, tl, F.lane);
            const int i2 = (i + 2 < cnt) ? i + 2 : cnt - 1;
            ca = cv_decode(F, it0 + NWAVES * i2, F.lane); CV_LOAD(va, ca);
            cv_store(vb, cb, tl, F.lane);
        }
    } else {
        for (int it = it0; it < hi; it += NWAVES) { ca = cv_decode(F, it, F.lane); CV_LOAD(va, ca); cv_store(va, ca, tl, F.lane); }
    }
}
template <class MapF>
DI void transpose_item_f8(const float* __restrict__ W, int ldw, unsigned char* __restrict__ WT8, LAS float* scr, int k0, int n0, int lane, const MapF f) {
    const int sc = f.src(n0 + (lane & 31));
    float wv[32];
#pragma unroll
    for (int i = 0; i < 32; ++i) { const int kk = 2 * i + (lane >> 5); wv[i] = W[(size_t)(k0 + kk) * ldw + sc]; }
#pragma unroll
    for (int i = 0; i < 32; ++i) { const int kk = 2 * i + (lane >> 5); scr[kk * 33 + (lane & 31)] = wv[i]; }
    asm volatile("s_waitcnt lgkmcnt(0)" ::: "memory");
    const int c = lane & 3;
#pragma unroll
    for (int j = 0; j < 2; ++j) { const int n = (lane >> 2) + 16 * j; const LAS float* sp = scr + (16 * c) * 33 + n;
        u32x4 o;
        o.x = pk4_f8(sp[0 * 33] * F8_WSCALE, sp[1 * 33] * F8_WSCALE, sp[2 * 33] * F8_WSCALE, sp[3 * 33] * F8_WSCALE); o.y = pk4_f8(sp[4 * 33] * F8_WSCALE, sp[5 * 33] * F8_WSCALE, sp[6 * 33] * F8_WSCALE, sp[7 * 33] * F8_WSCALE);
        o.z = pk4_f8(sp[8 * 33] * F8_WSCALE, sp[9 * 33] * F8_WSCALE, sp[10 * 33] * F8_WSCALE, sp[11 * 33] * F8_WSCALE); o.w = pk4_f8(sp[12 * 33] * F8_WSCALE, sp[13 * 33] * F8_WSCALE, sp[14 * 33] * F8_WSCALE, sp[15 * 33] * F8_WSCALE);
        *(u32x4*)(WT8 + (size_t)f.dst(n0 + n) * 2048 + k0 + 16 * c) = o; }
    asm volatile("s_waitcnt lgkmcnt(0)" ::: "memory");
}
template <bool F8>
DI void cvw_item(const float* __restrict__ W, int ldw, void* WT, char* tl, int k0, int s0, int mode, int lane) {
    const int n4 = lane & 15, kr = lane >> 4;
    const float* src = W + (size_t)(k0 + 16 * kr) * ldw + s0 + 4 * n4;
    f32x4 v[16];
#pragma unroll
    for (int i = 0; i < 16; ++i) v[i] = __builtin_nontemporal_load((const f32x4*)(src + (size_t)i * ldw));
    const int hb = (s0 >> 6) & 1, g128 = s0 & ~127;
#define CVW_ROW(n_) (mode == 0 ? s0 + (n_) : (mode == 1 ? s0 + ((n_) < 32 ? 2 * (n_) : 2 * ((n_) - 32) + 1) : g128 + 2 * (n_) + hb))
    if (F8) {
#pragma unroll
        for (int j = 0; j < 4; ++j) { const int n = 4 * n4 + j;
            u32x4 a;
            a.x = pk4_f8(v[0][j] * F8_WSCALE, v[1][j] * F8_WSCALE, v[2][j] * F8_WSCALE, v[3][j] * F8_WSCALE); a.y = pk4_f8(v[4][j] * F8_WSCALE, v[5][j] * F8_WSCALE, v[6][j] * F8_WSCALE, v[7][j] * F8_WSCALE);
            a.z = pk4_f8(v[8][j] * F8_WSCALE, v[9][j] * F8_WSCALE, v[10][j] * F8_WSCALE, v[11][j] * F8_WSCALE); a.w = pk4_f8(v[12][j] * F8_WSCALE, v[13][j] * F8_WSCALE, v[14][j] * F8_WSCALE, v[15][j] * F8_WSCALE);
            *(u32x4*)(tl + n * 64 + ((kr ^ (n4 & 3)) << 4)) = a; }
        asm volatile("s_waitcnt lgkmcnt(0)" ::: "memory");
#pragma unroll
        for (int r = 0; r < 4; ++r) { const int n = (lane >> 2) + 16 * r, cc = lane & 3;
            const u32x4 o = *(const u32x4*)(tl + n * 64 + ((cc ^ ((n >> 2) & 3)) << 4));
            *(u32x4*)((unsigned char*)WT + (size_t)CVW_ROW(n) * 2048 + k0 + 16 * cc) = o; }
    } else {
#pragma unroll
        for (int j = 0; j < 4; ++j) { const int n = 4 * n4 + j; char* row = tl + n * 128; const int sw = (n >> 2) & 7;
            u32x4 a, b;
            a.x = cvt_pk_bf16(v[0][j], v[1][j]); a.y = cvt_pk_bf16(v[2][j], v[3][j]); a.z = cvt_pk_bf16(v[4][j], v[5][j]); a.w = cvt_pk_bf16(v[6][j], v[7][j]);
            b.x = cvt_pk_bf16(v[8][j], v[9][j]); b.y = cvt_pk_bf16(v[10][j], v[11][j]); b.z = cvt_pk_bf16(v[12][j], v[13][j]); b.w = cvt_pk_bf16(v[14][j], v[15][j]);
            *(u32x4*)(row + (((2 * kr) ^ sw) << 4)) = a; *(u32x4*)(row + (((2 * kr + 1) ^ sw) << 4)) = b; }
        asm volatile("s_waitcnt lgkmcnt(0)" ::: "memory");
#pragma unroll
        for (int r = 0; r < 8; ++r) { const int n = (lane >> 3) + 8 * r, cc = lane & 7;
            const u32x4 o = *(const u32x4*)(tl + n * 128 + ((cc ^ ((n >> 2) & 7)) << 4));
            *(u32x4*)((bf16_t*)WT + (size_t)CVW_ROW(n) * 2048 + k0 + 8 * cc) = o; }
    }
    asm volatile("s_waitcnt lgkmcnt(0)" ::: "memory");
#undef CVW_ROW
}
DI void ph_convert(const Frame& F) {
    __syncthreads();
#if F8_IN && OPT_IN && OPT_OUT
    {
        char* tl = (char*)F.lds + F.wave * 8192;
        const int gw0 = F.wg * NWAVES + F.wave, ngw0 = F.nwg * NWAVES;
        constexpr int NI_IN = 32 * (NCOL / 64), NI_OUT = 32 * (D / 64);
        for (int it = gw0; it < NI_IN + NI_OUT; it += ngw0) {
            if (it < NI_IN) { const int kb = it / (NCOL / 64), cb = it % (NCOL / 64), s0 = cb * 64, sec = s0 >> 10;
                cvw_item<true>((const float*)F.in[I_WIN], NCOL, F.ws + WS_WINT, tl, kb * 64, s0, sec <= 1 ? 1 : ((sec == 3 || sec == 4) ? 2 : 0), F.lane); }
            else { const int r = it - NI_IN, kb = r >> 5, cb = r & 31;
                cvw_item<false>((const float*)F.in[I_WOUT], D, F.ws + WS_WOUTT, tl, kb * 64, cb * 64, 0, F.lane); }
        }
        return;
    }
#endif
    LAS float* scr = (LAS float*)(F.ldsl + F.wave * 16384);
    const int gw = F.wg * NWAVES + F.wave, ngw = F.nwg * NWAVES;
    constexpr int I_IN = OPT_IN ? 32 * (NCOL / 32) : 0, I_OUT = OPT_OUT ? 32 * 64 : 0, I_E1 = 0, I_E2 = 0;
    for (int it = gw; it < I_IN + I_OUT + I_E1 + I_E2; it += ngw) {
        int r = it;
        if (r < I_IN) { const int kb = r / (NCOL / 32), nb = r % (NCOL / 32);
#if F8_IN
            transpose_item_f8((const float*)F.in[I_WIN], NCOL, (unsigned char*)(F.ws + WS_WINT), scr, kb * 64, nb * 32, F.lane, MapIn{});
#else
            transpose_item((const float*)F.in[I_WIN], NCOL, (bf16_t*)(F.ws + WS_WINT), scr, kb * 64, nb * 32, F.lane, MapIn{});
#endif
            continue; } r -= I_IN;
        if (r < I_OUT) { const int kb = r >> 6, nb = r & 63; transpose_item((const float*)F.in[I_WOUT], D, (bf16_t*)(F.ws + WS_WOUTT), scr, kb * 64, nb * 32, F.lane, MapId{}); continue; } r -= I_OUT;
        if (r < I_E1) { const int q = r >> 11, up = q >> 4, e = q & 15, ii = r & 2047, kb = ii >> 6, nb = ii & 63;
            transpose_item((const float*)F.in[up ? I_WUP : I_WGATE] + (size_t)e * D * FF, FF, (bf16_t*)(F.ws + WS_W1T) + (size_t)e * 4096 * 2048, scr, kb * 64, nb * 32, F.lane, MapGU{up}); continue; } r -= I_E1;
        { const int e = r >> 11, ii = r & 2047, kb = ii >> 6, nb = ii & 63;
            transpose_item((const float*)F.in[I_WDOWN] + (size_t)e * FF * D, D, (bf16_t*)(F.ws + WS_W2T) + (size_t)e * 2048 * 2048, scr, kb * 64, nb * 32, F.lane, MapId{}); }
    }
}
struct SubOrder { pg8::StaticOrder S; int i0, n; DI bool next(int i, pg8::Unit& u) const { return i < n && S.next(i0 + i, u); } };
DI void ph_inproj(const Frame& F) {
    pg8::Gemm g{(const bf16_t*)(F.ws + WS_H), (const bf16_t*)(F.ws + WS_WINT), D}; GEpiIn E{F.ws};
    pg8::StaticOrder S; S.init(M, NCOL, F.nwg, F.wg);
#if F8_IN
    pg8::gemm_phase<GEpiIn, pg8::StaticOrder, false, true>(F.ldsl, g, S, E, nullptr, F.wave, F8_WSCL, F8_HSCL);
#else
    pg8::gemm_phase<GEpiIn, pg8::StaticOrder, false>(F.ldsl, g, S, E, nullptr, F.wave);
#endif
}
DI void ph_outproj(const Frame& F) {
    pg8::Gemm g{(const bf16_t*)(F.ws + WS_MIXIN), (const bf16_t*)(F.ws + WS_WOUTT), D}; pg8::StaticOrder S; S.init(M, D, F.nwg, F.wg); GEpiOut E{F.ws};
    pg8::gemm_phase<GEpiOut, pg8::StaticOrder, false>(F.ldsl, g, S, E, nullptr, F.wave);
}
DI void ph_e1(const Frame& F) {
    LAS int* rm = (LAS int*)(F.ldsl + RMAP_OFF);
    const int* rowmap = (const int*)(F.ws + WS_ROWMAP);
    pg8::ExpertOrder<16> S; S.init(F.nwg, F.wg);
    pg8::Unit u;
    {
        int rv[8]; bool ok[8];
#pragma unroll
        for (int i = 0; i < 8; ++i) { ok[i] = S.next(i, u); rv[i] = (ok[i] && F.tid < 256) ? rowmap[u.pm * 256 + F.tid] : 0; }
#pragma unroll
        for (int i = 0; i < 8; ++i) if (ok[i] && F.tid < 256) rm[i * 256 + F.tid] = rv[i];
    }
    __syncthreads();
    pg8::Gemm g{(const bf16_t*)(F.ws + WS_H), (const bf16_t*)(F.ws + WS_W1T), D}; GEpiE1 E{F.ws};
#if F8_E1
    pg8::gemm_phase<GEpiE1, pg8::ExpertOrder<16>, true, true>(F.ldsl, g, S, E, rm, F.wave, F8_WSCL, F8_HSCL);
#else
    pg8::gemm_phase<GEpiE1, pg8::ExpertOrder<16>, true>(F.ldsl, g, S, E, rm, F.wave);
#endif
}
DI void ph_e2(const Frame& F) {
    pg8::Gemm g{(const bf16_t*)(F.ws + WS_HID), (const bf16_t*)(F.ws + WS_W2T), FF}; pg8::ExpertOrder<8, true> S; S.init(F.nwg, F.wg); GEpiE2 E{F.ws};
#if F8_E2
    pg8::gemm_phase<GEpiE2, pg8::ExpertOrder<8, true>, false, true>(F.ldsl, g, S, E, nullptr, F.wave, F8_WSCL, F8_HIDSCL);
#else
    pg8::gemm_phase<GEpiE2, pg8::ExpertOrder<8, true>, false>(F.ldsl, g, S, E, nullptr, F.wave);
#endif
}


namespace att {
using bf16x8 = __attribute__((ext_vector_type(8))) short;
using s16x4  = __attribute__((ext_vector_type(4))) short;
using f32x16 = __attribute__((ext_vector_type(16))) float;
constexpr int SHM_V = 16384, SHM_K = 8192, OFF_V = 0, OFF_K = 49152, OFF_ST = 73728;
constexpr float THRL = 8.f;
#define AT_KSWZ(row, colB) ((row) * 128 + ((colB) ^ ((((row) >> 1) & 7) << 4)))
#define AT_SBAR() __builtin_amdgcn_sched_barrier(0)
DI int crow(int r, int hi) { return (r & 3) + 8 * (r >> 2) + 4 * hi; }
DI unsigned cvtpk(float lo, float hi) { unsigned r; asm volatile("v_cvt_pk_bf16_f32 %0, %1, %2" : "=v"(r) : "v"(lo), "v"(hi)); return r; }
DI int v_st(int k, int c) { const int kk = (k & ~0xC) | ((k & 4) << 1) | ((k & 8) >> 1); return ((kk >> 3) * 4 + (c >> 5)) * 512 + ((kk & 7) * 32 + (c & 31)) * 2; }
DI int v_rd_base(int lane) { return ((lane & 3) << 3) | (((lane >> 2) & 3) << 6) | (((lane >> 4) & 1) << 5) | (((lane >> 5) & 1) << 8); }
constexpr int v_rd_off(int d0, int ks, int half) { return d0 * 512 + ks * 4096 + half * 2048; }
template <int OFF> DI s16x4 tr_read(int vb) { s16x4 r; asm volatile("ds_read_b64_tr_b16 %0, %1 offset:%2" : "=&v"(r) : "v"(vb), "i"(OFF) : "memory"); return r; }
DI void partialSM(f32x16& p0, f32x16& p1, float& m_ref, f32x16& negm, float& alpha) {
    float pmax = p0[0];
#pragma unroll
    for (int r = 1; r < 16; ++r) pmax = fmaxf(pmax, p0[r]);
#pragma unroll
    for (int r = 0; r < 16; ++r) pmax = fmaxf(pmax, p1[r]);
    { auto rr = __builtin_amdgcn_permlane32_swap(__float_as_uint(pmax), __float_as_uint(pmax), false, false); pmax = fmaxf(__uint_as_float(rr[0]), __uint_as_float(rr[1])); }
    alpha = 1.f;
    if (__builtin_expect(!__all(pmax <= THRL), 0)) {
        const float dl = fmaxf(pmax, 0.f); m_ref += dl; alpha = __builtin_amdgcn_exp2f(-dl);
#pragma unroll
        for (int r = 0; r < 16; ++r) { p0[r] -= dl; p1[r] -= dl; }
#pragma unroll
        for (int r = 0; r < 16; ++r) negm[r] = -m_ref;
    }
#pragma unroll
    for (int r = 0; r < 16; ++r) p0[r] = __builtin_amdgcn_exp2f(p0[r]);
}
DI void finishSM(f32x16& p0, f32x16& p1, float alpha, float& l_reg, bf16x8& pa0, bf16x8& pa1, bf16x8& pa2, bf16x8& pa3) {
#pragma unroll
    for (int r = 0; r < 16; ++r) p1[r] = __builtin_amdgcn_exp2f(p1[r]);
    float ps = 0;
#pragma unroll
    for (int r = 0; r < 16; ++r) ps += p0[r];
#pragma unroll
    for (int r = 0; r < 16; ++r) ps += p1[r];
    { auto rr = __builtin_amdgcn_permlane32_swap(__float_as_uint(ps), __float_as_uint(ps), false, false); ps = __uint_as_float(rr[0]) + __uint_as_float(rr[1]); }
    l_reg = l_reg * alpha + ps;
#define AT_PK4(P, BASE, OUT) do { unsigned a0 = cvtpk(P[BASE + 0], P[BASE + 1]), a1 = cvtpk(P[BASE + 2], P[BASE + 3]);   \
    unsigned b0 = cvtpk(P[BASE + 4], P[BASE + 5]), b1 = cvtpk(P[BASE + 6], P[BASE + 7]);                              \
    auto r0 = __builtin_amdgcn_permlane32_swap(a0, b0, false, false); auto r1 = __builtin_amdgcn_permlane32_swap(a1, b1, false, false); \
    u32x4 w = {r0[0], r1[0], r0[1], r1[1]}; OUT = __builtin_bit_cast(bf16x8, w); } while (0)
    AT_PK4(p0, 0, pa0); AT_PK4(p0, 8, pa1); AT_PK4(p1, 0, pa2); AT_PK4(p1, 8, pa3);
#undef AT_PK4
}
DI void qkt(f32x16& p0, f32x16& p1, const char* Ks, const bf16x8* qr, const f32x16& negm, int r32, int hi) {
#pragma unroll
    for (int d0 = 0; d0 < 4; ++d0) { const int cb = (d0 * 16 + hi * 8) * 2;
        const bf16x8 b0 = *reinterpret_cast<const bf16x8*>(Ks + AT_KSWZ(r32, cb));
        const bf16x8 b1 = *reinterpret_cast<const bf16x8*>(Ks + AT_KSWZ(32 + r32, cb));
        p0 = __builtin_amdgcn_mfma_f32_32x32x16_bf16(b0, qr[d0], d0 == 0 ? negm : p0, 0, 0, 0);
        p1 = __builtin_amdgcn_mfma_f32_32x32x16_bf16(b1, qr[d0], d0 == 0 ? negm : p1, 0, 0, 0); }
}
template <int D0> DI void pv_one(f32x16& od, int vb, bf16x8 pa0, bf16x8 pa1, bf16x8 pa2, bf16x8 pa3) {
    const s16x4 l0 = tr_read<v_rd_off(D0, 0, 0)>(vb), h0 = tr_read<v_rd_off(D0, 0, 1)>(vb), l1 = tr_read<v_rd_off(D0, 1, 0)>(vb), h1 = tr_read<v_rd_off(D0, 1, 1)>(vb);
    const s16x4 l2 = tr_read<v_rd_off(D0, 2, 0)>(vb), h2 = tr_read<v_rd_off(D0, 2, 1)>(vb), l3 = tr_read<v_rd_off(D0, 3, 0)>(vb), h3 = tr_read<v_rd_off(D0, 3, 1)>(vb);
    asm volatile("s_waitcnt lgkmcnt(0)" ::: "memory"); AT_SBAR();
#define AT_PK(L, H) (bf16x8){L[0], L[1], L[2], L[3], H[0], H[1], H[2], H[3]}
    od = __builtin_amdgcn_mfma_f32_32x32x16_bf16(AT_PK(l0, h0), pa0, od, 0, 0, 0);
    od = __builtin_amdgcn_mfma_f32_32x32x16_bf16(AT_PK(l1, h1), pa1, od, 0, 0, 0);
    od = __builtin_amdgcn_mfma_f32_32x32x16_bf16(AT_PK(l2, h2), pa2, od, 0, 0, 0);
    od = __builtin_amdgcn_mfma_f32_32x32x16_bf16(AT_PK(l3, h3), pa3, od, 0, 0, 0);
#undef AT_PK
}
DI void pv_all_sm(f32x16* o, int vb, bf16x8 pa0, bf16x8 pa1, bf16x8 pa2, bf16x8 pa3, f32x16& p0, f32x16& p1, float& m_ref, f32x16& negm, float& alpha) {
    pv_one<0>(o[0], vb, pa0, pa1, pa2, pa3);
    float pmax = p0[0];
#pragma unroll
    for (int r = 1; r < 16; ++r) pmax = fmaxf(pmax, p0[r]);
    pv_one<1>(o[1], vb, pa0, pa1, pa2, pa3);
#pragma unroll
    for (int r = 0; r < 16; ++r) pmax = fmaxf(pmax, p1[r]);
    { auto rr = __builtin_amdgcn_permlane32_swap(__float_as_uint(pmax), __float_as_uint(pmax), false, false); pmax = fmaxf(__uint_as_float(rr[0]), __uint_as_float(rr[1])); }
    pv_one<2>(o[2], vb, pa0, pa1, pa2, pa3);
    alpha = 1.f;
    if (__builtin_expect(!__all(pmax <= THRL), 0)) {
        const float dl = fmaxf(pmax, 0.f); m_ref += dl; alpha = __builtin_amdgcn_exp2f(-dl);
#pragma unroll
        for (int r = 0; r < 16; ++r) { p0[r] -= dl; p1[r] -= dl; }
#pragma unroll
        for (int r = 0; r < 16; ++r) negm[r] = -m_ref;
    }
    pv_one<3>(o[3], vb, pa0, pa1, pa2, pa3);
#pragma unroll
    for (int r = 0; r < 16; ++r) p0[r] = __builtin_amdgcn_exp2f(p0[r]);
}
DI void pv_all(f32x16* o, int vb, bf16x8 pa0, bf16x8 pa1, bf16x8 pa2, bf16x8 pa3) {
    pv_one<0>(o[0], vb, pa0, pa1, pa2, pa3); pv_one<1>(o[1], vb, pa0, pa1, pa2, pa3); pv_one<2>(o[2], vb, pa0, pa1, pa2, pa3); pv_one<3>(o[3], vb, pa0, pa1, pa2, pa3);
}
constexpr int OFF_CV = OFF_ST + 65536, CV_TILE = 64 * 68, CV_NITEM = 192;
struct CvRide { int ci, pend, band, gu; const float* src; unsigned char* dst; unsigned char* sdst; };
DI void cv_band(const Frame& F, CvRide& cv, int band) {
    const int p = 6 * F.wg + band, q = p >> 5, kb = p & 31, ty = q >> 4, e = q & 15;
    const float* W = (const float*)F.in[ty == 0 ? I_WGATE : (ty == 1 ? I_WUP : I_WDOWN)] + (size_t)e * D * FF;
    cv.src = W + (size_t)(kb * 64) * 2048; cv.gu = ty < 2;
    unsigned char* WT8 = ty < 2 ? (unsigned char*)(F.ws + WS_W1T) + (size_t)e * 4096 * 2048 + (size_t)(ty * 128) * 2048 : (unsigned char*)(F.ws + WS_W2T) + (size_t)e * 2048 * 2048;
    cv.dst = WT8 + kb * 64; cv.band = band;
}
DI void attn_pass(const Frame& F, CvRide& cv, const bf16_t* __restrict__ Qb, const bf16_t* __restrict__ Kh, const bf16_t* __restrict__ Vh, char* lds, f32x16 (&o)[4], float& l_out, const int wave_s) {
    const int tid = tid_fresh(wave_s), wid = tid >> 6, lane = tid & 63, r32 = lane & 31, hi = lane >> 5;
    char* V_lds = lds + OFF_V; char* K_lds = lds + OFF_K;
    float m_ref = 0.f, l_reg = 0.f; bf16x8 qr[4]; f32x16 negm = f32x16{};
#pragma unroll
    for (int d = 0; d < 4; ++d) o[d] = f32x16{};
    const bf16_t* Qw = Qb + (size_t)(wid * 32 + r32) * 64 + hi * 8;
#pragma unroll
    for (int d0 = 0; d0 < 4; ++d0) qr[d0] = *reinterpret_cast<const bf16x8*>(Qw + d0 * 16);
    const int sr = tid >> 4, sc = (tid & 15) * 8, vst0 = v_st(sr, sc), vst1 = v_st(32 + sr, sc);
    const int kr = tid >> 3, kcb = (tid & 7) * 16, kst = AT_KSWZ(kr, kcb);
    const int vb0 = (int)(uintptr_t)V_lds + v_rd_base(lane);
    struct { bf16x8 vs0, vs1, ks0; } sr_[1];
    const unsigned gvo = (unsigned)((sr * 128 + sc) * 2), gko = (unsigned)((kr * 64 + (tid & 7) * 8) * 2);
#define AT_SLOAD(i, k0) do { const GAS char* vt_ = (const GAS char*)(Vh + (size_t)(k0) * 128); const GAS char* vt2_ = vt_ + 8192; const GAS char* kt_ = (const GAS char*)(Kh + (size_t)(k0) * 64); unsigned ov_ = gvo, ok2_ = gko; \
    asm volatile("" : "+s"(vt_), "+s"(vt2_), "+s"(kt_), "+v"(ov_), "+v"(ok2_)); \
    sr_[i].vs0 = *(const GAS bf16x8*)(vt_ + (size_t)ov_); sr_[i].vs1 = *(const GAS bf16x8*)(vt2_ + (size_t)ov_); sr_[i].ks0 = *(const GAS bf16x8*)(kt_ + (size_t)ok2_); } while (0)
#define AT_SWRITE(b, i) do { *(bf16x8*)(V_lds + (b) * SHM_V + vst0) = sr_[i].vs0; *(bf16x8*)(V_lds + (b) * SHM_V + vst1) = sr_[i].vs1; *(bf16x8*)(K_lds + (b) * SHM_K + kst) = sr_[i].ks0; } while (0)
#define AT_SWAIT() asm volatile("s_waitcnt vmcnt(0)" ::: "memory")
#define AT_RESC(a) do { if (__any((a) < 1.f)) { _Pragma("unroll") for (int d = 0; d < 4; ++d) _Pragma("unroll") for (int r = 0; r < 16; ++r) o[d][r] *= (a); } } while (0)
    const unsigned cv_ldo = (unsigned)(((tid >> 4) * 2 * 2048 + (tid & 15) * 4) * 4), cv_sto = (unsigned)((tid >> 3) * 2048 + 8 * (tid & 7));
    const int cv_lw = OFF_CV + (4 * (tid & 15)) * 68 + 2 * (tid >> 4), cv_lr = OFF_CV + (tid >> 3) * 68 + 8 * (tid & 7);
    f32x4 cvA = f32x4{}, cvB = f32x4{}; unsigned cvr0 = 0, cvr1 = 0;
#define AT_CVT2(x, y) __builtin_amdgcn_cvt_pk_fp8_f32(__builtin_amdgcn_fmed3f((x) * F8_WSCALE, -448.f, 448.f), __builtin_amdgcn_fmed3f((y) * F8_WSCALE, -448.f, 448.f), 0, false)
#define AT_CV_READ() do { if (cv.pend) { const char* t_ = lds + cv_lr + ((cv.ci - 1) & 1) * CV_TILE; cvr0 = *(const unsigned*)t_; cvr1 = *(const unsigned*)(t_ + 4); } } while (0)
#define AT_CV_LOAD() do { if (cv.ci < CV_NITEM) { if ((cv.ci >> 5) != cv.band) cv_band(F, cv, cv.ci >> 5); const float* s_ = cv.src + (cv.ci & 31) * 64; \
        const GAS char* g_ = (const GAS char*)s_; const GAS char* g2_ = g_ + 8192; unsigned o_ = cv_ldo; asm volatile("" : "+s"(g_), "+s"(g2_), "+v"(o_)); \
        cvA = __builtin_nontemporal_load((const GAS f32x4*)(g_ + (size_t)o_)); cvB = __builtin_nontemporal_load((const GAS f32x4*)(g2_ + (size_t)o_)); } } while (0)
#define AT_CV_STORE() do { if (cv.pend) { GAS unsigned char* gd_ = (GAS unsigned char*)cv.sdst; unsigned o_ = cv_sto; asm volatile("" : "+s"(gd_), "+v"(o_)); __builtin_nontemporal_store((u32x2){cvr0, cvr1}, (GAS u32x2*)(gd_ + (size_t)o_)); cv.pend = 0; } } while (0)
#define AT_CV_TAIL() do { if (cv.ci < CV_NITEM) { char* t_ = lds + cv_lw + (cv.ci & 1) * CV_TILE; \
        _Pragma("unroll") for (int j_ = 0; j_ < 4; ++j_) *(unsigned short*)(t_ + j_ * 68) = (unsigned short)AT_CVT2(cvA[j_], cvB[j_]); { const int nb_ = cv.ci & 31; cv.sdst = cv.dst + (size_t)(cv.gu ? ((nb_ >> 1) << 8) + ((nb_ & 1) << 6) : (nb_ << 6)) * 2048; } cv.pend = 1; ++cv.ci; } } while (0)
    f32x16 pA0, pA1, pB0, pB1; float alA, alB; bf16x8 pa0, pa1, pa2, pa3; constexpr int NT = S / 64;
    constexpr int SE = 0;
    {
        bf16x8 v10 = *reinterpret_cast<const bf16x8*>(&Vh[(size_t)(64 + sr) * 128 + sc]), v11 = *reinterpret_cast<const bf16x8*>(&Vh[(size_t)(96 + sr) * 128 + sc]);
        bf16x8 k10 = *reinterpret_cast<const bf16x8*>(&Kh[(size_t)(64 + kr) * 64 + (tid & 7) * 8]);
        AT_SLOAD(SE, 0); asm volatile("s_waitcnt vmcnt(0)" ::: "memory");
        __syncthreads();
        AT_SWRITE(0, SE);
        *(bf16x8*)(V_lds + SHM_V + vst0) = v10; *(bf16x8*)(V_lds + SHM_V + vst1) = v11; *(bf16x8*)(K_lds + SHM_K + kst) = k10;
        __syncthreads();
    }
    qkt(pA0, pA1, K_lds, qr, negm, r32, hi); partialSM(pA0, pA1, m_ref, negm, alA);
    int s_prev = 0, s_cur = 1, s_next = 2;
#define AT_ROT() do { const int t_ = s_prev; s_prev = s_cur; s_cur = s_next; s_next = t_; } while (0)
#define AT_STEP(X0, X1, Y0, Y1, alX, alY, j_, LOADN) do { \
        AT_CV_READ(); AT_CV_LOAD(); AT_SBAR(); qkt(X0, X1, K_lds + s_cur * SHM_K, qr, negm, r32, hi); \
        finishSM(Y0, Y1, alY, l_reg, pa0, pa1, pa2, pa3); AT_SBAR(); \
        if (LOADN) { AT_SLOAD(SE, ((j_) + 1) * 64); } AT_CV_STORE(); AT_SBAR(); \
        pv_all_sm(o, vb0 + s_prev * SHM_V, pa0, pa1, pa2, pa3, X0, X1, m_ref, negm, alX); \
        AT_SWAIT(); if (LOADN) { AT_SWRITE(s_next, SE); } AT_CV_TAIL(); \
        AT_RESC(alX); __syncthreads(); AT_ROT(); } while (0)
    for (int j = 1; j + 2 < NT; j += 2) {
        AT_STEP(pB0, pB1, pA0, pA1, alB, alA, j, true);
        AT_STEP(pA0, pA1, pB0, pB1, alA, alB, j + 1, true);
    }
    AT_STEP(pB0, pB1, pA0, pA1, alB, alA, NT - 1, false);
    AT_CV_READ(); AT_CV_STORE();
    finishSM(pB0, pB1, alB, l_reg, pa0, pa1, pa2, pa3); AT_SBAR();
    pv_all(o, vb0 + s_prev * SHM_V, pa0, pa1, pa2, pa3);
#undef AT_STEP
#undef AT_ROT
    l_out = l_reg;
#undef AT_CVT2
#undef AT_CV_READ
#undef AT_CV_LOAD
#undef AT_CV_STORE
#undef AT_CV_TAIL
#undef AT_SLOAD
#undef AT_SWRITE
#undef AT_SWAIT
#undef AT_RESC
}
}

DI void attn_unit(const Frame& F, att::CvRide& cv, int bh, int qb, float lam) {
    using namespace att;
    const int tid = tid_fresh(F.wave), lane = tid & 63, wid = tid >> 6, r32 = lane & 31, hi = lane >> 5;
    const bf16_t* QD = (const bf16_t*)(F.ws + WS_QD); const bf16_t* KD = (const bf16_t*)(F.ws + WS_KD); const bf16_t* VD = (const bf16_t*)(F.ws + WS_VD);
    unsigned* stash = (unsigned*)(F.lds + OFF_ST) + wid * 2048;
    const bf16_t* Vh = VD + (size_t)bh * S * 128;
    f32x16 o[4]; float l;
    attn_pass(F, cv, QD + ((size_t)(bh * 2 + 0) * S + qb * 256) * 64, KD + (size_t)(bh * 2 + 0) * S * 64, Vh, (char*)F.lds, o, l, F.wave);
    { const float rl = 1.f / l;
#pragma unroll
      for (int d = 0; d < 4; ++d)
#pragma unroll
          for (int r = 0; r < 16; r += 2) stash[(d * 8 + (r >> 1)) * 64 + lane] = pk2(o[d][r] * rl, o[d][r + 1] * rl); }
    attn_pass(F, cv, QD + ((size_t)(bh * 2 + 1) * S + qb * 256) * 64, KD + (size_t)(bh * 2 + 1) * S * 64, Vh, (char*)F.lds, o, l, F.wave);
    { const float rl = lam / l; float ss = 0.f;
#pragma unroll
      for (int d = 0; d < 4; ++d)
#pragma unroll
          for (int r = 0; r < 16; r += 2) { const unsigned w = stash[(d * 8 + (r >> 1)) * 64 + lane]; o[d][r] = bflo(w) - o[d][r] * rl; o[d][r + 1] = bfhi(w) - o[d][r + 1] * rl; ss += o[d][r] * o[d][r] + o[d][r + 1] * o[d][r + 1]; }
      { auto rr = __builtin_amdgcn_permlane32_swap(__float_as_uint(ss), __float_as_uint(ss), false, false); ss = __uint_as_float(rr[0]) + __uint_as_float(rr[1]); }
      const float rs = rsqrtf(ss * (1.f / 128.f) + NORM_EPS) * (1.f - LAM_INIT);
      const float* gain = (const float*)F.in[I_SUBLN];
      const int b = bh >> 3, h = bh & 7;
      f32x4 gq[4][4];
#pragma unroll
      for (int d = 0; d < 4; ++d)
#pragma unroll
          for (int g = 0; g < 4; ++g) gq[d][g] = *(const f32x4*)(gain + 32 * d + 8 * g + 4 * hi);
      bf16_t* obase = (bf16_t*)(F.ws + WS_MIXIN) + (size_t)(b * S + qb * 256 + wid * 32) * D + h * 128;
      char* tb = (char*)stash;
#pragma unroll
      for (int hf = 0; hf < 2; ++hf) {
#pragma unroll
          for (int dd = 0; dd < 2; ++dd)
#pragma unroll
              for (int gp = 0; gp < 2; ++gp) { const int d = 2 * hf + dd, g0 = 2 * gp, g1 = g0 + 1; const f32x4 ga = gq[d][g0], gb = gq[d][g1];
                  const unsigned a0 = pk2(o[d][4 * g0] * rs * ga[0], o[d][4 * g0 + 1] * rs * ga[1]), a1 = pk2(o[d][4 * g0 + 2] * rs * ga[2], o[d][4 * g0 + 3] * rs * ga[3]);
                  const unsigned b0 = pk2(o[d][4 * g1] * rs * gb[0], o[d][4 * g1 + 1] * rs * gb[1]), b1 = pk2(o[d][4 * g1 + 2] * rs * gb[2], o[d][4 * g1 + 3] * rs * gb[3]);
                  auto r0 = __builtin_amdgcn_permlane32_swap(a0, b0, false, false); auto r1 = __builtin_amdgcn_permlane32_swap(a1, b1, false, false);
                  char* wp = tb + r32 * 136 + (32 * dd + 16 * gp + 8 * hi) * 2;
                  *(u32x2*)wp = (u32x2){r0[0], r1[0]}; *(u32x2*)(wp + 8) = (u32x2){r0[1], r1[1]}; }
          asm volatile("s_waitcnt lgkmcnt(0)" ::: "memory");
#pragma unroll
          for (int q = 0; q < 4; ++q) { const int row = (lane >> 3) + 8 * q, ch = lane & 7; const char* rp = tb + row * 136 + ch * 16;
              const u32x2 lo = *(const u32x2*)rp, hi2 = *(const u32x2*)(rp + 8);
              *(u32x4*)(obase + (size_t)row * D + hf * 64 + ch * 8) = (u32x4){lo.x, lo.y, hi2.x, hi2.y}; }
          asm volatile("s_waitcnt lgkmcnt(0)" ::: "memory");
      } }
}
DI void convert_experts_slice(const Frame& F);
DI void ph_attn(const Frame& F) {
    const float lam = diff_lambda((const float*)F.in[I_LQ1], (const float*)F.in[I_LK1], (const float*)F.in[I_LQ2], (const float*)F.in[I_LK2], F.lane);
    const int x = F.wg & 7, j = F.wg >> 3;
    if (F.nwg == 256) { att::CvRide cv{0, 0, -1, 0, nullptr, nullptr, nullptr};
        attn_unit(F, cv, 0 * 16 + x * 2 + (j >> 4), j & 15, lam);
        attn_unit(F, cv, 1 * 16 + x * 2 + (j >> 4), j & 15, lam); }
    else { att::CvRide cv{att::CV_NITEM, 0, -1, 0, nullptr, nullptr, nullptr}; for (int u = F.wg; u < NB * NH * 16; u += F.nwg) attn_unit(F, cv, u >> 4, u & 15, lam); __syncthreads(); convert_experts_slice(F); __syncthreads(); }
}


namespace ret {
using att::bf16x8; using att::s16x4; using att::f32x16; using att::crow; using att::cvtpk; using att::v_st; using att::v_rd_base; using att::v_rd_off; using att::tr_read;
#define RT_KSWZ(row, colB) ((row) * 256 + ((colB) ^ (((row) & 7) << 4)))
DI bf16x8 scale8(bf16x8 v, float s) { const u32x4 w = __builtin_bit_cast(u32x4, v); u32x4 o; o.x = cvtpk(bflo(w.x) * s, bfhi(w.x) * s); o.y = cvtpk(bflo(w.y) * s, bfhi(w.y) * s); o.z = cvtpk(bflo(w.z) * s, bfhi(w.z) * s); o.w = cvtpk(bflo(w.w) * s, bfhi(w.w) * s); return __builtin_bit_cast(bf16x8, o); }
#define RT_PK(L, H) (bf16x8){L[0], L[1], L[2], L[3], H[0], H[1], H[2], H[3]}
template <int TOFF> DI void kv_step4(f32x16& acc, int vbK, int vbV) {
    const s16x4 ka0 = tr_read<TOFF + v_rd_off(0, 0, 0)>(vbK), kb0 = tr_read<TOFF + v_rd_off(0, 0, 1)>(vbK), va0 = tr_read<TOFF + v_rd_off(0, 0, 0)>(vbV), vb0 = tr_read<TOFF + v_rd_off(0, 0, 1)>(vbV);
    const s16x4 ka1 = tr_read<TOFF + v_rd_off(0, 1, 0)>(vbK), kb1 = tr_read<TOFF + v_rd_off(0, 1, 1)>(vbK), va1 = tr_read<TOFF + v_rd_off(0, 1, 0)>(vbV), vb1 = tr_read<TOFF + v_rd_off(0, 1, 1)>(vbV);
    const s16x4 ka2 = tr_read<TOFF + v_rd_off(0, 2, 0)>(vbK), kb2 = tr_read<TOFF + v_rd_off(0, 2, 1)>(vbK), va2 = tr_read<TOFF + v_rd_off(0, 2, 0)>(vbV), vb2 = tr_read<TOFF + v_rd_off(0, 2, 1)>(vbV);
    const s16x4 ka3 = tr_read<TOFF + v_rd_off(0, 3, 0)>(vbK), kb3 = tr_read<TOFF + v_rd_off(0, 3, 1)>(vbK), va3 = tr_read<TOFF + v_rd_off(0, 3, 0)>(vbV), vb3 = tr_read<TOFF + v_rd_off(0, 3, 1)>(vbV);
    asm volatile("s_waitcnt lgkmcnt(0)" ::: "memory"); __builtin_amdgcn_sched_barrier(0);
    acc = __builtin_amdgcn_mfma_f32_32x32x16_bf16(RT_PK(ka0, kb0), RT_PK(va0, vb0), acc, 0, 0, 0);
    acc = __builtin_amdgcn_mfma_f32_32x32x16_bf16(RT_PK(ka1, kb1), RT_PK(va1, vb1), acc, 0, 0, 0);
    acc = __builtin_amdgcn_mfma_f32_32x32x16_bf16(RT_PK(ka2, kb2), RT_PK(va2, vb2), acc, 0, 0, 0);
    acc = __builtin_amdgcn_mfma_f32_32x32x16_bf16(RT_PK(ka3, kb3), RT_PK(va3, vb3), acc, 0, 0, 0);
}
}

DI void state_unit(const Frame& F, int u) {
    using namespace ret;
    const int tid = tid_fresh(F.wave), lane = tid & 63, hi = lane >> 5;
    const int eh = u & 1, dkh = (u >> 1) & 1, dir = (u >> 2) & 1, bh = u >> 3, h = bh & 7;
    const float* logit = (const float*)F.in[I_DECAY];
    const float lg = log2f(1.f / (1.f + __expf(-logit[dir * 8 + h])));
    const float cd = exp2f(128.f * lg);
    char* lds = (char*)F.lds;
    const bf16_t* RK = (const bf16_t*)(F.ws + WS_RK) + (size_t)bh * S * 128 + dkh * 64; const bf16_t* RV = (const bf16_t*)(F.ws + WS_RV) + (size_t)bh * S * 128 + eh * 64;
    bf16_t* ST = (bf16_t*)(F.ws + WS_ST) + (size_t)((bh * 2 + dir) * 32) * 16384;
    const int srow = tid >> 3, sch = tid & 7;
    float kdec[2];
#pragma unroll
    for (int i = 0; i < 2; ++i) { const int j = srow + 64 * i; kdec[i] = exp2f(lg * (float)(dir ? j : 127 - j)); }
    int kst[2], vst[2];
#pragma unroll
    for (int i = 0; i < 2; ++i) { const int j = srow + 64 * i; kst[i] = (j >> 6) * 16384 + v_st(j & 63, 8 * sch); vst[i] = 32768 + (j >> 6) * 16384 + v_st(j & 63, 8 * sch); }
    const int grp = F.wave >> 2;
    const int rb = (F.wave >> 1) & 1, cb = F.wave & 1;
    const int vbK = (int)(uintptr_t)lds + v_rd_base(lane) + rb * 512, vbV = (int)(uintptr_t)(lds + 32768) + v_rd_base(lane) + cb * 512;
    f32x16 acc = f32x16{};
    bf16x8 kA[2], vA[2], kB[2], vB[2], kC[2], vC[2];
    const unsigned goff = (unsigned)((srow * 128 + 8 * sch) * 2);
#define ST_LOAD(KR, VR, it_) do { const int itc_ = (it_) < 32 ? (it_) : 31; const int n_ = dir ? 31 - itc_ : itc_; unsigned o_ = goff; asm volatile("" : "+v"(o_)); \
    const GAS char* kp_ = (const GAS char*)(RK + (size_t)n_ * 16384); const GAS char* vp_ = (const GAS char*)(RV + (size_t)n_ * 16384); \
    KR[0] = *(const GAS bf16x8*)(kp_ + (size_t)o_); KR[1] = *(const GAS bf16x8*)(kp_ + 16384 + (size_t)o_); VR[0] = *(const GAS bf16x8*)(vp_ + (size_t)o_); VR[1] = *(const GAS bf16x8*)(vp_ + 16384 + (size_t)o_); } while (0)
#define ST_STEP(KR, VR, it_) do { const int n = dir ? 31 - (it_) : (it_); \
        _Pragma("unroll") for (int i = 0; i < 2; ++i) { *(bf16x8*)(lds + kst[i]) = scale8(KR[i], kdec[i]); *(bf16x8*)(lds + vst[i]) = VR[i]; } \
        {   \
              \
            char* sw_ = lds + 65536 + grp * 8704 + (cb * 32 + (lane & 31)) * 136 + (rb * 32 + 4 * hi) * 2; \
            _Pragma("unroll") for (int g = 0; g < 4; ++g) *(u32x2*)(sw_ + 16 * g) = (u32x2){cvtpk(acc[4 * g], acc[4 * g + 1]), cvtpk(acc[4 * g + 2], acc[4 * g + 3])}; } \
        __syncthreads(); \
        ST_LOAD(KR, VR, (it_) + 3); \
        { const char* sr_ = lds + 65536 + srow * 136 + sch * 16; const u32x2 l0_ = *(const u32x2*)sr_, h0_ = *(const u32x2*)(sr_ + 8), l1_ = *(const u32x2*)(sr_ + 8704), h1_ = *(const u32x2*)(sr_ + 8712); \
          *(u32x4*)(ST + (size_t)n * 16384 + (size_t)(eh * 64 + srow) * 128 + dkh * 64 + sch * 8) = \
              (u32x4){cvtpk(bflo(l0_.x) + bflo(l1_.x), bfhi(l0_.x) + bfhi(l1_.x)), cvtpk(bflo(l0_.y) + bflo(l1_.y), bfhi(l0_.y) + bfhi(l1_.y)), \
                      cvtpk(bflo(h0_.x) + bflo(h1_.x), bfhi(h0_.x) + bfhi(h1_.x)), cvtpk(bflo(h0_.y) + bflo(h1_.y), bfhi(h0_.y) + bfhi(h1_.y))}; } \
        { _Pragma("unroll") for (int r = 0; r < 16; ++r) acc[r] *= cd; \
          if (grp == 0) kv_step4<0>(acc, vbK, vbV); else kv_step4<16384>(acc, vbK, vbV); } \
        __syncthreads(); } while (0)
    ST_LOAD(kA, vA, 0); ST_LOAD(kB, vB, 1); ST_LOAD(kC, vC, 2);
    for (int it = 0; it < 30; it += 3) { ST_STEP(kA, vA, it); ST_STEP(kB, vB, it + 1); ST_STEP(kC, vC, it + 2); }
    ST_STEP(kA, vA, 30); ST_STEP(kB, vB, 31);
#undef ST_STEP
#undef ST_LOAD
}

DI void retout_unit(const Frame& F, int u) {
    using namespace ret;
    const int tid = tid_fresh(F.wave), lane = tid & 63, wid = tid >> 6, r32 = lane & 31, hi = lane >> 5;
    const int bh = u >> 4, h = bh & 7, b = bh >> 3, cs = F.wave >> 2, w4 = F.wave & 3, n = 2 * (u & 15) + cs;
    (void)wid;
    const float* logit = (const float*)F.in[I_DECAY];
    const float lgf = log2f(1.f / (1.f + __expf(-logit[h]))), lgb = log2f(1.f / (1.f + __expf(-logit[8 + h])));
    char* lds = (char*)F.lds; char* Kc = lds + cs * 65536; char* Vc = Kc + 32768;
    const bf16_t* RQ = (const bf16_t*)(F.ws + WS_RQ) + ((size_t)bh * S + n * 128) * 128; const bf16_t* RK = (const bf16_t*)(F.ws + WS_RK) + ((size_t)bh * S + n * 128) * 128;
    const bf16_t* RV = (const bf16_t*)(F.ws + WS_RV) + ((size_t)bh * S + n * 128) * 128;
    const int js = w4 * 32 + r32;
    const size_t tok = (size_t)b * S + n * 128 + js;
    {
        const int t2 = tid & 255;
#pragma unroll
        for (int i = 0; i < 8; ++i) { const int p = t2 + 256 * i, row = p >> 4, ch = p & 15;
            *(bf16x8*)(Kc + RT_KSWZ(row, ch * 16)) = *reinterpret_cast<const bf16x8*>(RK + (size_t)row * 128 + 8 * ch);
            *(bf16x8*)(Vc + (row >> 6) * 16384 + v_st(row & 63, 8 * ch)) = *reinterpret_cast<const bf16x8*>(RV + (size_t)row * 128 + 8 * ch); }
    }
    bf16x8 qr[8];
    { const bf16_t* Qw = RQ + (size_t)(w4 * 32 + r32) * 128 + hi * 8;
#pragma unroll
      for (int ks = 0; ks < 8; ++ks) qr[ks] = *reinterpret_cast<const bf16x8*>(Qw + ks * 16); }
    f32x16 acc[4];
#pragma unroll
    for (int d = 0; d < 4; ++d) acc[d] = f32x16{};
    int kad[4];
#pragma unroll
    for (int kl = 0; kl < 4; ++kl) kad[kl] = RT_KSWZ(r32, (kl * 16 + hi * 8) * 2);
    __syncthreads();
#pragma unroll
    for (int t = 0; t < 2; ++t) {
        f32x16 p0 = f32x16{}, p1 = f32x16{};
#pragma unroll
        for (int ks = 0; ks < 8; ++ks) {
            const bf16x8 k0 = *reinterpret_cast<const bf16x8*>(Kc + kad[ks & 3] + (ks >> 2) * 128 + t * 16384);
            const bf16x8 k1 = *reinterpret_cast<const bf16x8*>(Kc + kad[ks & 3] + (ks >> 2) * 128 + t * 16384 + 8192);
            p0 = __builtin_amdgcn_mfma_f32_32x32x16_bf16(k0, qr[ks], p0, 0, 0, 0);
            p1 = __builtin_amdgcn_mfma_f32_32x32x16_bf16(k1, qr[ks], p1, 0, 0, 0);
            if (ks & 1) asm volatile("" ::: "memory"); }
#pragma unroll
        for (int r = 0; r < 16; ++r) { const int jm = t * 64 + crow(r, hi); const int d0 = js - jm, d1 = d0 - 32;
            p0[r] *= __builtin_amdgcn_exp2f((d0 >= 0 ? lgf : -lgb) * (float)d0);
            p1[r] *= __builtin_amdgcn_exp2f((d1 >= 0 ? lgf : -lgb) * (float)d1); }
        bf16x8 pa0, pa1, pa2, pa3;
#define RT_PK4(P, BASE, OUT) do { unsigned a0 = cvtpk(P[BASE + 0], P[BASE + 1]), a1 = cvtpk(P[BASE + 2], P[BASE + 3]);   \
    unsigned b0 = cvtpk(P[BASE + 4], P[BASE + 5]), b1 = cvtpk(P[BASE + 6], P[BASE + 7]);                              \
    auto r0 = __builtin_amdgcn_permlane32_swap(a0, b0, false, false); auto r1 = __builtin_amdgcn_permlane32_swap(a1, b1, false, false); \
    u32x4 w = {r0[0], r1[0], r0[1], r1[1]}; OUT = __builtin_bit_cast(bf16x8, w); } while (0)
        RT_PK4(p0, 0, pa0); RT_PK4(p0, 8, pa1); RT_PK4(p1, 0, pa2); RT_PK4(p1, 8, pa3);
#undef RT_PK4
        att::pv_all(acc, (int)(uintptr_t)(Vc + t * 16384) + v_rd_base(lane), pa0, pa1, pa2, pa3);
    }
    __syncthreads();
    {
        const bf16_t* Sf = (const bf16_t*)(F.ws + WS_ST) + (size_t)((bh * 2 + 0) * 32 + n) * 16384;
        const bf16_t* Sb = (const bf16_t*)(F.ws + WS_ST) + (size_t)((bh * 2 + 1) * 32 + n) * 16384;
        const char* sfb = pg8::uni((const char*)Sf); const char* sbb = pg8::uni((const char*)Sb);
        const unsigned ldk = (unsigned)__builtin_amdgcn_readfirstlane((unsigned)(uintptr_t)Kc + (unsigned)w4 * 8192u), ldv = (unsigned)__builtin_amdgcn_readfirstlane((unsigned)(uintptr_t)Vc + (unsigned)w4 * 8192u);
        unsigned vo[2];
#pragma unroll
        for (int par = 0; par < 2; ++par) { const int rowl = par * 4 + (lane >> 4); vo[par] = (unsigned)((lane >> 4) * 256 + (((lane & 15) ^ (rowl & 7)) << 4)); }
#pragma unroll
        for (int i = 0; i < 8; ++i) {
            asm volatile("s_mov_b32 m0, %2\n\ts_nop 0\n\tglobal_load_lds_dwordx4 %0, %1" :: "v"(vo[i & 1]), "s"(sfb + (size_t)(w4 * 8 + i) * 1024), "s"(ldk + (unsigned)i * 1024u) : "memory", "m0");
            asm volatile("s_mov_b32 m0, %2\n\ts_nop 0\n\tglobal_load_lds_dwordx4 %0, %1" :: "v"(vo[i & 1]), "s"(sbb + (size_t)(w4 * 8 + i) * 1024), "s"(ldv + (unsigned)i * 1024u) : "memory", "m0");
        }
    }
    const float* gain = (const float*)F.in[I_RETG] + h * 128;
    const bf16_t* grow = (const bf16_t*)(F.ws + WS_RG) + tok * 1024 + h * 128;
    asm volatile("s_waitcnt vmcnt(0)" ::: "memory");
    __syncthreads();
    const float rsf = exp2f(lgf * (float)(js + 1)), rsb = exp2f(lgb * (float)(128 - js));
#pragma unroll
    for (int dir = 0; dir < 2; ++dir) {
        const char* img = dir ? Vc : Kc; const float rs = dir ? rsb : rsf;
#pragma unroll
        for (int t = 0; t < 2; ++t) {
            f32x16 c0 = f32x16{}, c1 = f32x16{};
#pragma unroll
            for (int ks = 0; ks < 8; ++ks) {
                const bf16x8 s0 = *reinterpret_cast<const bf16x8*>(img + kad[ks & 3] + (ks >> 2) * 128 + t * 16384);
                const bf16x8 s1 = *reinterpret_cast<const bf16x8*>(img + kad[ks & 3] + (ks >> 2) * 128 + t * 16384 + 8192);
                c0 = __builtin_amdgcn_mfma_f32_32x32x16_bf16(s0, qr[ks], c0, 0, 0, 0);
                c1 = __builtin_amdgcn_mfma_f32_32x32x16_bf16(s1, qr[ks], c1, 0, 0, 0);
                if (ks & 1) asm volatile("" ::: "memory"); }
#pragma unroll
            for (int r = 0; r < 16; ++r) { acc[2 * t][r] += rs * c0[r]; acc[2 * t + 1][r] += rs * c1[r]; }
        }
    }
    f32x4 gq[4][4];
#pragma unroll
    for (int d = 0; d < 4; ++d)
#pragma unroll
        for (int g = 0; g < 4; ++g) gq[d][g] = *(const f32x4*)(gain + 32 * d + 8 * g + 4 * hi);
    u32x2 gtq[4][4];
#pragma unroll
    for (int d = 0; d < 4; ++d)
#pragma unroll
        for (int g = 0; g < 4; ++g) gtq[d][g] = *(const u32x2*)(grow + 32 * d + 8 * g + 4 * hi);
    float sm = 0.f;
#pragma unroll
    for (int d = 0; d < 4; ++d)
#pragma unroll
        for (int r = 0; r < 16; ++r) sm += acc[d][r];
    { auto rr = __builtin_amdgcn_permlane32_swap(__float_as_uint(sm), __float_as_uint(sm), false, false); sm = __uint_as_float(rr[0]) + __uint_as_float(rr[1]); }
    const float mu = sm * (1.f / 128.f); float sq = 0.f;
#pragma unroll
    for (int d = 0; d < 4; ++d)
#pragma unroll
        for (int r = 0; r < 16; ++r) { acc[d][r] -= mu; sq += acc[d][r] * acc[d][r]; }
    { auto rr = __builtin_amdgcn_permlane32_swap(__float_as_uint(sq), __float_as_uint(sq), false, false); sq = __uint_as_float(rr[0]) + __uint_as_float(rr[1]); }
    const float rs = rsqrtf(sq * (1.f / 128.f) + NORM_EPS);
    bf16_t* orow = (bf16_t*)(F.ws + WS_MIXIN) + tok * D + 1024 + h * 128;
#pragma unroll
    for (int d = 0; d < 4; ++d)
#pragma unroll
        for (int gp = 0; gp < 2; ++gp) { const int g0 = 2 * gp, g1 = g0 + 1; const f32x4 ga = gq[d][g0], gb = gq[d][g1]; const u32x2 ta = gtq[d][g0], tb = gtq[d][g1];
            const unsigned a0 = pk2(acc[d][4 * g0] * rs * ga[0] * bflo(ta.x), acc[d][4 * g0 + 1] * rs * ga[1] * bfhi(ta.x)), a1 = pk2(acc[d][4 * g0 + 2] * rs * ga[2] * bflo(ta.y), acc[d][4 * g0 + 3] * rs * ga[3] * bfhi(ta.y));
            const unsigned b0 = pk2(acc[d][4 * g1] * rs * gb[0] * bflo(tb.x), acc[d][4 * g1 + 1] * rs * gb[1] * bfhi(tb.x)), b1 = pk2(acc[d][4 * g1 + 2] * rs * gb[2] * bflo(tb.y), acc[d][4 * g1 + 3] * rs * gb[3] * bfhi(tb.y));
            auto r0 = __builtin_amdgcn_permlane32_swap(a0, b0, false, false); auto r1 = __builtin_amdgcn_permlane32_swap(a1, b1, false, false);
            *(u32x4*)(orow + 32 * d + 16 * gp + 8 * hi) = (u32x4){r0[0], r1[0], r0[1], r1[1]}; }
    __syncthreads();
}
DI void ph_state(const Frame& F) {
    for (int v = F.wg; v < NB * NH * 8; v += F.nwg) { const int x = v & 7, idx = v >> 3; state_unit(F, (x + 8 * (idx >> 3)) * 8 + (idx & 7)); } }
DI void ph_retout(const Frame& F) { for (int u = F.wg; u < NB * NH * 16; u += F.nwg) retout_unit(F, u); }

DI void ph_prenorm(const Frame& F) {
    const float* x = (const float*)F.in[I_X]; const float* g = (const float*)F.in[I_GPREMIX];
    const float* mod = (const float*)(F.ws + WS_MOD);
    bf16_t* H = (bf16_t*)(F.ws + WS_H);
    const int wgp = (F.nwg == 256) ? (((F.wg & 7) << 5) | (F.wg >> 3)) : F.wg;
    const int gw = wgp * NWAVES + F.wave, ngw = F.nwg * NWAVES;
    for (int r0 = gw * 8; r0 < M; r0 += ngw * 8) {
        const int b = r0 >> 12;
        const float* shift = mod + (size_t)b * 6 * D, * scale = shift + D;
        f32x4 pg[8], ps[8];
#pragma unroll
        for (int j = 0; j < 8; ++j) { const int d0 = 4 * F.lane + 256 * j; const f32x4 gg = *(const f32x4*)(g + d0), sc = *(const f32x4*)(scale + d0) + *(const f32x4*)(scale + MOD_HALF + d0); ps[j] = *(const f32x4*)(shift + d0) + *(const f32x4*)(shift + MOD_HALF + d0);
#pragma unroll
            for (int i = 0; i < 4; ++i) pg[j][i] = gg[i] * (1.f + sc[i]); }
        for (int m = r0; m < r0 + 8; m += 2) {
            const f32x4* xr = (const f32x4*)(x + (size_t)m * D) + F.lane;
            f32x4 v[8], w[8]; float ss = 0.f, ss2 = 0.f;
#pragma unroll
            for (int j = 0; j < 8; ++j) { v[j] = __builtin_nontemporal_load(xr + 64 * j); w[j] = __builtin_nontemporal_load(xr + 512 + 64 * j); }
#pragma unroll
            for (int j = 0; j < 8; ++j) { ss += (v[j][0] * v[j][0] + v[j][1] * v[j][1]) + (v[j][2] * v[j][2] + v[j][3] * v[j][3]); ss2 += (w[j][0] * w[j][0] + w[j][1] * w[j][1]) + (w[j][2] * w[j][2] + w[j][3] * w[j][3]); }
            const float rstd = rsqrtf(wave_sum(ss) * (1.f / D) + NORM_EPS), rstd2 = rsqrtf(wave_sum(ss2) * (1.f / D) + NORM_EPS);
#pragma unroll
            for (int j = 0; j < 8; ++j) {
                float o[4], o2[4];
#pragma unroll
                for (int i = 0; i < 4; ++i) { o[i] = v[j][i] * rstd * pg[j][i] + ps[j][i]; o2[i] = w[j][i] * rstd2 * pg[j][i] + ps[j][i]; }
#if F8_IN
                ((unsigned*)((unsigned char*)H + (size_t)m * D))[F.lane + 64 * j] = pk4_f8(o[0] * F8_HSCALE, o[1] * F8_HSCALE, o[2] * F8_HSCALE, o[3] * F8_HSCALE);
                ((unsigned*)((unsigned char*)H + (size_t)(m + 1) * D))[F.lane + 64 * j] = pk4_f8(o2[0] * F8_HSCALE, o2[1] * F8_HSCALE, o2[2] * F8_HSCALE, o2[3] * F8_HSCALE);
#else
                ((u32x2*)(H + (size_t)m * D) + F.lane)[64 * j] = (u32x2){pk2(o[0], o[1]), pk2(o[2], o[3])};
                ((u32x2*)(H + (size_t)(m + 1) * D) + F.lane)[64 * j] = (u32x2){pk2(o2[0], o2[1]), pk2(o2[2], o2[3])};
#endif
            }
        }
    }
}

DI void ph_rowpass(const Frame& F) {
    const float* x = (const float*)F.in[I_X]; const float* gpm = (const float*)F.in[I_GPOSTMIX]; const float* gpf = (const float*)F.in[I_GPREFFN];
    const float* wr = (const float*)F.in[I_WROUTER];
    const float* mod = (const float*)(F.ws + WS_MOD);
    const bf16_t* MIX = (const bf16_t*)(F.ws + WS_MIX);
    bf16_t* X1 = (bf16_t*)(F.ws + WS_X1); bf16_t* H2 = (bf16_t*)(F.ws + WS_H); float* AFF = (float*)(F.ws + WS_AFF);
    f32x4* wl = (f32x4*)F.lds;
    {
        f32x4 wt[16];
#pragma unroll
        for (int i = 0; i < 16; ++i) wt[i] = ((const f32x4*)wr)[F.tid + NTHR * i];
#pragma unroll
        for (int i = 0; i < 16; ++i) { const int si = F.tid + NTHR * i, d = si >> 2, q = si & 3; wl[((((d >> 8) * 4 + (d & 3)) * 4 + q) << 6) + ((d & 255) >> 2)] = wt[i]; }
    }
    f32x4* pgm = (f32x4*)(F.lds + 131072); f32x4* pgf = pgm + 512; f32x4* psh = pgf + 512;
    for (int bi = F.wg; bi < M / 64; bi += F.nwg) {
        const int blk = (F.nwg == 256) ? (((bi & 7) << 5) | (bi >> 3)) : bi;
        const int bb = (blk * 64) >> 12; const float* mb = mod + (size_t)bb * 6 * D;
        __syncthreads();
        { const int d4 = F.tid; const f32x4 a = ((const f32x4*)gpm)[d4], g1 = ((const f32x4*)(mb + 2 * D))[d4] + ((const f32x4*)(mb + MOD_HALF + 2 * D))[d4], c = ((const f32x4*)gpf)[d4], sc = ((const f32x4*)(mb + 4 * D))[d4] + ((const f32x4*)(mb + MOD_HALF + 4 * D))[d4];
          pgm[d4] = a * g1; pgf[d4] = c * (1.f + sc); psh[d4] = ((const f32x4*)(mb + 3 * D))[d4] + ((const f32x4*)(mb + MOD_HALF + 3 * D))[d4]; }
        if ((blk & 63) == 0) { const int d4 = F.tid; ((f32x4*)((float*)(F.ws + WS_MOD) + 2 * MOD_HALF + (size_t)bb * D))[d4] = ((const f32x4*)(mb + 5 * D))[d4] + ((const f32x4*)(mb + MOD_HALF + 5 * D))[d4]; }
        __syncthreads();
      for (int m = blk * 64 + F.wave * 8; m < blk * 64 + F.wave * 8 + 8; ++m) {
        const int b = m >> 12, s = m & 4095;
        const u32x2* mr = (const u32x2*)(MIX + (size_t)m * D) + F.lane;
        f32x4 v[8]; float ss = 0.f;
#pragma unroll
        for (int j = 0; j < 8; ++j) { const u32x2 w = __builtin_nontemporal_load(mr + 64 * j); v[j] = (f32x4){bflo(w.x), bfhi(w.x), bflo(w.y), bfhi(w.y)}; ss += (v[j][0] * v[j][0] + v[j][1] * v[j][1]) + (v[j][2] * v[j][2] + v[j][3] * v[j][3]); }
        const f32x4* xr = (const f32x4*)(x + (size_t)m * D) + F.lane;
        f32x4 xc[8];
#pragma unroll
        for (int j = 0; j < 8; ++j) xc[j] = __builtin_nontemporal_load(xr + 64 * j);
        const float rstd = rsqrtf(wave_sum(ss) * (1.f / D) + NORM_EPS);
        u32x2* x1r = (u32x2*)(X1 + (size_t)m * D) + F.lane;
        float ss2 = 0.f;
#pragma unroll
        for (int j = 0; j < 8; ++j) {
            const f32x4 gg = pgm[F.lane + 64 * j], xv = xc[j];
#pragma unroll
            for (int i = 0; i < 4; ++i) v[j][i] = xv[i] + (v[j][i] * rstd) * gg[i];
            x1r[64 * j] = (u32x2){pk2(v[j][0], v[j][1]), pk2(v[j][2], v[j][3])};
            ss2 += (v[j][0] * v[j][0] + v[j][1] * v[j][1]) + (v[j][2] * v[j][2] + v[j][3] * v[j][3]);
        }
        const float rstd2 = rsqrtf(wave_sum(ss2) * (1.f / D) + NORM_EPS);
        u32x2* h2r = (u32x2*)(H2 + (size_t)m * D) + F.lane;
        f32x2 lgp[8];
#pragma unroll
        for (int e = 0; e < 8; ++e) lgp[e] = (f32x2){0.f, 0.f};
#pragma unroll
        for (int j = 0; j < 8; ++j) {
            const f32x4 gg = pgf[F.lane + 64 * j], sh = psh[F.lane + 64 * j];
            float h[4];
#pragma unroll
            for (int i = 0; i < 4; ++i) h[i] = v[j][i] * rstd2 * gg[i] + sh[i];
#if F8_E1
            ((unsigned*)((unsigned char*)H2 + (size_t)m * D))[F.lane + 64 * j] = pk4_f8(h[0] * F8_HSCALE, h[1] * F8_HSCALE, h[2] * F8_HSCALE, h[3] * F8_HSCALE);
#else
            h2r[64 * j] = (u32x2){pk2(h[0], h[1]), pk2(h[2], h[3])};
#endif
#pragma unroll
            for (int i = 0; i < 4; ++i) v[j][i] = h[i];
        }
        {
            f32x4 wq0[4], wq1[4], wq2[4];
#define RT_LD(W, t_) do { _Pragma("unroll") for (int q = 0; q < 4; ++q) W[q] = wl[((((t_)) * 4 + q) << 6) + F.lane]; } while (0)
#define RT_FMA(W, t_) do { const float hv_ = v[(t_) >> 2][(t_) & 3]; const f32x2 hh = {hv_, hv_}; _Pragma("unroll") for (int q = 0; q < 4; ++q) { \
                lgp[2 * q] = __builtin_elementwise_fma(hh, (f32x2){W[q][0], W[q][1]}, lgp[2 * q]); lgp[2 * q + 1] = __builtin_elementwise_fma(hh, (f32x2){W[q][2], W[q][3]}, lgp[2 * q + 1]); } \
                asm volatile("" ::: "memory"); } while (0)
            RT_LD(wq0, 0); RT_LD(wq1, 1);
#pragma unroll
            for (int t = 0; t < 30; t += 3) { RT_LD(wq2, t + 2); RT_FMA(wq0, t); RT_LD(wq0, t + 3); RT_FMA(wq1, t + 1); RT_LD(wq1, t + 4); RT_FMA(wq2, t + 2); }
            RT_FMA(wq0, 30); RT_FMA(wq1, 31);
#undef RT_LD
#undef RT_FMA
        }
        {
            const float tot = expert_totals16(lgp, F.lane);
            const float pe = __expf(tot - experts_max(tot));
            const float prob = pe * (1.f / experts_sum(pe));
            if ((F.lane & 3) == 0) AFF[((size_t)b * NE + (F.lane >> 2)) * S + s] = prob;
        }
      }
    }
}

DI int block_scan_incl(int v, volatile LAS int* sw, int tid) {
    const int lane = tid & 63, wid = tid >> 6;
#pragma unroll
    for (int o = 1; o < 64; o <<= 1) { const int t = __shfl_up(v, o); if (lane >= o) v += t; }
    if (lane == 63) sw[wid] = v;
    __syncthreads();
    int off = 0;
    for (int i = 0; i < wid; ++i) off += sw[i];
    __syncthreads();
    return v + off;
}
DI void ph_topk(const Frame& F) {
    const float* AFF = (const float*)(F.ws + WS_AFF);
    int* rowmap = (int*)(F.ws + WS_ROWMAP); float* gatev = (float*)(F.ws + WS_GATEV); int* sel = (int*)(F.ws + WS_SEL);
    volatile LAS int* hist = (volatile LAS int*)F.ldsl;
    volatile LAS int* sw = (volatile LAS int*)(F.ldsl + 1024);
    volatile LAS int* bc = (volatile LAS int*)(F.ldsl + 1024 + 64);
    for (int u = F.wg; u < NB * NE; u += F.nwg) {
        const int b = u >> 4, e = u & 15;
        const float* a = AFF + (size_t)u * S;
        unsigned key[8];
        { const u32x4 k0 = *(const u32x4*)(a + F.tid * 8), k1 = *(const u32x4*)(a + F.tid * 8 + 4); key[0] = k0.x; key[1] = k0.y; key[2] = k0.z; key[3] = k0.w; key[4] = k1.x; key[5] = k1.y; key[6] = k1.z; key[7] = k1.w; }
        unsigned prefix = 0u; int krem = CAP;
#pragma unroll
        for (int pass = 0; pass < 4; ++pass) {
            const int shift = 24 - 8 * pass;
            if (F.tid < 256) hist[F.tid] = 0;
            __syncthreads();
#pragma unroll
            for (int j = 0; j < 8; ++j) { const bool match = (pass == 0) || ((key[j] >> (shift + 8)) == prefix); if (match) __hip_atomic_fetch_add((LAS int*)&hist[(key[j] >> shift) & 255u], 1, __ATOMIC_RELAXED, __HIP_MEMORY_SCOPE_WORKGROUP); }
            __syncthreads();
            const int mybin = 255 - F.tid;
            const int my = F.tid < 256 ? hist[mybin] : 0;
            const int suf = block_scan_incl(my, sw, F.tid);
            if (F.tid < 256 && suf >= krem && suf - my < krem) { bc[0] = mybin; bc[1] = krem - (suf - my); }
            __syncthreads();
            prefix = (prefix << 8) | (unsigned)bc[0]; krem = bc[1];
            __syncthreads();
        }
        int neq = 0;
#pragma unroll
        for (int j = 0; j < 8; ++j) neq += (key[j] == prefix) ? 1 : 0;
        int eqbase = block_scan_incl(neq, sw, F.tid) - neq;
        int nsel = 0; bool flag[8];
#pragma unroll
        for (int j = 0; j < 8; ++j) { const bool eq = key[j] == prefix; flag[j] = key[j] > prefix || (eq && eqbase < krem); eqbase += eq ? 1 : 0; nsel += flag[j] ? 1 : 0; }
        int slot = block_scan_incl(nsel, sw, F.tid) - nsel;
        int slv[8];
#pragma unroll
        for (int j = 0; j < 8; ++j) {
            const int s = F.tid * 8 + j;
            int sl = -1;
            if (flag[j]) { sl = slot++; if (sl < CAP) { rowmap[e * 2048 + b * CAP + sl] = b * S + s; gatev[e * 2048 + b * CAP + sl] = __uint_as_float(key[j]); } else sl = -1; }
            slv[j] = sl;
        }
        { u32x4* sp = (u32x4*)(sel + (size_t)u * S + F.tid * 8);
          sp[0] = (u32x4){(unsigned)slv[0], (unsigned)slv[1], (unsigned)slv[2], (unsigned)slv[3]}; sp[1] = (u32x4){(unsigned)slv[4], (unsigned)slv[5], (unsigned)slv[6], (unsigned)slv[7]}; }
        __syncthreads();
    }
}

DI void ph_final(const Frame& F) {
    const bf16_t* X1 = (const bf16_t*)(F.ws + WS_X1); const bf16_t* Y = (const bf16_t*)(F.ws + WS_Y); const int* sel = (const int*)(F.ws + WS_SEL);
    const float* mod = (const float*)(F.ws + WS_MOD); const float* g = (const float*)F.in[I_GPOSTFFN];
    const int gw = F.wg * NWAVES + F.wave, ngw = F.nwg * NWAVES;
    for (int r0 = 8 * gw; r0 < M; r0 += 8 * ngw) {
      const int b = r0 >> 12;
      const float* g2 = mod + 2 * MOD_HALF + (size_t)b * D;
      f32x4 ggt[8];
#pragma unroll
      for (int j = 0; j < 8; ++j) { const int d0 = 4 * F.lane + 256 * j; ggt[j] = *(const f32x4*)(g + d0) * *(const f32x4*)(g2 + d0); }
      int slots[8];
      { const u32x4* sp = (const u32x4*)(sel + ((size_t)b * NE + (F.lane & 15)) * S + (r0 & 4095)); const u32x4 s0 = sp[0], s1 = sp[1];
        slots[0] = (int)s0.x; slots[1] = (int)s0.y; slots[2] = (int)s0.z; slots[3] = (int)s0.w; slots[4] = (int)s1.x; slots[5] = (int)s1.y; slots[6] = (int)s1.z; slots[7] = (int)s1.w; }
#pragma unroll
      for (int pr = 0; pr < 4; ++pr) {
        const int m = r0 + 2 * pr;
        f32x4 acc[2][8];
#pragma unroll
        for (int rw = 0; rw < 2; ++rw)
#pragma unroll
            for (int j = 0; j < 8; ++j) acc[rw][j] = (f32x4){0.f, 0.f, 0.f, 0.f};
        const int myslot0 = slots[2 * pr], myslot1 = slots[2 * pr + 1];
        u32x2 xw[2][8];
#pragma unroll
        for (int rw = 0; rw < 2; ++rw)
#pragma unroll
            for (int j = 0; j < 8; ++j) xw[rw][j] = __builtin_nontemporal_load((const u32x2*)(X1 + (size_t)(m + rw) * D) + F.lane + 64 * j);
        unsigned m0 = (unsigned)(__ballot(myslot0 >= 0) & 0xFFFFull), m1 = (unsigned)(__ballot(myslot1 >= 0) & 0xFFFFull);
        while (m0 | m1) {
            int e_[4] = {0, 0, 0, 0}, s_[4] = {-1, -1, -1, -1};
            if (m0) { e_[0] = __builtin_ctz(m0); m0 &= m0 - 1; s_[0] = __builtin_amdgcn_readlane(myslot0, e_[0]); }
            if (m0) { e_[1] = __builtin_ctz(m0); m0 &= m0 - 1; s_[1] = __builtin_amdgcn_readlane(myslot0, e_[1]); }
            if (m1) { e_[2] = __builtin_ctz(m1); m1 &= m1 - 1; s_[2] = __builtin_amdgcn_readlane(myslot1, e_[2]); }
            if (m1) { e_[3] = __builtin_ctz(m1); m1 &= m1 - 1; s_[3] = __builtin_amdgcn_readlane(myslot1, e_[3]); }
#if F8_Y
            unsigned yv[4][8];
#pragma unroll
            for (int t = 0; t < 4; ++t) { const unsigned* yr = (const unsigned*)((const unsigned char*)Y + ((size_t)e_[t] * 2048 + b * CAP + (s_[t] < 0 ? 0 : s_[t])) * D) + F.lane;
#pragma unroll
                for (int j = 0; j < 8; ++j) yv[t][j] = __builtin_nontemporal_load(yr + 64 * j); }
#pragma unroll
            for (int t = 0; t < 4; ++t) { const float wt = s_[t] < 0 ? 0.f : 1.f;
#pragma unroll
                for (int j = 0; j < 8; ++j) { const int w = (int)yv[t][j]; const f32x2 lo = __builtin_amdgcn_cvt_pk_f32_fp8(w, false), hi = __builtin_amdgcn_cvt_pk_f32_fp8(w, true);
                    acc[t >> 1][j][0] += wt * lo.x; acc[t >> 1][j][1] += wt * lo.y; acc[t >> 1][j][2] += wt * hi.x; acc[t >> 1][j][3] += wt * hi.y; } }
#else
            u32x2 yv[4][8];
#pragma unroll
            for (int t = 0; t < 4; ++t) { const u32x2* yr = (const u32x2*)(Y + ((size_t)e_[t] * 2048 + b * CAP + (s_[t] < 0 ? 0 : s_[t])) * D) + F.lane;
#pragma unroll
                for (int j = 0; j < 8; ++j) yv[t][j] = yr[64 * j]; }
#pragma unroll
            for (int t = 0; t < 4; ++t) { const float wt = s_[t] < 0 ? 0.f : 1.f;
#pragma unroll
                for (int j = 0; j < 8; ++j) { const u32x2 w = yv[t][j]; acc[t >> 1][j][0] += wt * bflo(w.x); acc[t >> 1][j][1] += wt * bfhi(w.x); acc[t >> 1][j][2] += wt * bflo(w.y); acc[t >> 1][j][3] += wt * bfhi(w.y); } }
#endif
        }
#pragma unroll
        for (int rw = 0; rw < 2; ++rw) {
            float ss = 0.f;
#if F8_Y
#pragma unroll
            for (int j = 0; j < 8; ++j) acc[rw][j] = acc[rw][j] * (1.f / F8_YSCALE);
#endif
#pragma unroll
            for (int j = 0; j < 8; ++j) ss += (acc[rw][j][0] * acc[rw][j][0] + acc[rw][j][1] * acc[rw][j][1]) + (acc[rw][j][2] * acc[rw][j][2] + acc[rw][j][3] * acc[rw][j][3]);
            const float rstd = rsqrtf(wave_sum(ss) * (1.f / D) + NORM_EPS);
            f32x4* orow = (f32x4*)(F.out + (size_t)(m + rw) * D) + F.lane;
#pragma unroll
            for (int j = 0; j < 8; ++j) {
                const f32x4 xv = (f32x4){bflo(xw[rw][j].x), bfhi(xw[rw][j].x), bflo(xw[rw][j].y), bfhi(xw[rw][j].y)};
                f32x4 o;
#pragma unroll
                for (int i = 0; i < 4; ++i) { o[i] = xv[i] + (acc[rw][j][i] * rstd) * ggt[j][i]; }
                __builtin_nontemporal_store(o, orow + 64 * j);
            }
        }
      }
    }
}

__global__ void __launch_bounds__(NTHR, 2) mega(Args a) {
    extern __shared__ __attribute__((aligned(16))) unsigned char lds[];
    Frame F;
    F.lds = lds; F.ldsl = (LAS unsigned char*)lds; F.ws = a.ws; F.in = a.in; F.out = a.out;
    F.wg = blockIdx.x; F.nwg = gridDim.x;
    F.wave = __builtin_amdgcn_readfirstlane(threadIdx.x >> 6);
#define REFRESH() do { F.tid = tid_fresh(F.wave); F.lane = F.tid & 63; } while (0)
    REFRESH();
    for (int u = F.tid; u < (LDS_BYTES - LDSCTL_OFF) / 4; u += NTHR) ((unsigned*)(lds + LDSCTL_OFF))[u] = 0u;
    __syncthreads();
    const int lo = a.ph_lo, hi = a.ph_hi;
    XcdBarrier bar; bar.bar = (unsigned*)(a.ws + WS_CTL) + CW_BAR; bar.x = 0; bar.st = nullptr; bar.wave = F.wave;
    if (hi - lo > 1) bar = xcd_barrier_post((unsigned*)(a.ws + WS_CTL) + CW_BAR, (volatile LAS unsigned*)(lds + MISC_OFF + 32), F.wave);
#define IN(k) (lo <= (k) && (k) < hi)
#define SEAM(k) do { if (IN(k) && IN((k) + 1)) xcd_barrier(bar); } while (0)
    if (IN(PH_PREP)) { for (int rep_ = 0; rep_ < REP_PREP; ++rep_) { REFRESH(); ph_prep(F); } for (int rep_ = 0; rep_ < REP_CONV; ++rep_) { REFRESH(); ph_convert(F); } SEAM(PH_PREP); }
    if (IN(PH_PRENORM)) { for (int rep_ = 0; rep_ < REP_PRENORM; ++rep_) { REFRESH(); ph_prenorm(F); } SEAM(PH_PRENORM); }
#if OPT_IN
    if (IN(PH_INPROJ)) { for (int rep_ = 0; rep_ < REP_IN; ++rep_) { REFRESH(); ph_inproj(F); } SEAM(PH_INPROJ); }
#endif
#if OPT_RET && OPT_ATTN
    if (IN(PH_ATTN)) { for (int rep_ = 0; rep_ < REP_STATE; ++rep_) { REFRESH(); ph_state(F); } SEAM(PH_ATTN); }
    if (IN(PH_RETOUT)) { for (int rep_ = 0; rep_ < REP_RETOUT; ++rep_) { REFRESH(); ph_retout(F); } __syncthreads();
        for (int rep_ = 0; rep_ < REP_ATTN; ++rep_) { REFRESH(); ph_attn(F); } SEAM(PH_RETOUT); }
#else
    if (IN(PH_ATTN)) {
#if OPT_RET
        for (int rep_ = 0; rep_ < REP_STATE; ++rep_) { REFRESH(); ph_state(F); }
#endif
#if OPT_ATTN
        for (int rep_ = 0; rep_ < REP_ATTN; ++rep_) { REFRESH(); ph_attn(F); }
#endif
        SEAM(PH_ATTN); }
#if OPT_RET
    if (IN(PH_RETOUT)) { for (int rep_ = 0; rep_ < REP_RETOUT; ++rep_) { REFRESH(); ph_retout(F); } SEAM(PH_RETOUT); }
#endif
#endif
#if OPT_OUT
    if (IN(PH_OUTPROJ)) { REFRESH(); ph_outproj(F); SEAM(PH_OUTPROJ); }
#endif
    if (IN(PH_ROWPASS)) { for (int rep_ = 0; rep_ < REP_ROWPASS; ++rep_) { REFRESH(); ph_rowpass(F); } SEAM(PH_ROWPASS); }
    if (IN(PH_TOPK)) { for (int rep_ = 0; rep_ < REP_TOPK; ++rep_) { REFRESH(); ph_topk(F); } SEAM(PH_TOPK); }
#if OPT_E1
    if (IN(PH_E1)) { for (int rep_ = 0; rep_ < REP_E1; ++rep_) { REFRESH(); ph_e1(F); } SEAM(PH_E1); }
#endif
#if OPT_E2
    if (IN(PH_E2)) { REFRESH(); ph_e2(F); SEAM(PH_E2); }
#endif
    if (IN(PH_FINAL)) { for (int rep_ = 0; rep_ < REP_FINAL; ++rep_) { REFRESH(); ph_final(F); } }
#undef IN
#undef SEAM
}

static void launch_mega(const Args& base, int lo, int hi, int grid, hipStream_t stream) {
    Args a = base; a.ph_lo = lo; a.ph_hi = hi;
    hipLaunchKernelGGL(mega, dim3(grid), dim3(NTHR), LDS_BYTES, stream, a);
}
extern "C" void kernel_launch(void* const* d_in, const int* in_sizes, int n_in, void* d_out, int out_size, void* d_ws, size_t ws_size, hipStream_t stream) {
    static int grid = 0;
    if (grid == 0) {
        if (n_in != 22 || out_size != M * D || ws_size < WS_END) { fprintf(stderr, "kernel_launch: unexpected shapes (n_in %d out %d ws %zu)\n", n_in, out_size, ws_size); grid = -1; return; }
        int dev = 0, cus = 0;
        if (hipGetDevice(&dev) != hipSuccess || hipDeviceGetAttribute(&cus, hipDeviceAttributeMultiprocessorCount, dev) != hipSuccess) { grid = -1; return; }
        if (hipFuncSetAttribute((const void*)mega, hipFuncAttributeMaxDynamicSharedMemorySize, LDS_BYTES) != hipSuccess) { fprintf(stderr, "kernel_launch: hipFuncSetAttribute failed\n"); grid = -1; return; }
        (void)hipGetLastError();
        grid = cus;
    }
    if (grid < 0) return;
    unsigned char* ws = (unsigned char*)d_ws;
    (void)hipMemsetAsync(ws + WS_CTL, 0, CTL_ZERO_BYTES, stream);
    Args a{};
    for (int i = 0; i < 22; ++i) a.in[i] = d_in[i];
    a.out = (float*)d_out; a.ws = ws; a.ph_lo = 0; a.ph_hi = 0;

#if OPT_IN && OPT_OUT && OPT_E1 && OPT_E2 && OPT_ATTN && OPT_RET && !defined(MK_PER_PHASE)
    launch_mega(a, 0, PH_COUNT, grid, stream);
    { const hipError_t le1 = hipPeekAtLastError(); if (le1 != hipSuccess) fprintf(stderr, "kernel_launch: launch failed: %s\n", hipGetErrorName(le1)); }
    return;
#endif
    launch_mega(a, PH_PREP, PH_PREP + 1, grid, stream);
    launch_mega(a, PH_PRENORM, PH_PRENORM + 1, grid, stream);
#if OPT_IN
    launch_mega(a, PH_INPROJ, PH_INPROJ + 1, grid, stream);
#else
    hipLaunchKernelGGL((k_gemm_naive<EpiIn, false, true>), dim3(NCOL / 128, M / 64, 1), dim3(256), 0, stream,
                       (const bf16_t*)(ws + WS_H), D, (const int*)nullptr, (const float*)d_in[I_WIN], (const float*)nullptr, NCOL, D, M, 0L, EpiIn{ws});
#endif
#if OPT_ATTN || OPT_RET
    launch_mega(a, PH_ATTN, PH_ATTN + 1, grid, stream);
#endif
#if !OPT_ATTN
    hipLaunchKernelGGL(k_attn_naive, dim3(NB * NH * 2 * 16), dim3(256), 0, stream, (const bf16_t*)(ws + WS_QD), (const bf16_t*)(ws + WS_KD), (const bf16_t*)(ws + WS_VD), (float*)(ws + WS_ON));
    hipLaunchKernelGGL(k_attn_combine, dim3(NB * NH * S / 4), dim3(256), 0, stream, (const float*)(ws + WS_ON), (const float*)d_in[I_LQ1], (const float*)d_in[I_LK1], (const float*)d_in[I_LQ2], (const float*)d_in[I_LK2],
                       (const float*)d_in[I_SUBLN], (bf16_t*)(ws + WS_MIXIN));
#endif
#if OPT_RET
    launch_mega(a, PH_RETOUT, PH_RETOUT + 1, grid, stream);
#else
    hipLaunchKernelGGL(k_ret_naive, dim3(NB * NH * 2 * 16), dim3(256), 0, stream, (const bf16_t*)(ws + WS_RQ), (const bf16_t*)(ws + WS_RK), (const bf16_t*)(ws + WS_RV), (const float*)d_in[I_DECAY], (float*)(ws + WS_RAW));
    hipLaunchKernelGGL(k_ret_norm, dim3(NB * NH * S / 4), dim3(256), 0, stream, (const float*)(ws + WS_RAW), (const float*)d_in[I_RETG], (const bf16_t*)(ws + WS_RG), (bf16_t*)(ws + WS_MIXIN));
#endif
#if OPT_OUT
    launch_mega(a, PH_OUTPROJ, PH_OUTPROJ + 1, grid, stream);
#else
    hipLaunchKernelGGL((k_gemm_naive<EpiOut, false, false>), dim3(D / 128, M / 64, 1), dim3(256), 0, stream,
                       (const bf16_t*)(ws + WS_MIXIN), D, (const int*)nullptr, (const float*)d_in[I_WOUT], (const float*)nullptr, D, D, M, 0L, EpiOut{ws});
#endif
    launch_mega(a, PH_ROWPASS, PH_ROWPASS + 1, grid, stream);
    launch_mega(a, PH_TOPK, PH_TOPK + 1, grid, stream);
#if OPT_E1
    launch_mega(a, PH_E1, PH_E1 + 1, grid, stream);
#else
    hipLaunchKernelGGL((k_gemm_naive<EpiE1, true, false>), dim3(FF / 128, 2048 / 64, NE), dim3(256), 0, stream,
                       (const bf16_t*)(ws + WS_H), D, (const int*)(ws + WS_ROWMAP), (const float*)d_in[I_WGATE], (const float*)d_in[I_WUP], FF, D, 2048, (long)D * FF, EpiE1{ws});
#endif
#if OPT_E2
    launch_mega(a, PH_E2, PH_E2 + 1, grid, stream);
#else
    hipLaunchKernelGGL((k_gemm_naive<EpiE2, false, false>), dim3(D / 128, 2048 / 64, NE), dim3(256), 0, stream,
                       (const bf16_t*)(ws + WS_HID), FF, (const int*)nullptr, (const float*)d_in[I_WDOWN], (const float*)nullptr, D, FF, 2048, (long)FF * D, EpiE2{ws});
#endif
    launch_mega(a, PH_FINAL, PH_FINAL + 1, grid, stream);
    const hipError_t le = hipPeekAtLastError();
    if (le != hipSuccess) fprintf(stderr, "kernel_launch: launch failed: %s\n", hipGetErrorName(le));
}
```
